# Optimizing an MI355X kernel written in HIP

```python
import jax, jax.numpy as jnp
from jax import lax
import numpy as np

D_MODEL = 2048
BATCH = 2
SEQ = 8192
DEPTH = 2

GLA_HEADS = 4
GLA_DK = D_MODEL // 2
GLA_DV = D_MODEL
GLA_HK = GLA_DK // GLA_HEADS
GLA_HV = GLA_DV // GLA_HEADS
GLA_LOWRANK = 16
GLA_GATE_TEMP = 16.0
GLA_CHUNK = 64
POOL_WIDTH = D_MODEL // 2
POOL_WINDOWS = (2, 4, 8, 16)
POOL_GROUPS = 4
POOL_GW = POOL_WIDTH // POOL_GROUPS
N_BRANCH = 2
SPLIT_SIZES = (GLA_DK, GLA_DK, GLA_DV, GLA_DV, GLA_LOWRANK, POOL_WIDTH, D_MODEL, D_MODEL)
D_IN = 2 * GLA_DK + 2 * GLA_DV + GLA_LOWRANK + POOL_WIDTH + N_BRANCH * D_MODEL
D_FF = 5632
N_EXPERTS = 8
TOP_K = 2
N_DENSE = (DEPTH + 1) // 2
N_MOE = DEPTH // 2
EPS = 1e-6

kernel_name = "hybrid_gla_pool_moe_trunk"


def rmsnorm(x, g):
    xf = x.astype(jnp.float32)
    y = xf * lax.rsqrt(jnp.mean(xf * xf, axis=-1, keepdims=True) + EPS)
    return (y * g.astype(jnp.float32)).astype(x.dtype)


def swiglu(h, w_gate, w_up, w_down):
    return (jax.nn.silu(h @ w_gate) * (h @ w_up)) @ w_down


def gla_chunked(q, k, v, log_a):
    B, S, H, dk = q.shape
    dv = v.shape[-1]
    C = GLA_CHUNK
    nc = S // C

    def chunk(t):
        return t.astype(jnp.float32).reshape(B, nc, C, H, t.shape[-1]).transpose(1, 0, 3, 2, 4)

    qc, kc, vc, ac = chunk(q), chunk(k), chunk(v), chunk(log_a)
    b = jnp.cumsum(ac, axis=3)
    b_last = b[:, :, :, -1:, :]
    q_t = qc * jnp.exp(b) * (dk ** -0.5)
    k_t = kc * jnp.exp(-b)
    k_end = kc * jnp.exp(b_last - b)
    causal = jnp.tril(jnp.ones((C, C), dtype=bool))
    att = jnp.einsum('nbhid,nbhjd->nbhij', q_t, k_t)
    att = jnp.where(causal, att, 0.0)
    o_intra = jnp.einsum('nbhij,nbhjv->nbhiv', att, vc)

    def step(state, inp):
        q_i, k_i, v_i, dec = inp
        o = jnp.einsum('bhid,bhdv->bhiv', q_i, state)
        state = state * jnp.swapaxes(dec, -1, -2) + jnp.einsum('bhjd,bhjv->bhdv', k_i, v_i)
        return state, o

    s0 = jnp.zeros((B, H, dk, dv), jnp.float32)
    _, o_inter = lax.scan(step, s0, (q_t, k_end, vc, jnp.exp(b_last)))
    o = o_intra + o_inter
    return o.transpose(1, 0, 3, 2, 4).reshape(B, S, H, dv)


def pool_mixer(p, w_pool, pool_scale):
    B, S, _ = p.shape
    pf = p.astype(jnp.float32).reshape(B, S, POOL_GROUPS, POOL_GW)
    cs = jnp.cumsum(pf, axis=1)
    pos = jnp.arange(S)
    outs = []
    for g, w in enumerate(POOL_WINDOWS):
        c = cs[:, :, g]
        c_prev = jnp.pad(c, ((0, 0), (w, 0), (0, 0)))[:, :S]
        cnt = jnp.minimum(pos + 1, w).astype(jnp.float32)[None, :, None]
        outs.append((c - c_prev) / cnt - pf[:, :, g])
    mixed = jnp.stack(outs, axis=2).astype(p.dtype)
    y = jnp.einsum('bsgc,gcd->bsgd', mixed, w_pool)
    return y.reshape(B, S, POOL_WIDTH) * pool_scale


def token_mixer(h, w_in, w_alpha, b_alpha, gla_norm, w_pool, pool_scale,
                w_branch_gla, w_branch_pool, w_out):
    B, S, _ = h.shape
    z = h @ w_in
    idx = [int(i) for i in np.cumsum(SPLIT_SIZES)[:-1]]
    q, k, v, r, a1, p, g_a, g_b = jnp.split(z, idx, axis=-1)
    log_a = jax.nn.log_sigmoid((a1 @ w_alpha + b_alpha).astype(jnp.float32)) / GLA_GATE_TEMP
    hd = lambda t, d: t.reshape(B, S, GLA_HEADS, d)
    o = gla_chunked(hd(q, GLA_HK), hd(k, GLA_HK), hd(v, GLA_HV), hd(log_a, GLA_HK))
    o = o * lax.rsqrt(jnp.mean(o * o, axis=-1, keepdims=True) + EPS) * gla_norm.astype(jnp.float32)
    o = o * jax.nn.silu(hd(r, GLA_HV).astype(jnp.float32))
    y_a = o.reshape(B, S, GLA_DV).astype(h.dtype) @ w_branch_gla
    y_b = pool_mixer(p, w_pool, pool_scale) @ w_branch_pool
    u = jax.nn.sigmoid(g_a) * y_a + jax.nn.sigmoid(g_b) * y_b
    return u.astype(h.dtype) @ w_out


def moe_ffn(h, w_router, w_gate, w_up, w_down):
    B, S, D = h.shape
    t = h.reshape(B * S, D)
    logits = (t @ w_router).astype(jnp.float32)
    top_val, top_idx = lax.top_k(logits, TOP_K)
    top_w = jax.nn.softmax(top_val, axis=-1)
    combine = jnp.sum(jax.nn.one_hot(top_idx, N_EXPERTS, dtype=jnp.float32) * top_w[..., None], axis=1)
    out = jnp.zeros((B * S, D), jnp.float32)
    for e in range(N_EXPERTS):
        out = out + combine[:, e:e + 1] * swiglu(t, w_gate[e], w_up[e], w_down[e]).astype(jnp.float32)
    return out.astype(h.dtype).reshape(B, S, D)


def setup_inputs(seed: int = 0) -> dict:
    key = jax.random.key(seed)
    ks = jax.random.split(key, 24)
    f32 = jnp.float32
    nrm = lambda k, shape, fan_in: jax.random.normal(k, shape, f32) * (fan_in ** -0.5)
    gain = lambda k, shape: 1.0 + 0.02 * jax.random.normal(k, shape, f32)
    return {
        "x": jax.random.normal(ks[0], (BATCH, SEQ, D_MODEL), f32),
        "ln_mix": gain(ks[1], (DEPTH, D_MODEL)),
        "w_in": nrm(ks[2], (DEPTH, D_MODEL, D_IN), D_MODEL),
        "w_alpha": nrm(ks[3], (DEPTH, GLA_LOWRANK, GLA_DK), GLA_LOWRANK),
        "b_alpha": 0.1 * jax.random.normal(ks[4], (DEPTH, GLA_DK), f32),
        "gla_norm": gain(ks[5], (DEPTH, GLA_HV)),
        "w_pool": nrm(ks[6], (DEPTH, POOL_GROUPS, POOL_GW, POOL_GW), POOL_GW),
        "pool_scale": 1.0 + 0.1 * jax.random.normal(ks[7], (DEPTH, POOL_WIDTH), f32),
        "w_branch_gla": nrm(ks[8], (DEPTH, GLA_DV, D_MODEL), GLA_DV),
        "w_branch_pool": nrm(ks[9], (DEPTH, POOL_WIDTH, D_MODEL), POOL_WIDTH),
        "w_out": nrm(ks[10], (DEPTH, D_MODEL, D_MODEL), D_MODEL),
        "ln_ffn": gain(ks[11], (DEPTH, D_MODEL)),
        "ffn_w_gate": nrm(ks[12], (N_DENSE, D_MODEL, D_FF), D_MODEL),
        "ffn_w_up": nrm(ks[13], (N_DENSE, D_MODEL, D_FF), D_MODEL),
        "ffn_w_down": nrm(ks[14], (N_DENSE, D_FF, D_MODEL), D_FF),
        "router_w": nrm(ks[15], (N_MOE, D_MODEL, N_EXPERTS), D_MODEL),
        "exp_w_gate": nrm(ks[16], (N_MOE, N_EXPERTS, D_MODEL, D_FF), D_MODEL),
        "exp_w_up": nrm(ks[17], (N_MOE, N_EXPERTS, D_MODEL, D_FF), D_MODEL),
        "exp_w_down": nrm(ks[18], (N_MOE, N_EXPERTS, D_FF, D_MODEL), D_FF),
        "ln_final": gain(ks[19], (D_MODEL,)),
    }


def reference(x, ln_mix, w_in, w_alpha, b_alpha, gla_norm, w_pool, pool_scale,
              w_branch_gla, w_branch_pool, w_out, ln_ffn, ffn_w_gate, ffn_w_up,
              ffn_w_down, router_w, exp_w_gate, exp_w_up, exp_w_down, ln_final):
    for l in range(DEPTH):
        h = rmsnorm(x, ln_mix[l])
        x = x + token_mixer(h, w_in[l], w_alpha[l], b_alpha[l], gla_norm[l], w_pool[l],
                            pool_scale[l], w_branch_gla[l], w_branch_pool[l], w_out[l])
        h = rmsnorm(x, ln_ffn[l])
        if l % 2 == 0:
            i = l // 2
            x = x + swiglu(h, ffn_w_gate[i], ffn_w_up[i], ffn_w_down[i])
        else:
            i = l // 2
            x = x + moe_ffn(h, router_w[i], exp_w_gate[i], exp_w_up[i], exp_w_down[i])
    return rmsnorm(x, ln_final)
```

```cpp
#include <hip/hip_runtime.h>
#include <cstdio>
#include <cstdint>

namespace pg8 {
#define PG8_LAS __attribute__((address_space(3)))
typedef unsigned short bf16_t;
typedef short bf16x8 __attribute__((ext_vector_type(8)));
typedef float f32x4 __attribute__((ext_vector_type(4)));
typedef unsigned u32x4 __attribute__((ext_vector_type(4)));
typedef unsigned u32x2 __attribute__((ext_vector_type(2)));
constexpr int BM = 256, BK = 64, HALF = 128, HTB = HALF * BK * 2  , STAGE_BYTES = 8 * HTB, NXCD = 8, WGM = 8;

__host__ __device__ __forceinline__ int lds_byte(int r, int c) { const int st = (r >> 4) * 2 + (c >> 5), rr = r & 15, cc = c & 31, ob = rr * 64 + cc * 2; return st * 1024 + (ob ^ (((ob >> 9) & 1) << 5)); }
__host__ __device__ __forceinline__ void stage_rc(int b, int& R, int& C) { const int st = b / 1024, sb = b % 1024, swz = sb ^ (((sb >> 9) & 1) << 5); R = (st >> 1) * 16 + swz / 64; C = (st & 1) * 32 + (swz % 64) / 2; }
__host__ __device__ __forceinline__ int perm32(int rho) { const int n = rho >> 4, i = rho & 15; return 8 * (i >> 2) + 4 * n + (i & 3); }

struct Unit { int pm, pn, be; };
struct Gemm { const bf16_t* A; const bf16_t* Bt; int M, N, K; size_t bstride; int lda, ldb; };

struct StaticOrder {
    int nM, nN, nwg, G, c;
    __host__ __device__ void init(int M, int N, int G_, int c_) { nM = M / BM; nN = N / BM; nwg = nM * nN; G = G_; c = c_; }
    __host__ __device__ bool next(int i, Unit& u) const {
        const long L = (long)i * G + c; if (L >= nwg) return false;
        int wgid = (int)L; { const int q = nwg / NXCD, r = nwg % NXCD, xcd = wgid % NXCD, off = wgid / NXCD; wgid = (xcd < r ? xcd * (q + 1) : r * (q + 1) + (xcd - r) * q) + off; }
        const int nig = WGM * nN, gid = wgid / nig, fm = gid * WGM, gsz = (nM - fm) < WGM ? (nM - fm) : WGM;
        u.pm = fm + ((wgid % nig) % gsz); u.pn = (wgid % nig) / gsz; u.be = 0; return true;
    }
    __device__ __forceinline__ void a_ready(const Unit&) const {}
    __device__ __forceinline__ void done(const Unit&) const {}
};
struct PoolOrder {
    int G, c;
    __device__ __forceinline__ bool next(int i, Unit& u) const { const int L = i * G + c; if (L >= 64) return false; u.pm = L; u.pn = 0; u.be = L >> 3; return true; }
    __device__ __forceinline__ void a_ready(const Unit&) const {}
    __device__ __forceinline__ void done(const Unit&) const {}
};
struct MoeOrder {
    int nM, nN, nwg, G, c; int pe[8];
    __device__ __forceinline__ void init(const unsigned* cnt, int nN_, int G_, int c_) {
        int p = 0;
#pragma unroll
        for (int e = 0; e < 8; ++e) { p += (int)((__hip_atomic_load(cnt + e, __ATOMIC_RELAXED, __HIP_MEMORY_SCOPE_AGENT) + 255u) >> 8); pe[e] = p; }
        nM = p; nN = nN_; nwg = nM * nN; G = G_; c = c_;
    }
    __device__ __forceinline__ bool next(int i, Unit& u) const {
        const long L = (long)i * G + c; if (L >= nwg) return false;
        int wgid = (int)L; { const int q = nwg / NXCD, r = nwg % NXCD, xcd = wgid % NXCD, off = wgid / NXCD; wgid = (xcd < r ? xcd * (q + 1) : r * (q + 1) + (xcd - r) * q) + off; }
        const int nig = WGM * nN, gid = wgid / nig, fm = gid * WGM, gsz = (nM - fm) < WGM ? (nM - fm) : WGM;
        u.pm = fm + ((wgid % nig) % gsz); u.pn = (wgid % nig) / gsz;
        int be = 0;
#pragma unroll
        for (int e = 0; e < 7; ++e) be += (u.pm >= pe[e]) ? 1 : 0;
        u.be = be; return true;
    }
    __device__ __forceinline__ void a_ready(const Unit&) const {}
    __device__ __forceinline__ void done(const Unit&) const {}
};

__device__ __forceinline__ unsigned cvt_pk_bf16(float lo, float hi) { unsigned r; asm volatile("v_cvt_pk_bf16_f32 %0, %1, %2" : "=v"(r) : "v"(lo), "v"(hi)); return r; }
__device__ __forceinline__ float bf_lo(unsigned w) { return __uint_as_float(w << 16); }
__device__ __forceinline__ float bf_hi(unsigned w) { return __uint_as_float(w & 0xffff0000u); }
__device__ __forceinline__ float fsigmoid(float x) { return __builtin_amdgcn_rcpf(1.0f + __expf(-x)); }
__device__ __forceinline__ float fsilu(float x) { return x * __builtin_amdgcn_rcpf(1.0f + __expf(-x)); }
__device__ __forceinline__ float flogsig(float x) { return fminf(x, 0.0f) - __logf(1.0f + __expf(-fabsf(x))); }

constexpr int ZP_ = 11264;
struct EpiZ {
    static constexpr bool PERM = true, AFTER_DRAIN = false;
    bf16_t* Zb;
    __device__ __forceinline__ void operator()(const f32x4 (&acc)[2][2][4][2], const Unit& u, int wr, int wc, int fr, int fq) const {
        const int row0 = u.pm * BM + wr * 64 + fr; const int pn = u.pn;
        const int mode = (pn >= 16 && pn < 24) ? 1 : (pn >= 28 ? 2 : 0);
        const int col0 = pn * BM + wc * 32 + 8 * fq;
#pragma unroll
        for (int ai = 0; ai < 2; ++ai)
#pragma unroll
            for (int m = 0; m < 4; ++m) { bf16_t* rowp = Zb + (size_t)(row0 + ai * HALF + m * 16) * ZP_ + col0;
#pragma unroll
                for (int bj = 0; bj < 2; ++bj) { f32x4 v0 = acc[ai][bj][m][0], v1 = acc[ai][bj][m][1];
                    if (mode == 1) {
#pragma unroll
                        for (int j = 0; j < 4; ++j) { v0[j] = fsilu(v0[j]); v1[j] = fsilu(v1[j]); } }
                    else if (mode == 2) {
#pragma unroll
                        for (int j = 0; j < 4; ++j) { v0[j] = fsigmoid(v0[j]); v1[j] = fsigmoid(v1[j]); } }
                    u32x4 w; w.x = cvt_pk_bf16(v0[0], v0[1]); w.y = cvt_pk_bf16(v0[2], v0[3]); w.z = cvt_pk_bf16(v1[0], v1[1]); w.w = cvt_pk_bf16(v1[2], v1[3]);
                    *(u32x4*)(rowp + bj * HALF) = w; } }
    }
};
template <bool ACCUM> struct EpiGate {
    static constexpr bool PERM = true, AFTER_DRAIN = false;
    bf16_t* U; int ldu; const bf16_t* G; int ldg;
    __device__ __forceinline__ void operator()(const f32x4 (&acc)[2][2][4][2], const Unit& u, int wr, int wc, int fr, int fq) const {
        const int row0 = u.pm * BM + wr * 64 + fr, col0 = u.pn * BM + wc * 32 + 8 * fq;
#pragma unroll
        for (int ai = 0; ai < 2; ++ai)
#pragma unroll
            for (int m = 0; m < 4; ++m) { const size_t r = (size_t)(row0 + ai * HALF + m * 16); bf16_t* up = U + r * ldu + col0; const bf16_t* gp = G + r * ldg + col0;
#pragma unroll
                for (int bj = 0; bj < 2; ++bj) { const u32x4 gw = *(const u32x4*)(gp + bj * HALF); f32x4 v0 = acc[ai][bj][m][0], v1 = acc[ai][bj][m][1];
                    v0[0] *= bf_lo(gw.x); v0[1] *= bf_hi(gw.x); v0[2] *= bf_lo(gw.y); v0[3] *= bf_hi(gw.y); v1[0] *= bf_lo(gw.z); v1[1] *= bf_hi(gw.z); v1[2] *= bf_lo(gw.w); v1[3] *= bf_hi(gw.w);
                    if (ACCUM) { const u32x4 ow = *(const u32x4*)(up + bj * HALF);
                        v0[0] += bf_lo(ow.x); v0[1] += bf_hi(ow.x); v0[2] += bf_lo(ow.y); v0[3] += bf_hi(ow.y); v1[0] += bf_lo(ow.z); v1[1] += bf_hi(ow.z); v1[2] += bf_lo(ow.w); v1[3] += bf_hi(ow.w); }
                    u32x4 w; w.x = cvt_pk_bf16(v0[0], v0[1]); w.y = cvt_pk_bf16(v0[2], v0[3]); w.z = cvt_pk_bf16(v1[0], v1[1]); w.w = cvt_pk_bf16(v1[2], v1[3]);
                    *(u32x4*)(up + bj * HALF) = w; } }
    }
};
struct EpiRes {
    static constexpr bool PERM = false, AFTER_DRAIN = false;
    const float* base; float* out; int ldc;
    __device__ __forceinline__ void operator()(const f32x4 (&acc)[2][2][4][2], const Unit& u, int wr, int wc, int fr, int fq) const {
        const int row0 = u.pm * BM + wr * 64 + fr, col0 = u.pn * BM + wc * 32 + 4 * fq;
#pragma unroll
        for (int ai = 0; ai < 2; ++ai)
#pragma unroll
            for (int m = 0; m < 4; ++m) { const size_t off = (size_t)(row0 + ai * HALF + m * 16) * ldc + col0;
#pragma unroll
                for (int bj = 0; bj < 2; ++bj)
#pragma unroll
                    for (int n = 0; n < 2; ++n) { const f32x4 bs = *(const f32x4*)(base + off + bj * HALF + n * 16); *(f32x4*)(out + off + bj * HALF + n * 16) = bs + acc[ai][bj][m][n]; } }
    }
};
struct EpiSwiGLU {
    static constexpr bool PERM = true, AFTER_DRAIN = false;
    bf16_t* Hm; int ldh;
    __device__ __forceinline__ void operator()(const f32x4 (&acc)[2][2][4][2], const Unit& u, int wr, int wc, int fr, int fq) const {
        const int row0 = u.pm * BM + wr * 64 + fr, colh = u.pn * HALF + wc * 32 + 8 * fq;
#pragma unroll
        for (int ai = 0; ai < 2; ++ai)
#pragma unroll
            for (int m = 0; m < 4; ++m) { bf16_t* rowp = Hm + (size_t)(row0 + ai * HALF + m * 16) * ldh + colh;
                const f32x4 g0 = acc[ai][0][m][0], g1 = acc[ai][0][m][1], u0 = acc[ai][1][m][0], u1 = acc[ai][1][m][1];
                u32x4 w; w.x = cvt_pk_bf16(fsilu(g0[0]) * u0[0], fsilu(g0[1]) * u0[1]); w.y = cvt_pk_bf16(fsilu(g0[2]) * u0[2], fsilu(g0[3]) * u0[3]);
                w.z = cvt_pk_bf16(fsilu(g1[0]) * u1[0], fsilu(g1[1]) * u1[1]); w.w = cvt_pk_bf16(fsilu(g1[2]) * u1[2], fsilu(g1[3]) * u1[3]);
                *(u32x4*)rowp = w; }
    }
};
struct EpiBf16 {
    static constexpr bool PERM = true, AFTER_DRAIN = false;
    bf16_t* O; int ldc;
    __device__ __forceinline__ void operator()(const f32x4 (&acc)[2][2][4][2], const Unit& u, int wr, int wc, int fr, int fq) const {
        const int row0 = u.pm * BM + wr * 64 + fr, col0 = u.pn * BM + wc * 32 + 8 * fq;
#pragma unroll
        for (int ai = 0; ai < 2; ++ai)
#pragma unroll
            for (int m = 0; m < 4; ++m) { bf16_t* rowp = O + (size_t)(row0 + ai * HALF + m * 16) * ldc + col0;
#pragma unroll
                for (int bj = 0; bj < 2; ++bj) { const f32x4 v0 = acc[ai][bj][m][0], v1 = acc[ai][bj][m][1];
                    u32x4 w; w.x = cvt_pk_bf16(v0[0], v0[1]); w.y = cvt_pk_bf16(v0[2], v0[3]); w.z = cvt_pk_bf16(v1[0], v1[1]); w.w = cvt_pk_bf16(v1[2], v1[3]);
                    *(u32x4*)(rowp + bj * HALF) = w; } }
    }
};

typedef int i32x8 __attribute__((ext_vector_type(8)));
typedef int i32x4 __attribute__((ext_vector_type(4)));
constexpr int FP8_WSCALE = 127 - 6;
__device__ __forceinline__ i32x8 pg8_cat(const bf16x8& a, const bf16x8& b) { return __builtin_shufflevector(__builtin_bit_cast(i32x4, a), __builtin_bit_cast(i32x4, b), 0, 1, 2, 3, 4, 5, 6, 7); }
__device__ __forceinline__ unsigned pk4_fp8(float a, float b, float c, float d) { int w = __builtin_amdgcn_cvt_pk_fp8_f32(a, b, 0, false); w = __builtin_amdgcn_cvt_pk_fp8_f32(c, d, w, true); return (unsigned)w; }
struct EpiSwiGLU8 {
    static constexpr bool PERM = true, AFTER_DRAIN = false;
    unsigned char* Hm; int ldh;
    __device__ __forceinline__ void operator()(const f32x4 (&acc)[2][2][4][2], const Unit& u, int wr, int wc, int fr, int fq) const {
        const int row0 = u.pm * BM + wr * 64 + fr, colh = u.pn * HALF + wc * 32 + 8 * fq;
#pragma unroll
        for (int ai = 0; ai < 2; ++ai)
#pragma unroll
            for (int m = 0; m < 4; ++m) { unsigned char* rowp = Hm + (size_t)(row0 + ai * HALF + m * 16) * ldh + colh;
                const f32x4 g0 = acc[ai][0][m][0], g1 = acc[ai][0][m][1], u0 = acc[ai][1][m][0], u1 = acc[ai][1][m][1];
                u32x2 w; w.x = pk4_fp8(fsilu(g0[0]) * u0[0], fsilu(g0[1]) * u0[1], fsilu(g0[2]) * u0[2], fsilu(g0[3]) * u0[3]);
                w.y = pk4_fp8(fsilu(g1[0]) * u1[0], fsilu(g1[1]) * u1[1], fsilu(g1[2]) * u1[2], fsilu(g1[3]) * u1[3]);
                *(u32x2*)rowp = w; }
    }
};

struct EpiPoolW {
    static constexpr bool PERM = true, AFTER_DRAIN = false;
    bf16_t* O;
    __device__ __forceinline__ void operator()(const f32x4 (&acc)[2][2][4][2], const Unit& u, int wr, int wc, int fr, int fq) const {
        const int l = u.pm >> 5, g = (u.pm >> 3) & 3, np = u.pm & 7;
        const int row0 = np * BM + wr * 64 + fr, col0 = 2048 + 256 * g + wc * 32 + 8 * fq;
        bf16_t* base = O + (size_t)l * 2048 * 3072;
#pragma unroll
        for (int ai = 0; ai < 2; ++ai)
#pragma unroll
            for (int m = 0; m < 4; ++m) { bf16_t* rowp = base + (size_t)(row0 + ai * HALF + m * 16) * 3072 + col0;
#pragma unroll
                for (int bj = 0; bj < 2; ++bj) { const f32x4 v0 = acc[ai][bj][m][0], v1 = acc[ai][bj][m][1];
                    u32x4 w; w.x = cvt_pk_bf16(v0[0], v0[1]); w.y = cvt_pk_bf16(v0[2], v0[3]); w.z = cvt_pk_bf16(v1[0], v1[1]); w.w = cvt_pk_bf16(v1[2], v1[3]);
                    *(u32x4*)(rowp + bj * HALF) = w; } }
    }
};

template <class Epi, class Sched, bool ALIGN_EPI = false, bool SP2 = false, bool FP8 = false>
__device__ __forceinline__ void gemm_phase(PG8_LAS unsigned char* lds, const Gemm g, const Sched& S, const Epi& E) {
    int tid_ = threadIdx.x; asm volatile("" : "+v"(tid_));
    const int tid = tid_, wid = __builtin_amdgcn_readfirstlane(tid >> 6), lane = tid & 63, wr = wid >> 2, wc = wid & 3, fr = lane & 15, fq = lane >> 4;
    const int K = g.K, nt = K / BK;
    unsigned voffA[2], voffB[2];
#pragma unroll
    for (int i = 0; i < 2; ++i) { int R, C; stage_rc(tid * 16 + i * 8192, R, C); const int Rb = Epi::PERM ? ((R & ~31) + perm32(R & 31)) : R;
        voffA[i] = (unsigned)(R * g.lda + C) * 2u; voffB[i] = (unsigned)(Rb * g.ldb + C) * 2u; }
    const size_t kstep = (size_t)(BK * 2);
    const size_t hstepA = (size_t)HALF * g.lda * 2, hstepB = (size_t)HALF * g.ldb * 2;
    const size_t tstepA = 2 * hstepA, tstepB = 2 * hstepB;
    const unsigned ldsw = (unsigned)wid * 1024u;
    const int aoff = lds_byte(wr * 64 + fr, fq * 8), boff = lds_byte(wc * 32 + fr, fq * 8);
#define PG8_SA(b, h) (((b) * 2 + (h)) * HTB)
#define PG8_SB(b, h) ((4 + (b) * 2 + (h)) * HTB)
#define PG8_STAGE(bufoff, gbase, voff) do { _Pragma("unroll") for (int _i = 0; _i < 2; ++_i) \
        __builtin_amdgcn_global_load_lds((const unsigned*)((const char*)(gbase) + (voff)[_i]), (PG8_LAS unsigned*)(lds + (bufoff) + ldsw + _i * 8192), 16, 0, 0); } while (0)
#define PG8_LDA(dst, b, h) do { if constexpr (FP8) { _Pragma("unroll") for (int m = 0; m < 4; ++m) { dst##8[m].lo = *(const PG8_LAS i32x4*)(lds + PG8_SA(b, h) + aoff + m * 2048); dst##8[m].hi = *(const PG8_LAS i32x4*)(lds + PG8_SA(b, h) + aoff + m * 2048 + 1024); } } \
        else { _Pragma("unroll") for (int m = 0; m < 4; ++m) _Pragma("unroll") for (int k = 0; k < 2; ++k) dst[m][k] = *(const PG8_LAS bf16x8*)(lds + PG8_SA(b, h) + aoff + m * 2048 + k * 1024); } } while (0)
#define PG8_LDB(dst, b, h) do { if constexpr (FP8) { _Pragma("unroll") for (int n = 0; n < 2; ++n) { dst##8[n].lo = *(const PG8_LAS i32x4*)(lds + PG8_SB(b, h) + boff + n * 2048); dst##8[n].hi = *(const PG8_LAS i32x4*)(lds + PG8_SB(b, h) + boff + n * 2048 + 1024); } } \
        else { _Pragma("unroll") for (int n = 0; n < 2; ++n) _Pragma("unroll") for (int k = 0; k < 2; ++k) dst[n][k] = *(const PG8_LAS bf16x8*)(lds + PG8_SB(b, h) + boff + n * 2048 + k * 1024); } } while (0)
#define PG8_MMA(ai, bj, At, Bt) do { __builtin_amdgcn_s_setprio(1); \
        if constexpr (FP8) { _Pragma("unroll") for (int m = 0; m < 4; ++m) _Pragma("unroll") for (int n = 0; n < 2; ++n) \
            asm volatile("v_mfma_scale_f32_16x16x128_f8f6f4 %0, %1, %2, %0, %3, %4 op_sel_hi:[0,0,0]" : "+v"(acc[ai][bj][m][n]) : "v"(Bt##8[n]), "v"(At##8[m]), "v"(fp8_sw), "v"(fp8_sa)); } \
        else { _Pragma("unroll") for (int m = 0; m < 4; ++m) _Pragma("unroll") for (int n = 0; n < 2; ++n) _Pragma("unroll") for (int k = 0; k < 2; ++k) \
            acc[ai][bj][m][n] = __builtin_amdgcn_mfma_f32_16x16x32_bf16(Bt[n][k], At[m][k], acc[ai][bj][m][n], 0, 0, 0); } \
        __builtin_amdgcn_s_setprio(0); } while (0)
#define PG8_WAIT_V(n) asm volatile("s_waitcnt vmcnt(" #n ")" ::: "memory")
#define PG8_WAIT_L(n) asm volatile("s_waitcnt lgkmcnt(" #n ")" ::: "memory")
#define PG8_BAR __builtin_amdgcn_s_barrier()
#define PG8_SCHED __builtin_amdgcn_sched_barrier(0)
    Unit cur, nxt; int ui = 0;
    if (!S.next(0, cur)) return;
    f32x4 acc[2][2][4][2];
#pragma unroll
    for (int a = 0; a < 2; ++a)
#pragma unroll
        for (int b = 0; b < 2; ++b)
#pragma unroll
            for (int m = 0; m < 4; ++m)
#pragma unroll
                for (int n = 0; n < 2; ++n) acc[a][b][m][n] = (f32x4){0.f, 0.f, 0.f, 0.f};
    bf16x8 At[4][2], B0[2][2], B1[2][2]; i32x8 At8[4], B08[2], B18[2]; const int fp8_sw = FP8_WSCALE, fp8_sa = 127;
    const char* cA = (const char*)g.A + (size_t)cur.pm * tstepA; const char* cB = (const char*)g.Bt + (size_t)cur.be * g.bstride + (size_t)cur.pn * tstepB;
    S.a_ready(cur);
    if constexpr (SP2) {
        PG8_STAGE(PG8_SB(0, 0), cB, voffB); PG8_STAGE(PG8_SB(0, 1), cB + hstepB, voffB); PG8_STAGE(PG8_SA(0, 0), cA, voffA); PG8_STAGE(PG8_SA(0, 1), cA + hstepA, voffA);
        if (wr == 1) PG8_BAR;
        PG8_WAIT_V(2); PG8_BAR;
        PG8_STAGE(PG8_SB(1, 0), cB + kstep, voffB); PG8_STAGE(PG8_SA(1, 0), cA + kstep, voffA); PG8_STAGE(PG8_SB(1, 1), cB + hstepB + kstep, voffB);
        PG8_WAIT_V(6); PG8_BAR;
    } else {
        PG8_STAGE(PG8_SB(0, 0), cB, voffB); PG8_STAGE(PG8_SA(0, 0), cA, voffA); PG8_STAGE(PG8_SB(0, 1), cB + hstepB, voffB); PG8_STAGE(PG8_SA(0, 1), cA + hstepA, voffA);
        if (wr == 1) PG8_BAR;
        PG8_WAIT_V(4); PG8_BAR;
        PG8_STAGE(PG8_SB(1, 0), cB + kstep, voffB); PG8_STAGE(PG8_SA(1, 0), cA + kstep, voffA); PG8_STAGE(PG8_SB(1, 1), cB + hstepB + kstep, voffB);
        PG8_WAIT_V(6); PG8_BAR;
    }
    for (;;) {
        const bool has_next = S.next(ui + 1, nxt);
        const char* nA = has_next ? (const char*)g.A + (size_t)nxt.pm * tstepA : cA; const char* nB = has_next ? (const char*)g.Bt + (size_t)nxt.be * g.bstride + (size_t)nxt.pn * tstepB : cB;
        for (int t = 0; t < nt; t += 2) {
            const bool last = (t == nt - 2);
            const char* a1 = cA + (size_t)(t + 1) * kstep;
            const char* a2 = last ? nA : cA + (size_t)(t + 2) * kstep; const char* b2 = last ? nB : cB + (size_t)(t + 2) * kstep;
            const char* a3 = a2 + kstep; const char* b3 = b2 + kstep;
            if (last && has_next) S.a_ready(nxt);
            if constexpr (SP2) {
            PG8_LDB(B0, 0, 0); PG8_LDB(B1, 0, 1); PG8_SCHED; PG8_LDA(At, 0, 0); PG8_STAGE(PG8_SA(1, 1), a1 + hstepA, voffA);
            PG8_WAIT_V(8); PG8_WAIT_L(0); PG8_BAR; PG8_MMA(0, 0, At, B0); PG8_MMA(0, 1, At, B1); PG8_BAR; PG8_SCHED;
            PG8_LDA(At, 0, 1); PG8_STAGE(PG8_SB(0, 0), b2, voffB); PG8_STAGE(PG8_SB(0, 1), b2 + hstepB, voffB); PG8_STAGE(PG8_SA(0, 0), a2, voffA);
            PG8_WAIT_V(8); PG8_WAIT_L(0); PG8_BAR; PG8_MMA(1, 0, At, B0); PG8_MMA(1, 1, At, B1); PG8_BAR; PG8_SCHED;
            PG8_LDB(B0, 1, 0); PG8_LDB(B1, 1, 1); PG8_SCHED; PG8_LDA(At, 1, 0); PG8_STAGE(PG8_SA(0, 1), a2 + hstepA, voffA);
            PG8_WAIT_V(8); PG8_WAIT_L(0); PG8_BAR; PG8_MMA(0, 0, At, B0); PG8_MMA(0, 1, At, B1); PG8_BAR; PG8_SCHED;
            PG8_LDA(At, 1, 1); PG8_STAGE(PG8_SB(1, 0), b3, voffB); PG8_STAGE(PG8_SB(1, 1), b3 + hstepB, voffB); PG8_STAGE(PG8_SA(1, 0), a3, voffA);
            PG8_WAIT_V(8); PG8_WAIT_L(0); PG8_BAR; PG8_MMA(1, 0, At, B0); PG8_MMA(1, 1, At, B1); PG8_BAR; PG8_SCHED;
            } else {
            PG8_LDB(B0, 0, 0); PG8_SCHED; PG8_LDA(At, 0, 0); PG8_STAGE(PG8_SA(1, 1), a1 + hstepA, voffA);
            PG8_WAIT_L(8); PG8_BAR; PG8_WAIT_L(0); PG8_MMA(0, 0, At, B0); PG8_BAR; PG8_SCHED;
            PG8_LDB(B1, 0, 1); PG8_STAGE(PG8_SB(0, 0), b2, voffB);
            PG8_BAR; PG8_WAIT_L(0); PG8_MMA(0, 1, At, B1); PG8_BAR;
            PG8_LDA(At, 0, 1); PG8_STAGE(PG8_SA(0, 0), a2, voffA);
            PG8_BAR; PG8_WAIT_L(0); PG8_MMA(1, 0, At, B0); PG8_BAR; PG8_SCHED;
            PG8_STAGE(PG8_SB(0, 1), b2 + hstepB, voffB);
            PG8_WAIT_V(6); PG8_BAR; PG8_MMA(1, 1, At, B1); PG8_BAR;
            PG8_LDB(B0, 1, 0); PG8_SCHED; PG8_LDA(At, 1, 0); PG8_STAGE(PG8_SA(0, 1), a2 + hstepA, voffA);
            PG8_WAIT_L(8); PG8_BAR; PG8_WAIT_L(0); PG8_MMA(0, 0, At, B0); PG8_BAR; PG8_SCHED;
            PG8_LDB(B1, 1, 1); PG8_STAGE(PG8_SB(1, 0), b3, voffB);
            PG8_BAR; PG8_WAIT_L(0); PG8_MMA(0, 1, At, B1); PG8_BAR;
            PG8_LDA(At, 1, 1); PG8_STAGE(PG8_SA(1, 0), a3, voffA);
            PG8_BAR; PG8_WAIT_L(0); PG8_MMA(1, 0, At, B0); PG8_BAR; PG8_SCHED;
            PG8_STAGE(PG8_SB(1, 1), b3 + hstepB, voffB);
            PG8_WAIT_V(6); PG8_BAR; PG8_MMA(1, 1, At, B1); PG8_BAR;
            }
        }
        if constexpr (FP8) asm volatile("s_nop 15\n\ts_nop 15" ::: "memory");
        if constexpr (ALIGN_EPI) { if (wr == 0) PG8_BAR; }
        if constexpr (!Epi::AFTER_DRAIN) { E(acc, cur, wr, wc, fr, fq); S.done(cur); }
        if (!has_next) break;
#pragma unroll
        for (int a = 0; a < 2; ++a)
#pragma unroll
            for (int b = 0; b < 2; ++b)
#pragma unroll
                for (int m = 0; m < 4; ++m)
#pragma unroll
                    for (int n = 0; n < 2; ++n) acc[a][b][m][n] = (f32x4){0.f, 0.f, 0.f, 0.f};
        cur = nxt; cA = nA; cB = nB; ++ui;
        if constexpr (ALIGN_EPI) { if (wr == 1) PG8_BAR; }
    }
    PG8_WAIT_V(0);
    if constexpr (!ALIGN_EPI) { if (wr == 0) PG8_BAR; }
    PG8_BAR;
    if constexpr (Epi::AFTER_DRAIN) { E.fused(acc, cur, wr, wc, fr, fq, lds, wid, lane); S.done(cur); }
#undef PG8_SA
#undef PG8_SB
#undef PG8_STAGE
#undef PG8_LDA
#undef PG8_LDB
#undef PG8_MMA
#undef PG8_WAIT_V
#undef PG8_WAIT_L
#undef PG8_BAR
#undef PG8_SCHED
}
}

constexpr int NWAVES = 8;
constexpr int BATCH = 2, SEQ = 8192, M = BATCH * SEQ, D = 2048, NH = 4, HK = 256, HV = 512, PW = 1024, DFF = 5632, NE = 8, DIN = 11280;
constexpr int ZN = 12288;
constexpr int ZP = 11264;
constexpr int ZC_Q = 0, ZC_K = 1024, ZC_V = 2048, ZC_R = 4096, ZC_P = 6144, ZC_GA = 7168, ZC_GB = 9216;
constexpr int KCAT = 3072;
constexpr int FFN = 2 * DFF;
constexpr int MAXSLOT = 2 * M + NE * 256;
constexpr float EPS = 1e-6f;
static_assert(pg8::ZP_ == ZP, "pitch");

constexpr size_t MiB = 1u << 20;
constexpr size_t WS_CTL = 0, CTL_ZERO_BYTES = 65536;
constexpr size_t WS_TOKSLOT = 1 * MiB, WS_WSLOT = 1 * MiB + 256 * 1024, WS_TOKE = 2 * MiB, WS_TOKW = 2 * MiB + 256 * 1024;
constexpr size_t WS_WIN = 4 * MiB, WS_BCAT = 100 * MiB, WS_WOUT = 124 * MiB, WS_FF1 = 140 * MiB, WS_FF2 = 184 * MiB, WS_EF1 = 206 * MiB, WS_EF2 = 558 * MiB;
constexpr size_t WS_HB = 734 * MiB, WS_ZB = 798 * MiB, WS_LA = 1172 * MiB, WS_OF = 1236 * MiB, WS_ACAT = 1364 * MiB, WS_U = 1460 * MiB, WS_END = 1524 * MiB;
constexpr size_t WS_HMID = WS_ZB, WS_HPERM = WS_ACAT;
static_assert(WS_WIN + 2 * (size_t)ZN * D * 2 <= WS_BCAT && WS_BCAT + 2 * (size_t)D * KCAT * 2 <= WS_WOUT && WS_WOUT + 2 * (size_t)D * D * 2 <= WS_FF1, "ws map 1");
static_assert(WS_FF1 + (size_t)FFN * D * 2 <= WS_FF2 && WS_FF2 + (size_t)D * DFF * 2 <= WS_EF1 && WS_EF1 + 8 * (size_t)FFN * D * 2 <= WS_EF2 && WS_EF2 + 8 * (size_t)D * DFF * 2 <= WS_HB, "ws map 2");
static_assert(WS_HB + (size_t)M * D * 2 <= WS_ZB && WS_ZB + (size_t)M * ZP * 2 <= WS_LA && WS_HMID + (size_t)MAXSLOT * DFF * 2 <= WS_LA && WS_LA + (size_t)M * 1024 * 4 <= WS_OF, "ws map 3");
static_assert(WS_OF + (size_t)M * D * 4 <= WS_ACAT && WS_ACAT + (size_t)M * KCAT * 2 <= WS_U && WS_U + (size_t)M * D * 2 <= WS_END && WS_HPERM + (size_t)MAXSLOT * D * 2 <= WS_END, "ws map 4");
static_assert((size_t)MAXSLOT * 4 <= 256 * 1024 && (size_t)M * 2 * 4 <= 256 * 1024, "ctl tables");
constexpr int CW_TMO = 0, CW_CODE = 1, CW_BAR = 4096, CW_CNT = 8192, CW_FILL = 8256;

constexpr int RING_OFF = 0, RING_BYTES = 131072;
constexpr int LDSCTL_OFF = RING_BYTES, MISC_OFF = LDSCTL_OFF + 320;
constexpr int LDS_BYTES = 147456;

#define GAS __attribute__((address_space(1)))
#define LAS __attribute__((address_space(3)))
typedef unsigned short bf16;
typedef unsigned v4u __attribute__((ext_vector_type(4)));
typedef unsigned v2u __attribute__((ext_vector_type(2)));
typedef float f32x4 __attribute__((ext_vector_type(4)));
typedef GAS unsigned gu32;
#define RLX_AGENT __ATOMIC_RELAXED, __HIP_MEMORY_SCOPE_AGENT
#define LDS_WAIT() asm volatile("s_waitcnt lgkmcnt(0)" ::: "memory")
#define VM_WAIT() asm volatile("s_waitcnt vmcnt(0)" ::: "memory")
__device__ __forceinline__ unsigned f2bf(float f) { unsigned u = __builtin_bit_cast(unsigned, f); return (u + 0x7fffu + ((u >> 16) & 1u)) >> 16; }
__device__ __forceinline__ unsigned pk2(float lo, float hi) { return f2bf(lo) | (f2bf(hi) << 16); }
__device__ __forceinline__ float bfl(unsigned w) { return __uint_as_float(w << 16); }
__device__ __forceinline__ float bfh(unsigned w) { return __uint_as_float(w & 0xffff0000u); }
__device__ __forceinline__ float wave_sum(float v) {
#pragma unroll
    for (int o = 1; o < 64; o <<= 1) v += __shfl_xor(v, o);
    return v;
}
typedef __bf16 gl_bf2 __attribute__((ext_vector_type(2)));
typedef float gl_f2 __attribute__((ext_vector_type(2)));
__device__ __forceinline__ unsigned pkbf(float lo, float hi) { gl_f2 v = {lo, hi}; return __builtin_bit_cast(unsigned, __builtin_convertvector(v, gl_bf2)); }
__device__ __forceinline__ int opq(int x) { asm volatile("" : "+v"(x)); return x; }
#define XB_TMO      128
#define XB_XCNT(j)  (256  + 64 * (j))
#define XB_XSUB(j)  (1280 + 64 * (j))
#define XB_XGEN(j)  (2304 + 64 * (j))
#define XB_TOP      3328
#define XB_TOPGEN   3392
#define XCD_BAR_WORDS 3456
#define XB_SPIN_CAP (1u << 18)

__device__ __forceinline__ unsigned xb_ld(unsigned* p)              { return __hip_atomic_load(p, __ATOMIC_RELAXED, __HIP_MEMORY_SCOPE_AGENT); }
__device__ __forceinline__ unsigned xb_add(unsigned* p, unsigned v) { return __hip_atomic_fetch_add(p, v, __ATOMIC_RELAXED, __HIP_MEMORY_SCOPE_AGENT); }
__device__ __forceinline__ unsigned xb_xcc_id() { return (unsigned)__builtin_amdgcn_s_getreg((3 << 11) | 20) & 0xFu; }
#define XB_SPIN(cond, bar) do { unsigned _sp = 0; while (cond) { __builtin_amdgcn_s_sleep(1); \
    if ((++_sp & 255u) == 0u) { if (xb_ld(&(bar)[XB_TMO])) break; if (_sp > XB_SPIN_CAP) { atomicAdd(&(bar)[XB_TMO], 1u); break; } } } } while (0)

struct XcdBarrier {
    unsigned* bar; unsigned x;
    volatile LAS unsigned* st;
};

__device__ __forceinline__ XcdBarrier xcd_barrier_post(unsigned* bar, volatile LAS unsigned* st) {
    XcdBarrier b; b.bar = bar; b.x = xb_xcc_id(); b.st = st;
    if (threadIdx.x == 0) (void)xb_add(&bar[XB_XCNT(b.x)], 1u);
    return b;
}
__device__ __forceinline__ void xcd_barrier_complete(unsigned* bar, unsigned x, unsigned& nloc, unsigned& nx) {
    const unsigned G = gridDim.x * gridDim.y * gridDim.z;
    unsigned sum, cnt, mine, sp = 0u;
    for (;;) {
        sum = 0u; cnt = 0u; mine = 0u;
#pragma unroll
        for (unsigned j = 0; j < 16; ++j) { const unsigned c = xb_ld(&bar[XB_XCNT(j)]); sum += c; cnt += (c > 0u) ? 1u : 0u; mine = (j == x) ? c : mine; }
        if (sum == G) break;
        __builtin_amdgcn_s_sleep(1);
        if ((++sp & 255u) == 0u) { if (xb_ld(&bar[XB_TMO])) break; if (sp > XB_SPIN_CAP) { atomicAdd(&bar[XB_TMO], 1u); break; } }
    }
    nloc = mine > 0u ? mine : 1u; nx = cnt > 0u ? cnt : 1u;
}

__device__ __forceinline__ void xcd_barrier(const XcdBarrier& b) {
    asm volatile("s_waitcnt vmcnt(0)" ::: "memory");
    __syncthreads();
    if (threadIdx.x == 0) {
        unsigned* bar = b.bar;
        __builtin_amdgcn_s_waitcnt(0);
        unsigned nloc = b.st[0], nx = b.st[1];
        if (nloc == 0u) { xcd_barrier_complete(bar, b.x, nloc, nx); b.st[0] = nloc; b.st[1] = nx; }
        const unsigned old = xb_add(&bar[XB_XSUB(b.x)], 1u);
        const unsigned gen = old / nloc;
        if (old + 1u == (gen + 1u) * nloc) {
            __builtin_amdgcn_fence(__ATOMIC_RELEASE, "agent");
            asm volatile("s_waitcnt vmcnt(0)" ::: "memory");
            const unsigned og = xb_add(&bar[XB_TOP], 1u);
            const unsigned tg = og / nx;
            if (og + 1u == (tg + 1u) * nx) xb_add(&bar[XB_TOPGEN], 1u);
            else XB_SPIN(xb_ld(&bar[XB_TOPGEN]) == tg, bar);
            __builtin_amdgcn_fence(__ATOMIC_ACQUIRE, "agent");
            xb_add(&bar[XB_XGEN(b.x)], 1u);
            asm volatile("s_waitcnt vmcnt(0)" ::: "memory");
        } else {
            XB_SPIN(xb_ld(&bar[XB_XGEN(b.x)]) == gen, bar);
            __builtin_amdgcn_fence(__ATOMIC_ACQUIRE, "agent");
            asm volatile("s_waitcnt vmcnt(0)" ::: "memory");
        }
    }
    __syncthreads();
}

struct TrJob { const float* src; unsigned char* dst; int ldw, ldt, k0, n0, mode, row_off, kind; };
__device__ __forceinline__ int tr_drow(int nn, int mode, int row_off) { return mode ? (256 * (nn >> 7) + (nn & 127) + row_off) : (row_off + nn); }
__device__ __forceinline__ void tr_load(const TrJob& J, f32x4 (&R)[16], int lane) {
    if (J.kind == 0) { const int nq = lane & 15, kr = lane >> 4; const float* b = J.src + (size_t)(4 * kr) * J.ldw + 4 * nq;
#pragma unroll
        for (int jq = 0; jq < 4; ++jq)
#pragma unroll
            for (int x = 0; x < 4; ++x) R[4 * jq + x] = __builtin_nontemporal_load((const GAS f32x4*)(b + (size_t)(16 * jq + x) * J.ldw));
    } else { const int nq = lane & 7, kr = lane >> 3; const float* b = J.src + (size_t)(4 * kr) * J.ldw + 4 * nq;
#pragma unroll
        for (int jq = 0; jq < 4; ++jq)
#pragma unroll
            for (int x = 0; x < 4; ++x) R[4 * jq + x] = __builtin_nontemporal_load((const GAS f32x4*)(b + (size_t)(32 * jq + x) * J.ldw)); }
}
__device__ __forceinline__ void tr_finish(const TrJob& J, const f32x4 (&R)[16], LAS unsigned* T, int lane, int nostore) {
    if (J.kind == 0) { const int nq = lane & 15, kr = lane >> 4;
#pragma unroll
        for (int jq = 0; jq < 4; ++jq)
#pragma unroll
            for (int i = 0; i < 4; ++i) { T[(4 * nq + i) * 33 + 8 * jq + 2 * kr] = pkbf(R[4 * jq][i], R[4 * jq + 1][i]); T[(4 * nq + i) * 33 + 8 * jq + 2 * kr + 1] = pkbf(R[4 * jq + 2][i], R[4 * jq + 3][i]); }
        LDS_WAIT(); asm volatile("" ::: "memory");
#pragma unroll
        for (int r = 0; r < 8; ++r) { const int t = lane + 64 * r, n = t >> 3, c = t & 7; const LAS unsigned* s = T + n * 33 + 4 * c;
            v4u o; o.x = s[0]; o.y = s[1]; o.z = s[2]; o.w = s[3];
            if (!nostore || o.x == 0x12345678u) *(GAS v4u*)(J.dst + (size_t)tr_drow(J.n0 + n, J.mode, J.row_off) * J.ldt + 2 * J.k0 + 16 * c) = o; }
    } else { const int nq = lane & 7, kr = lane >> 3;
#pragma unroll
        for (int jq = 0; jq < 4; ++jq)
#pragma unroll
            for (int i = 0; i < 4; ++i) T[(4 * nq + i) * 33 + 8 * jq + kr] = pg8::pk4_fp8(R[4 * jq][i] * 64.0f, R[4 * jq + 1][i] * 64.0f, R[4 * jq + 2][i] * 64.0f, R[4 * jq + 3][i] * 64.0f);
        LDS_WAIT(); asm volatile("" ::: "memory");
#pragma unroll
        for (int r = 0; r < 4; ++r) { const int t = lane + 64 * r, n = t >> 3, c = t & 7; const LAS unsigned* s = T + n * 33 + 4 * c;
            v4u o; o.x = s[0]; o.y = s[1]; o.z = s[2]; o.w = s[3];
            if (!nostore || o.x == 0x12345678u) *(GAS v4u*)(J.dst + (size_t)tr_drow(J.n0 + n, J.mode, J.row_off) * J.ldt + J.k0 + 16 * c) = o; } }
    LDS_WAIT(); asm volatile("" ::: "memory");
}

template <bool ROUTE>
__device__ __forceinline__ void norm_rows(const float* X, const float* gain, bf16* out, int gw, int NGW, int lane0,
                                          const LAS float* rw, int* tok_e, float* tok_w, LAS unsigned* hist) {
    const int lane = opq(lane0);
    f32x4 nx[8];
    if (gw < M) { const GAS f32x4* xr = (const GAS f32x4*)(X + (size_t)gw * D) + lane;
#pragma unroll
        for (int j = 0; j < 8; ++j) nx[j] = xr[64 * j]; }
    for (int m = gw; m < M; m += NGW) {
        f32x4 v[8]; float s = 0.f;
#pragma unroll
        for (int j = 0; j < 8; ++j) { v[j] = nx[j]; s += (v[j].x * v[j].x + v[j].y * v[j].y) + (v[j].z * v[j].z + v[j].w * v[j].w); }
        if (m + NGW < M) { const GAS f32x4* xr = (const GAS f32x4*)(X + (size_t)(m + NGW) * D) + lane;
#pragma unroll
            for (int j = 0; j < 8; ++j) nx[j] = xr[64 * j]; }
        const float rstd = 1.0f / sqrtf(wave_sum(s) * (1.0f / D) + EPS);
        GAS unsigned long long* o8 = (GAS unsigned long long*)(out + (size_t)m * D) + lane;
#pragma unroll
        for (int j = 0; j < 8; ++j) { const f32x4 g4 = ((const GAS f32x4*)gain)[lane + 64 * j]; v[j] = v[j] * rstd * g4;
            o8[64 * j] = (unsigned long long)pk2(v[j].x, v[j].y) | ((unsigned long long)pk2(v[j].z, v[j].w) << 32); }
        if (ROUTE) {
            float lg[8];
#pragma unroll
            for (int e = 0; e < 8; ++e) lg[e] = 0.f;
#pragma unroll
            for (int j = 0; j < 8; ++j)
#pragma unroll
                for (int i = 0; i < 4; ++i) { const int k = 4 * (lane + 64 * j) + i; const f32x4 r0 = *(const LAS f32x4*)(rw + k * 8), r1 = *(const LAS f32x4*)(rw + k * 8 + 4); const float hv = v[j][i];
                    lg[0] += hv * r0.x; lg[1] += hv * r0.y; lg[2] += hv * r0.z; lg[3] += hv * r0.w; lg[4] += hv * r1.x; lg[5] += hv * r1.y; lg[6] += hv * r1.z; lg[7] += hv * r1.w; }
#pragma unroll
            for (int e = 0; e < 8; ++e) lg[e] = wave_sum(lg[e]);
            float v1 = lg[0]; int i1 = 0;
#pragma unroll
            for (int e = 1; e < 8; ++e) if (lg[e] > v1) { v1 = lg[e]; i1 = e; }
            float v2 = -3.0e38f; int i2 = 0;
#pragma unroll
            for (int e = 0; e < 8; ++e) if (e != i1 && lg[e] > v2) { v2 = lg[e]; i2 = e; }
            const float ex = __expf(v2 - v1), w1 = 1.0f / (1.0f + ex), w2 = ex * w1;
            if (lane == 0) { tok_e[2 * m] = i1; tok_e[2 * m + 1] = i2; tok_w[2 * m] = w1; tok_w[2 * m + 1] = w2;
                __hip_atomic_fetch_add(hist + i1, 1u, __ATOMIC_RELAXED, __HIP_MEMORY_SCOPE_WORKGROUP); __hip_atomic_fetch_add(hist + i2, 1u, __ATOMIC_RELAXED, __HIP_MEMORY_SCOPE_WORKGROUP); }
        }
    }
}


typedef short gl_bf16x8 __attribute__((ext_vector_type(8)));
typedef short gl_s16x4 __attribute__((ext_vector_type(4)));
__device__ __forceinline__ unsigned off_q(unsigned row, unsigned ch) { return 512u * row + 16u * (ch ^ (row & 15u)); }
__device__ __forceinline__ unsigned off_a(unsigned row, unsigned ch) { return 128u * row + 16u * (ch ^ (row & 7u)); }
__device__ __forceinline__ unsigned off_b(unsigned row, unsigned ch) { return 256u * row + 16u * (ch ^ (((row & 3u) << 2) | ((row >> 2) & 3u))); }
__device__ __forceinline__ gl_bf16x8 tr_frag(unsigned base, unsigned lane, unsigned c) {
    const unsigned g = lane >> 4, q = (lane & 15u) >> 2, p = lane & 3u;
    const unsigned a0 = base + off_b(8u * g + q, 2u * c + (p >> 1)) + 8u * (p & 1u), a1 = base + off_b(8u * g + 4u + q, 2u * c + (p >> 1)) + 8u * (p & 1u);
    const gl_s16x4 lo = __builtin_amdgcn_ds_read_tr16_b64_v4i16((LAS gl_s16x4*)a0), hi = __builtin_amdgcn_ds_read_tr16_b64_v4i16((LAS gl_s16x4*)a1);
    return __builtin_shufflevector(lo, hi, 0, 1, 2, 3, 4, 5, 6, 7);
}
#define GLA_MFMA(a, b, c) __builtin_amdgcn_mfma_f32_16x16x32_bf16((a), (b), (c), 0, 0, 0)
constexpr int GLA_NSEG = 8, GLA_CPS = 16;
constexpr int GL_QT = 0, GL_KE = 32768, GL_V = 65536, GL_ATT = 81920, GL_DEC = 90112;

__device__ __forceinline__ void gla_g0(LAS unsigned char* lds, bf16* Zb, const bf16* Hb, const bf16* WA1T, const float* w_alpha, const float* b_alpha, bf16* ATT, float* DEC, int bx, int G, int tid0, int lane0, int wave) {
    const int tid = opq(tid0), lane = tid & 63; (void)lane0;
    LAS float* sB = (LAS float*)lds; LAS unsigned char* sQ = lds + 65536; LAS unsigned char* sK = lds + 98304;
    LAS float* sP = (LAS float*)(lds + 65536);
    LAS float* sA1 = (LAS float*)(lds + 131072 + 1024);
    const unsigned li = lane & 15, g = lane >> 4;
    for (int uc = bx; uc < 256; uc += G) {
        const int b = uc >> 7, c = uc & 127; const size_t row0 = (size_t)b * SEQ + (size_t)c * 64;
        __syncthreads();
        { f32x4 pa[4];
#pragma unroll
            for (int mt = 0; mt < 4; ++mt) pa[mt] = (f32x4){0.f, 0.f, 0.f, 0.f};
#pragma unroll
            for (int s2 = 0; s2 < 4; ++s2) { gl_bf16x8 bf[2], af[2][4];
#pragma unroll
                for (int ss = 0; ss < 2; ++ss) { const int s = 8 * wave + 2 * s2 + ss; bf[ss] = *(const GAS gl_bf16x8*)(WA1T + (size_t)li * D + 32 * s + 8 * g);
#pragma unroll
                    for (int mt = 0; mt < 4; ++mt) af[ss][mt] = *(const GAS gl_bf16x8*)(Hb + (row0 + 16 * mt + li) * D + 32 * s + 8 * g); }
#pragma unroll
                for (int ss = 0; ss < 2; ++ss)
#pragma unroll
                    for (int mt = 0; mt < 4; ++mt) pa[mt] = GLA_MFMA(af[ss][mt], bf[ss], pa[mt]); }
#pragma unroll
            for (int mt = 0; mt < 4; ++mt)
#pragma unroll
                for (int j = 0; j < 4; ++j) sP[(wave * 64 + 16 * mt + 4 * g + j) * 16 + li] = pa[mt][j]; }
        __syncthreads();
#pragma unroll
        for (int e2 = 0; e2 < 2; ++e2) { const int e = tid + 512 * e2; float s = 0.f;
#pragma unroll
            for (int w = 0; w < 8; ++w) s += sP[w * 1024 + e];
            sA1[e] = s; }
        for (int h = 0; h < 4; ++h) {
        const int u = (b << 9) | (c << 2) | h;
        __syncthreads();
        v4u q8r[4], k8r[4];
#pragma unroll
        for (int i = 0; i < 4; ++i) { const int n = tid + 512 * i, r = n >> 5, ch = n & 31;
            q8r[i] = *(const GAS v4u*)(Zb + (row0 + r) * ZP + ZC_Q + h * 256 + 8 * ch); k8r[i] = *(const GAS v4u*)(Zb + (row0 + r) * ZP + ZC_K + h * 256 + 8 * ch); }
        {
            const int d = tid & 255, hf = tid >> 8; float wa[16];
#pragma unroll
            for (int r = 0; r < 16; ++r) wa[r] = w_alpha[r * 1024 + h * 256 + d];
            const float ba = b_alpha[h * 256 + d];
            float vv[32];
#pragma unroll
            for (int t = 0; t < 32; ++t) { const LAS f32x4* ap = (const LAS f32x4*)(sA1 + (32 * hf + t) * 16); const f32x4 a0 = ap[0], a1 = ap[1], a2 = ap[2], a3 = ap[3];
                float s = ba + (a0.x * wa[0] + a0.y * wa[1]) + (a0.z * wa[2] + a0.w * wa[3]) + (a1.x * wa[4] + a1.y * wa[5]) + (a1.z * wa[6] + a1.w * wa[7])
                             + (a2.x * wa[8] + a2.y * wa[9]) + (a2.z * wa[10] + a2.w * wa[11]) + (a3.x * wa[12] + a3.y * wa[13]) + (a3.z * wa[14] + a3.w * wa[15]);
                vv[t] = pg8::flogsig(s) * 0.0625f; }
#pragma unroll
            for (int t = 1; t < 32; ++t) vv[t] += vv[t - 1];
            LAS float* tot = (LAS float*)(lds + 65536);
            if (hf == 0) tot[d] = vv[31];
            __syncthreads();
            const float add = hf ? tot[d] : 0.f;
#pragma unroll
            for (int t = 0; t < 32; ++t) sB[(32 * hf + t) * 256 + d] = vv[t] + add;
        }
        __syncthreads();
#pragma unroll
        for (int i = 0; i < 4; ++i) { const int n = tid + 512 * i, r = n >> 5, ch = n & 31;
            bf16* qp = Zb + (row0 + r) * ZP + ZC_Q + h * 256; bf16* kp = Zb + (row0 + r) * ZP + ZC_K + h * 256;
            const v4u q8 = q8r[i], k8 = k8r[i];
            const f32x4 b0 = *(const LAS f32x4*)(sB + r * 256 + 8 * ch), b1 = *(const LAS f32x4*)(sB + r * 256 + 8 * ch + 4);
            const f32x4 l0 = *(const LAS f32x4*)(sB + 63 * 256 + 8 * ch), l1 = *(const LAS f32x4*)(sB + 63 * 256 + 8 * ch + 4);
            const float qv[8] = {bfl(q8.x), bfh(q8.x), bfl(q8.y), bfh(q8.y), bfl(q8.z), bfh(q8.z), bfl(q8.w), bfh(q8.w)};
            const float kv[8] = {bfl(k8.x), bfh(k8.x), bfl(k8.y), bfh(k8.y), bfl(k8.z), bfh(k8.z), bfl(k8.w), bfh(k8.w)};
            const float bb[8] = {b0.x, b0.y, b0.z, b0.w, b1.x, b1.y, b1.z, b1.w}; const float bl[8] = {l0.x, l0.y, l0.z, l0.w, l1.x, l1.y, l1.z, l1.w};
            float qt[8], kt[8], ke[8];
#pragma unroll
            for (int e = 0; e < 8; ++e) { qt[e] = qv[e] * __expf(bb[e]) * 0.0625f; kt[e] = kv[e] * __expf(-bb[e]); ke[e] = kv[e] * __expf(bl[e] - bb[e]); }
            v4u qw, kw, ew; qw.x = pkbf(qt[0], qt[1]); qw.y = pkbf(qt[2], qt[3]); qw.z = pkbf(qt[4], qt[5]); qw.w = pkbf(qt[6], qt[7]);
            kw.x = pkbf(kt[0], kt[1]); kw.y = pkbf(kt[2], kt[3]); kw.z = pkbf(kt[4], kt[5]); kw.w = pkbf(kt[6], kt[7]);
            ew.x = pkbf(ke[0], ke[1]); ew.y = pkbf(ke[2], ke[3]); ew.z = pkbf(ke[4], ke[5]); ew.w = pkbf(ke[6], ke[7]);
            *(LAS v4u*)(sQ + off_q(r, ch)) = qw; *(LAS v4u*)(sK + off_q(r, ch)) = kw;
            *(GAS v4u*)(kp + 8 * ch) = ew;
            const int p0 = 32 * (ch >> 2) + 16 * (ch & 1) + 4 * ((ch >> 1) & 1);
            v2u w0, w1; w0.x = qw.x; w0.y = qw.y; w1.x = qw.z; w1.y = qw.w;
            *(GAS v2u*)(qp + p0) = w0; *(GAS v2u*)(qp + p0 + 8) = w1; }
        if (tid < 256) DEC[((size_t)b * 128 + c) * 1024 + h * 256 + tid] = __expf(sB[63 * 256 + tid]);
        __syncthreads();
#pragma unroll
        for (int tt = 0; tt < 2; ++tt) { const int T = 2 * wave + tt, jt = T >> 2, it = T & 3;
            f32x4 acc = {0.f, 0.f, 0.f, 0.f};
            if (jt <= it) {
#pragma unroll
                for (int s = 0; s < 8; ++s) { const gl_bf16x8 a = *(const LAS gl_bf16x8*)(sK + off_q(16 * jt + li, 4 * s + g)), bq = *(const LAS gl_bf16x8*)(sQ + off_q(16 * it + li, 4 * s + g));
                    acc = GLA_MFMA(a, bq, acc); } }
            const int i = 16 * it + (int)li, j0 = 16 * jt + 4 * (int)g;
            v2u w; w.x = pkbf(j0 + 0 <= i ? acc[0] : 0.f, j0 + 1 <= i ? acc[1] : 0.f); w.y = pkbf(j0 + 2 <= i ? acc[2] : 0.f, j0 + 3 <= i ? acc[3] : 0.f);
            *(GAS v2u*)(ATT + (size_t)u * 4096 + i * 64 + j0) = w; }
        }
    }
}

struct GlaRegs { v4u k[4], q[4], v[2], a; f32x4 d; };
template <bool WITH_Q>
__device__ __forceinline__ void gla_issue(GlaRegs& R, const bf16* Zb, const bf16* ATT, const float* DEC, int b, int c, int h, int sl, int tid) {
    const size_t row0 = (size_t)b * SEQ + (size_t)c * 64;
#pragma unroll
    for (int i = 0; i < 4; ++i) { const int n = tid + 512 * i, r = n >> 5, ch = n & 31;
        R.k[i] = *(const GAS v4u*)(Zb + (row0 + r) * ZP + ZC_K + h * 256 + 8 * ch);
        if (WITH_Q) R.q[i] = *(const GAS v4u*)(Zb + (row0 + r) * ZP + ZC_Q + h * 256 + 8 * ch); }
#pragma unroll
    for (int i = 0; i < 2; ++i) { const int n = tid + 512 * i, r = n >> 4, ch = n & 15; R.v[i] = *(const GAS v4u*)(Zb + (row0 + r) * ZP + ZC_V + h * 512 + sl * 128 + 8 * ch); }
    if (WITH_Q) { const int r = tid >> 3, ch = tid & 7; const unsigned u = ((unsigned)b << 9) | ((unsigned)c << 2) | (unsigned)h; R.a = *(const GAS v4u*)(ATT + (size_t)u * 4096 + r * 64 + 8 * ch); }
    if (tid < 64) R.d = *(const GAS f32x4*)(DEC + ((size_t)b * 128 + c) * 1024 + h * 256 + 4 * tid);
}
template <bool WITH_Q>
__device__ __forceinline__ void gla_commit(const GlaRegs& R, LAS unsigned char* lds, int tid) {
#pragma unroll
    for (int i = 0; i < 4; ++i) { const int n = tid + 512 * i, r = n >> 5, ch = n & 31;
        *(LAS v4u*)(lds + GL_KE + ((r >> 5) * 2 + (ch >> 4)) * 8192 + off_b(r & 31, ch & 15)) = R.k[i];
        if (WITH_Q) *(LAS v4u*)(lds + GL_QT + off_q(r, ch)) = R.q[i]; }
#pragma unroll
    for (int i = 0; i < 2; ++i) { const int n = tid + 512 * i, r = n >> 4, ch = n & 15; *(LAS v4u*)(lds + GL_V + (r >> 5) * 8192 + off_b(r & 31, ch)) = R.v[i]; }
    if (WITH_Q) { const int r = tid >> 3, ch = tid & 7; *(LAS v4u*)(lds + GL_ATT + off_a(r, ch)) = R.a; }
    if (tid < 64) ((LAS f32x4*)(lds + GL_DEC))[tid] = R.d;
}
__device__ __forceinline__ void gla_update(LAS unsigned char* lds, f32x4 (&S)[16], const gl_bf16x8 (&vf)[2], unsigned lane, unsigned g) {
    const unsigned lbase = (unsigned)(size_t)lds;
#pragma unroll
    for (int i2 = 0; i2 < 8; ++i2) {
        f32x4 d4[2]; gl_bf16x8 kf[2][2];
#pragma unroll
        for (int ii = 0; ii < 2; ++ii) { const int i = 2 * i2 + ii; d4[ii] = *(const LAS f32x4*)(lds + GL_DEC + 4 * (16 * i + 4 * g));
            kf[ii][0] = tr_frag(lbase + GL_KE + (0 * 2 + (i >> 3)) * 8192, lane, i & 7); kf[ii][1] = tr_frag(lbase + GL_KE + (1 * 2 + (i >> 3)) * 8192, lane, i & 7); }
        __builtin_amdgcn_sched_barrier(0);
#pragma unroll
        for (int ii = 0; ii < 2; ++ii) { const int i = 2 * i2 + ii; S[i] = S[i] * d4[ii]; S[i] = GLA_MFMA(kf[ii][0], vf[0], S[i]); S[i] = GLA_MFMA(kf[ii][1], vf[1], S[i]); }
        __builtin_amdgcn_sched_barrier(0);
    }
}

__device__ __forceinline__ void gla_g1(LAS unsigned char* lds, const bf16* Zb, const float* DEC, float* SL, float* DSEG, int bx, int G, int tid0, int lane0, int wave) {
    const int tid = opq(tid0), lane = tid & 63; (void)lane0;
    const unsigned li = lane & 15, g = lane >> 4; const unsigned lbase = (unsigned)(size_t)lds;
    for (int un = bx; un < 256; un += G) {
        const int seg = un & 7, bh = un >> 5, sl = (un >> 3) & 3, b = bh >> 2, h = bh & 3;
        if (seg == 7) continue;
        f32x4 S[16];
#pragma unroll
        for (int i = 0; i < 16; ++i) S[i] = (f32x4){0.f, 0.f, 0.f, 0.f};
        float dprod = 1.0f;
        GlaRegs R; gla_issue<false>(R, Zb, nullptr, DEC, b, seg * GLA_CPS, h, sl, tid);
        for (int cc = 0; cc < GLA_CPS; ++cc) {
            __syncthreads();
            gla_commit<false>(R, lds, tid);
            __syncthreads();
            if (cc + 1 < GLA_CPS) gla_issue<false>(R, Zb, nullptr, DEC, b, seg * GLA_CPS + cc + 1, h, sl, tid);
            if (tid < 256) dprod *= ((LAS float*)(lds + GL_DEC))[tid];
            unsigned lv = (unsigned)lane; asm volatile("" : "+v"(lv));
            gl_bf16x8 vf[2]; vf[0] = tr_frag(lbase + GL_V, lv, wave); vf[1] = tr_frag(lbase + GL_V + 8192, lv, wave);
            gla_update(lds, S, vf, lv, lv >> 4);
        }
        float* pp = SL + ((size_t)(bh * 7 + seg) * 256 + 4 * g) * 512 + sl * 128 + 16 * wave + li;
#pragma unroll
        for (int i = 0; i < 16; ++i) { asm volatile("" : "+v"(pp));
#pragma unroll
            for (int r = 0; r < 4; ++r) pp[r * 512] = S[i][r];
            pp += 16 * 512; }
        if (sl == 0 && tid < 256) DSEG[(bh * 7 + seg) * 256 + tid] = dprod;
    }
}
__device__ __forceinline__ void gla_g2(float* SL, const float* DSEG, int gtid, int NT) {
    for (int it = gtid; it < 8 * 256 * 128; it += NT) { const int bh = it >> 15, dk = (it >> 7) & 255, d4 = it & 127;
        f32x4 s = {0.f, 0.f, 0.f, 0.f};
        for (int seg = 0; seg < 7; ++seg) { GAS f32x4* p = (GAS f32x4*)(SL + ((size_t)(bh * 7 + seg) * 256 + dk) * 512) + d4; const float d = DSEG[(bh * 7 + seg) * 256 + dk];
            s = s * d + *p; *p = s; } }
}
__device__ __forceinline__ void gla_g3_chunk(LAS unsigned char* lds, f32x4 (&S)[16], GlaRegs& R, const bf16* Zb, const bf16* ATT, const float* DEC, float* OF,
                                             int b, int c, int h, int sl, int c_next, bool refill, bool do_update, int tid, int lane, int wave) {
    const unsigned lbase = (unsigned)(size_t)lds;
    __syncthreads();
    gla_commit<true>(R, lds, tid);
    __syncthreads();
    if (refill) gla_issue<true>(R, Zb, ATT, DEC, b, c_next, h, sl, tid);
    unsigned lv = (unsigned)lane; asm volatile("" : "+v"(lv));
    const unsigned li = lv & 15, g = lv >> 4;
    gl_bf16x8 vf[2]; vf[0] = tr_frag(lbase + GL_V, lv, wave); vf[1] = tr_frag(lbase + GL_V + 8192, lv, wave);
    f32x4 o[4];
#pragma unroll
    for (int nt = 0; nt < 4; ++nt) o[nt] = (f32x4){0.f, 0.f, 0.f, 0.f};
#pragma unroll
    for (int s = 0; s < 8; ++s) {
        gl_bf16x8 qf[4];
#pragma unroll
        for (int nt = 0; nt < 4; ++nt) qf[nt] = *(const LAS gl_bf16x8*)(lds + GL_QT + off_q(16 * nt + li, 4 * s + g));
        v4u aw; aw.x = pkbf(S[2 * s][0], S[2 * s][1]); aw.y = pkbf(S[2 * s][2], S[2 * s][3]); aw.z = pkbf(S[2 * s + 1][0], S[2 * s + 1][1]); aw.w = pkbf(S[2 * s + 1][2], S[2 * s + 1][3]);
        const gl_bf16x8 af = __builtin_bit_cast(gl_bf16x8, aw);
        __builtin_amdgcn_sched_barrier(0);
#pragma unroll
        for (int nt = 0; nt < 4; ++nt) o[nt] = GLA_MFMA(af, qf[nt], o[nt]);
        __builtin_amdgcn_sched_barrier(0);
    }
    { gl_bf16x8 tf[6];
#pragma unroll
        for (int nt = 0; nt < 4; ++nt) tf[nt] = *(const LAS gl_bf16x8*)(lds + GL_ATT + off_a(16 * nt + li, g));
#pragma unroll
        for (int nt = 2; nt < 4; ++nt) tf[2 + nt] = *(const LAS gl_bf16x8*)(lds + GL_ATT + off_a(16 * nt + li, 4 + g));
        __builtin_amdgcn_sched_barrier(0);
#pragma unroll
        for (int nt = 0; nt < 4; ++nt) o[nt] = GLA_MFMA(vf[0], tf[nt], o[nt]);
#pragma unroll
        for (int nt = 2; nt < 4; ++nt) o[nt] = GLA_MFMA(vf[1], tf[2 + nt], o[nt]);
        __builtin_amdgcn_sched_barrier(0); }
    bf16* op = (bf16*)OF + ((size_t)b * SEQ + (size_t)c * 64 + li) * D + h * 512 + sl * 128 + 16 * wave + 4 * g;
#pragma unroll
    for (int nt = 0; nt < 4; ++nt) { v2u w; w.x = pkbf(o[nt][0], o[nt][1]); w.y = pkbf(o[nt][2], o[nt][3]); *(GAS v2u*)(op + (size_t)(16 * nt) * D) = w; }
    if (do_update) gla_update(lds, S, vf, lv, g);
}
__device__ __forceinline__ void gla_g3(LAS unsigned char* lds, const bf16* Zb, const bf16* ATT, const float* DEC, const float* SL, float* OF, int bx, int G, int tid0, int lane0, int wave) {
    const int tid = opq(tid0), lane = tid & 63; (void)lane0;
    const unsigned li = lane & 15, g = lane >> 4;
    for (int un = bx; un < 256; un += G) {
        const int seg = un & 7, bh = un >> 5, sl = (un >> 3) & 3, b = bh >> 2, h = bh & 3;
        f32x4 S[16];
        if (seg == 0) {
#pragma unroll
            for (int i = 0; i < 16; ++i) S[i] = (f32x4){0.f, 0.f, 0.f, 0.f};
        } else { const float* pp = SL + ((size_t)(bh * 7 + seg - 1) * 256 + 4 * g) * 512 + sl * 128 + 16 * wave + li;
#pragma unroll
            for (int i = 0; i < 16; ++i) { asm volatile("" : "+v"(pp));
#pragma unroll
                for (int r = 0; r < 4; ++r) S[i][r] = pp[r * 512];
                pp += 16 * 512; } }
        const int c0 = seg * GLA_CPS;
        GlaRegs RA; gla_issue<true>(RA, Zb, ATT, DEC, b, c0, h, sl, tid);
        for (int cc = 0; cc < GLA_CPS; ++cc)
            gla_g3_chunk(lds, S, RA, Zb, ATT, DEC, OF, b, c0 + cc, h, sl, c0 + cc + 1, cc + 1 < GLA_CPS, cc + 1 < GLA_CPS, tid, lane, wave);
    }
}

struct Args { const float* in[20]; float* out; unsigned char* ws; int ph_lo, ph_hi, li, pad; };
constexpr int PH_PER_LAYER = 12, N_PHASES = 2 + 2 * PH_PER_LAYER;

#define IN(k) (lo <= (k) && (k) < hi)
#define SEAM(k) do { if (IN(k) && IN((k) + 1)) xcd_barrier(bar); } while (0)
template <int l> __device__ __forceinline__ void layer_phases(const Args& args, LAS unsigned char* lds, const XcdBarrier& bar, const int lo, const int hi,
                                                             const int tid, const int lane, const int wave, const int G, const int bx, const int vcu, const int gw, const int NGW) {
    unsigned char* ws = args.ws;
    gu32* ctl = (gu32*)(ws + WS_CTL);
    const float* x_in = args.in[0]; const float* ln_mix = args.in[1]; const float* w_in = args.in[2]; const float* w_alpha = args.in[3]; const float* b_alpha = args.in[4];
    const float* gla_norm = args.in[5]; const float* w_pool = args.in[6]; const float* pool_scale = args.in[7]; const float* w_bg = args.in[8]; const float* w_bp = args.in[9];
    const float* w_out = args.in[10]; const float* ln_ffn = args.in[11]; const float* ffn_g = args.in[12]; const float* ffn_u = args.in[13]; const float* ffn_d = args.in[14];
    const float* router_w = args.in[15]; const float* exp_g = args.in[16]; const float* exp_u = args.in[17]; const float* exp_d = args.in[18]; const float* ln_final = args.in[19];
    float* xo = args.out;
    bf16* WinT = (bf16*)(ws + WS_WIN); bf16* BcatT = (bf16*)(ws + WS_BCAT); bf16* WoutT = (bf16*)(ws + WS_WOUT); bf16* FF1T = (bf16*)(ws + WS_FF1); bf16* FF2T = (bf16*)(ws + WS_FF2);
    unsigned char* EF1T = ws + WS_EF1; unsigned char* EF2T = ws + WS_EF2;
    bf16* Hb = (bf16*)(ws + WS_HB); bf16* Zb = (bf16*)(ws + WS_ZB); float* LA = (float*)(ws + WS_LA); float* OF = (float*)(ws + WS_OF);
    bf16* Acat = (bf16*)(ws + WS_ACAT); bf16* Ub = (bf16*)(ws + WS_U); bf16* Hmid = (bf16*)(ws + WS_HMID); unsigned char* Hmid8 = ws + WS_HMID; unsigned char* Hperm8 = ws + WS_HPERM;
    bf16* WA1T = (bf16*)(ws + WS_CTL + 3 * MiB); bf16* WbpT = (bf16*)(ws + WS_OF); bf16* WpS = (bf16*)(ws + WS_OF + 8 * MiB);
    int* slot_of_tok = (int*)(ws + WS_TOKSLOT); int* tok_e = (int*)(ws + WS_TOKE); float* tok_w = (float*)(ws + WS_TOKW); bf16* YS = (bf16*)(ws + WS_LA);
    unsigned* cnt = (unsigned*)(ctl + CW_CNT); unsigned* fill = (unsigned*)(ctl + CW_FILL);

    constexpr int pb = 1 + PH_PER_LAYER * l;
        if (IN(pb + 0)) {
            pg8::Gemm g{Hb, WinT + (size_t)l * ZN * D, M, ZP, D, 0, D, D}; pg8::StaticOrder S; S.init(M, ZP, G, bx);
            pg8::EpiZ E{Zb};
            pg8::gemm_phase<pg8::EpiZ, pg8::StaticOrder, true, true>(lds + RING_OFF, g, S, E);
        }
        SEAM(pb + 0);
        bf16* ATT = (bf16*)(ws + WS_LA); float* DEC = (float*)(ws + WS_LA + 8 * MiB); float* DSEG = (float*)(ws + WS_LA + 10 * MiB); float* SL = (float*)(ws + WS_U);
        if (IN(pb + 1)) gla_g0(lds + RING_OFF, Zb, Hb, WA1T + (size_t)l * 16 * D, w_alpha + (size_t)l * 16 * 1024, b_alpha + l * 1024, ATT, DEC, bx, G, tid, lane, wave);
        SEAM(pb + 1);
        if (IN(pb + 2)) gla_g1(lds + RING_OFF, Zb, DEC, SL, DSEG, bx, G, tid, lane, wave);
        SEAM(pb + 2);
        if (IN(pb + 3)) {
            if (l == 0) {
                pg8::Gemm g{WbpT, WpS, 2 * 4 * 2048, 256, 256, (size_t)256 * 256 * 2, 256, 256}; pg8::PoolOrder S; S.G = G; S.c = bx;
                pg8::EpiPoolW E{BcatT};
                pg8::gemm_phase<pg8::EpiPoolW, pg8::PoolOrder, false, false>(lds + RING_OFF, g, S, E);
            }
            gla_g2(SL, DSEG, vcu * 512 + tid, G * 512);
        }
        SEAM(pb + 3);
        if (IN(pb + 4)) gla_g3(lds + RING_OFF, Zb, ATT, DEC, SL, OF, bx, G, tid, lane, wave);
        SEAM(pb + 4);
        if (IN(pb + 5)) {
            const float* gn = gla_norm + l * HV;
            for (int m = gw; m < M; m += NGW) {
                const f32x4 g0 = *(const GAS f32x4*)(gn + lane * 8), g1 = *(const GAS f32x4*)(gn + lane * 8 + 4);
#pragma unroll
                for (int h = 0; h < NH; ++h) {
                    const v4u ow = *(const GAS v4u*)((const bf16*)OF + (size_t)m * D + h * HV + lane * 8); f32x4 o0 = {bfl(ow.x), bfh(ow.x), bfl(ow.y), bfh(ow.y)}, o1 = {bfl(ow.z), bfh(ow.z), bfl(ow.w), bfh(ow.w)};
                    float s = (o0.x * o0.x + o0.y * o0.y) + (o0.z * o0.z + o0.w * o0.w) + (o1.x * o1.x + o1.y * o1.y) + (o1.z * o1.z + o1.w * o1.w);
                    const float rstd = 1.0f / sqrtf(wave_sum(s) * (1.0f / HV) + EPS);
                    const v4u rw = *(const GAS v4u*)(Zb + (size_t)m * ZP + ZC_R + h * HV + lane * 8);
                    o0 = o0 * rstd * g0; o1 = o1 * rstd * g1;
                    v4u w; w.x = pk2(o0.x * bfl(rw.x), o0.y * bfh(rw.x)); w.y = pk2(o0.z * bfl(rw.y), o0.w * bfh(rw.y)); w.z = pk2(o1.x * bfl(rw.z), o1.y * bfh(rw.z)); w.w = pk2(o1.z * bfl(rw.w), o1.w * bfh(rw.w));
                    *(GAS v4u*)(Acat + (size_t)m * KCAT + h * HV + lane * 8) = w;
                }
                const int t = m & (SEQ - 1), win = 2 << (lane >> 4), nw = (t + 1 < win) ? (t + 1) : win;
                float sm[16], p0[16];
#pragma unroll
                for (int i = 0; i < 16; ++i) { sm[i] = 0.f; p0[i] = 0.f; }
#pragma unroll
                for (int bt = 0; bt < 2; ++bt) {
                    v4u pa[8], pc[8];
#pragma unroll
                    for (int s = 0; s < 8; ++s) { const int sft = 8 * bt + s; pa[s] = (v4u){0u, 0u, 0u, 0u}; pc[s] = (v4u){0u, 0u, 0u, 0u};
                        if (sft < nw) { const GAS v4u* pp = (const GAS v4u*)(Zb + (size_t)(m - sft) * ZP + ZC_P + lane * 16); pa[s] = pp[0]; pc[s] = pp[1]; } }
#pragma unroll
                    for (int s = 0; s < 8; ++s) { const v4u a = pa[s], c = pc[s];
                        const float pv[16] = {bfl(a.x), bfh(a.x), bfl(a.y), bfh(a.y), bfl(a.z), bfh(a.z), bfl(a.w), bfh(a.w), bfl(c.x), bfh(c.x), bfl(c.y), bfh(c.y), bfl(c.z), bfh(c.z), bfl(c.w), bfh(c.w)};
#pragma unroll
                        for (int i = 0; i < 16; ++i) { sm[i] += pv[i]; if (bt == 0 && s == 0) p0[i] = pv[i]; } }
                }
                const float inv = 1.0f / (float)nw;
                v4u w0, w1;
                w0.x = pk2(sm[0] * inv - p0[0], sm[1] * inv - p0[1]); w0.y = pk2(sm[2] * inv - p0[2], sm[3] * inv - p0[3]); w0.z = pk2(sm[4] * inv - p0[4], sm[5] * inv - p0[5]); w0.w = pk2(sm[6] * inv - p0[6], sm[7] * inv - p0[7]);
                w1.x = pk2(sm[8] * inv - p0[8], sm[9] * inv - p0[9]); w1.y = pk2(sm[10] * inv - p0[10], sm[11] * inv - p0[11]); w1.z = pk2(sm[12] * inv - p0[12], sm[13] * inv - p0[13]); w1.w = pk2(sm[14] * inv - p0[14], sm[15] * inv - p0[15]);
                GAS v4u* mp = (GAS v4u*)(Acat + (size_t)m * KCAT + 2048 + lane * 16); mp[0] = w0; mp[1] = w1;
            }
        }
        SEAM(pb + 5);
        if (IN(pb + 6)) {
            pg8::Gemm g{Acat, BcatT + (size_t)l * D * KCAT, M, D, D, 0, KCAT, KCAT}; pg8::StaticOrder S; S.init(M, D, G, bx);
            pg8::EpiGate<false> E{Ub, D, Zb + ZC_GA, ZP};
            pg8::gemm_phase<pg8::EpiGate<false>, pg8::StaticOrder, true, true>(lds + RING_OFF, g, S, E);
        }
        if (IN(pb + 6)) {
            VM_WAIT(); __syncthreads();
            pg8::Gemm g{Acat + 2048, BcatT + (size_t)l * D * KCAT + 2048, M, D, 1024, 0, KCAT, KCAT}; pg8::StaticOrder S; S.init(M, D, G, bx);
            pg8::EpiGate<true> E{Ub, D, Zb + ZC_GB, ZP};
            pg8::gemm_phase<pg8::EpiGate<true>, pg8::StaticOrder, true, true>(lds + RING_OFF, g, S, E);
        }
        SEAM(pb + 6);
        if (IN(pb + 7)) {
            pg8::Gemm g{Ub, WoutT + (size_t)l * D * D, M, D, D, 0, D, D}; pg8::StaticOrder S; S.init(M, D, G, bx);
            pg8::EpiRes E{l == 0 ? x_in : (const float*)xo, xo, D};
            pg8::gemm_phase<pg8::EpiRes, pg8::StaticOrder, true, true>(lds + RING_OFF, g, S, E);
        }
        SEAM(pb + 7);
        if (IN(pb + 8)) {
            if (l == 0) norm_rows<false>(xo, ln_ffn, Hb, gw, NGW, lane, nullptr, nullptr, nullptr, nullptr);
            else {
                LAS float* rw = (LAS float*)(lds + RING_OFF); LAS unsigned* hist = (LAS unsigned*)(lds + RING_OFF + 65536);
                for (int i = tid; i < D * NE / 4; i += 512) ((LAS f32x4*)rw)[i] = ((const GAS f32x4*)router_w)[i];
                if (tid < 8) hist[tid] = 0u;
                __syncthreads();
                norm_rows<true>(xo, ln_ffn + D, Hb, gw, NGW, lane, rw, tok_e, tok_w, hist);
                __syncthreads();
                if (tid < 8) __hip_atomic_fetch_add(cnt + tid, hist[tid], RLX_AGENT);
            }
        }
        SEAM(pb + 8);
        if (l == 0) {
            if (IN(pb + 9)) {
                pg8::Gemm g{Hb, FF1T, M, FFN, D, 0, D, D}; pg8::StaticOrder S; S.init(M, FFN, G, bx);
                pg8::EpiSwiGLU E{Hmid, DFF};
                pg8::gemm_phase<pg8::EpiSwiGLU, pg8::StaticOrder, true, true>(lds + RING_OFF, g, S, E);
            }
            SEAM(pb + 9);
            if (IN(pb + 10)) {
                pg8::Gemm g{Hmid, FF2T, M, D, DFF, 0, DFF, DFF}; pg8::StaticOrder S; S.init(M, D, G, bx);
                pg8::EpiRes E{xo, args.li == 7 ? OF : xo, D};
                pg8::gemm_phase<pg8::EpiRes, pg8::StaticOrder, true, true>(lds + RING_OFF, g, S, E);
            }
            SEAM(pb + 10);
            if (IN(pb + 11)) norm_rows<false>(xo, ln_mix + D, Hb, gw, NGW, lane, nullptr, nullptr, nullptr, nullptr);
            SEAM(pb + 11);
        } else {
            if (IN(pb + 9)) {
                LAS unsigned* lcnt = (LAS unsigned*)(lds + RING_OFF); LAS unsigned* lbase = lcnt + 8; LAS int* lslot = (LAS int*)(lcnt + 16);
                int brow[8]; { int p = 0;
#pragma unroll
                    for (int e = 0; e < 8; ++e) { brow[e] = 256 * p; p += (int)((__hip_atomic_load(cnt + e, RLX_AGENT) + 255u) >> 8); } }
                for (int ch = bx; ch < M / 64; ch += G) {
                    __syncthreads();
                    if (tid < 8) lcnt[tid] = 0u;
                    __syncthreads();
                    int e = 0, tok = 0; unsigned rank = 0;
                    if (tid < 128) { tok = ch * 64 + (tid >> 1); e = tok_e[2 * tok + (tid & 1)]; rank = __hip_atomic_fetch_add(lcnt + e, 1u, __ATOMIC_RELAXED, __HIP_MEMORY_SCOPE_WORKGROUP); }
                    __syncthreads();
                    if (tid < 8) lbase[tid] = __hip_atomic_fetch_add(fill + tid, lcnt[tid], RLX_AGENT);
                    __syncthreads();
                    if (tid < 128) { int br = 0;
#pragma unroll
                        for (int q = 0; q < 8; ++q) br = (e == q) ? brow[q] : br;
                        const int slot = br + (int)lbase[e] + (int)rank; lslot[tid] = slot; slot_of_tok[2 * tok + (tid & 1)] = slot; }
                    __syncthreads();
                    for (int en = wave; en < 128; en += NWAVES) { const int tk = ch * 64 + (en >> 1), slot = lslot[en];
                        const GAS v4u* src = (const GAS v4u*)(Hb + (size_t)tk * D) + 4 * lane; GAS v4u* dst = (GAS v4u*)(Hperm8 + (size_t)slot * D) + 2 * lane;
#pragma unroll
                        for (int j = 0; j < 2; ++j) { const v4u a = src[2 * j], c = src[2 * j + 1]; v4u o;
                            o.x = pg8::pk4_fp8(bfl(a.x), bfh(a.x), bfl(a.y), bfh(a.y)); o.y = pg8::pk4_fp8(bfl(a.z), bfh(a.z), bfl(a.w), bfh(a.w));
                            o.z = pg8::pk4_fp8(bfl(c.x), bfh(c.x), bfl(c.y), bfh(c.y)); o.w = pg8::pk4_fp8(bfl(c.z), bfh(c.z), bfl(c.w), bfh(c.w)); dst[j] = o; } }
                }
            }
            SEAM(pb + 9);
            if (IN(pb + 10)) {
                pg8::Gemm g{(const bf16*)Hperm8, (const bf16*)EF1T, MAXSLOT, FFN, D / 2, (size_t)FFN * D, D / 2, D / 2}; pg8::MoeOrder S; S.init(cnt, FFN / 256, G, bx);
                pg8::EpiSwiGLU8 E{Hmid8, DFF};
                pg8::gemm_phase<pg8::EpiSwiGLU8, pg8::MoeOrder, true, true, true>(lds + RING_OFF, g, S, E);
            }
            SEAM(pb + 10);
            if (IN(pb + 11)) {
                pg8::Gemm g{(const bf16*)Hmid8, (const bf16*)EF2T, MAXSLOT, D, DFF / 2, (size_t)D * DFF, DFF / 2, DFF / 2}; pg8::MoeOrder S; S.init(cnt, D / 256, G, bx);
                pg8::EpiBf16 E{YS, D};
                pg8::gemm_phase<pg8::EpiBf16, pg8::MoeOrder, true, true, true>(lds + RING_OFF, g, S, E);
            }
            SEAM(pb + 11);
        }
}

__global__ void __launch_bounds__(NWAVES * 64, 2) fwd(Args args) {
    extern __shared__ __attribute__((aligned(16))) unsigned char lds_raw[];
    LAS unsigned char* lds = (LAS unsigned char*)lds_raw;
    volatile LAS unsigned* MISC = (volatile LAS unsigned*)(lds + MISC_OFF);
    const int tid = threadIdx.x, lane = tid & 63, wave = __builtin_amdgcn_readfirstlane(tid >> 6);
    const int G = gridDim.x, bx = blockIdx.x;
    const int vcu = (G % 8 == 0) ? (bx % 8) * (G / 8) + bx / 8 : bx;
    const int gw = vcu * NWAVES + wave, NGW = G * NWAVES;
    unsigned char* ws = args.ws;
    gu32* ctl = (gu32*)(ws + WS_CTL);
    const float* x_in = args.in[0]; const float* ln_mix = args.in[1]; const float* w_in = args.in[2]; const float* w_alpha = args.in[3]; const float* b_alpha = args.in[4];
    const float* gla_norm = args.in[5]; const float* w_pool = args.in[6]; const float* pool_scale = args.in[7]; const float* w_bg = args.in[8]; const float* w_bp = args.in[9];
    const float* w_out = args.in[10]; const float* ln_ffn = args.in[11]; const float* ffn_g = args.in[12]; const float* ffn_u = args.in[13]; const float* ffn_d = args.in[14];
    const float* router_w = args.in[15]; const float* exp_g = args.in[16]; const float* exp_u = args.in[17]; const float* exp_d = args.in[18]; const float* ln_final = args.in[19];
    float* xo = args.out;
    bf16* WinT = (bf16*)(ws + WS_WIN); bf16* BcatT = (bf16*)(ws + WS_BCAT); bf16* WoutT = (bf16*)(ws + WS_WOUT); bf16* FF1T = (bf16*)(ws + WS_FF1); bf16* FF2T = (bf16*)(ws + WS_FF2);
    unsigned char* EF1T = ws + WS_EF1; unsigned char* EF2T = ws + WS_EF2;
    bf16* Hb = (bf16*)(ws + WS_HB); bf16* Zb = (bf16*)(ws + WS_ZB); float* LA = (float*)(ws + WS_LA); float* OF = (float*)(ws + WS_OF);
    bf16* Acat = (bf16*)(ws + WS_ACAT); bf16* Ub = (bf16*)(ws + WS_U); bf16* Hmid = (bf16*)(ws + WS_HMID); unsigned char* Hmid8 = ws + WS_HMID; unsigned char* Hperm8 = ws + WS_HPERM;
    bf16* WA1T = (bf16*)(ws + WS_CTL + 3 * MiB); bf16* WbpT = (bf16*)(ws + WS_OF); bf16* WpS = (bf16*)(ws + WS_OF + 8 * MiB);
    int* slot_of_tok = (int*)(ws + WS_TOKSLOT); int* tok_e = (int*)(ws + WS_TOKE); float* tok_w = (float*)(ws + WS_TOKW); bf16* YS = (bf16*)(ws + WS_LA);
    unsigned* cnt = (unsigned*)(ctl + CW_CNT); unsigned* fill = (unsigned*)(ctl + CW_FILL);

    for (int u = tid; u < (LDS_BYTES - LDSCTL_OFF) / 4; u += NWAVES * 64) ((LAS unsigned*)(lds + LDSCTL_OFF))[u] = 0u;
    __syncthreads();
    const int lo = args.ph_lo, hi = args.ph_hi;
    XcdBarrier bar; bar.bar = (unsigned*)(ctl + CW_BAR); bar.x = 0; bar.st = nullptr;
    if (hi - lo > 1) bar = xcd_barrier_post((unsigned*)(ctl + CW_BAR), MISC + 8);

    if (IN(0)) {
        LAS unsigned* Tl = (LAS unsigned*)(lds + RING_OFF + wave * 16384);
#ifdef PROBE_NOW
        const int PNW = (args.li == 7);
#else
        constexpr int PNW = 0;
#endif
        for (int i = vcu * 512 + tid; i < 2 * 16 * D; i += G * 512) { const int l = i >> 15, r = (i >> 11) & 15, k = i & 2047; WA1T[i] = (bf16)f2bf(w_in[(size_t)l * D * DIN + (size_t)k * DIN + 6144 + r]); }
        for (int i = vcu * 512 + tid; i < 2 * 4 * 256 * 256 / 4; i += G * 512) { const int d4 = i & 63, lg = i >> 14;
            const f32x4 w = ((const GAS f32x4*)w_pool)[i], s = ((const GAS f32x4*)pool_scale)[lg * 64 + d4];
            v2u o; o.x = pkbf(w.x * s.x, w.y * s.y); o.y = pkbf(w.z * s.z, w.w * s.w); ((GAS v2u*)WpS)[i] = o; }
#ifdef PROBE_NOSTORE
        const int PNS = (args.li == 7);
#else
        constexpr int PNS = 0;
#endif
        constexpr int T_LAYER = 8192, T_DENSE = 8448, T_ALL = 2 * T_LAYER + T_DENSE + 8 * T_DENSE;
        auto decode = [&](int it, TrJob& J) {
            J.mode = 0; J.row_off = 0; J.kind = 0; int kt, nt;
            if (it < 2 * T_LAYER) { const int l = it / T_LAYER, r = it % T_LAYER; const float* wi = w_in + (size_t)l * D * DIN; unsigned char* wt = (unsigned char*)(WinT + (size_t)l * ZN * D);
                if (r < 3072) { J.src = wi; J.ldw = DIN; J.dst = wt; J.ldt = 2 * D; kt = r / 96; nt = r % 96; }
                else if (r < 5632) { const int q = r - 3072; J.src = wi + 6160; J.ldw = DIN; J.dst = wt; J.ldt = 2 * D; J.row_off = 6144; kt = q / 80; nt = q % 80; }
                else if (r < 6656) { const int q = r - 5632; J.src = w_bg + (size_t)l * D * D; J.ldw = D; J.dst = (unsigned char*)(BcatT + (size_t)l * D * KCAT); J.ldt = 2 * KCAT; kt = q >> 5; nt = q & 31; }
                else if (r < 7680) { const int q = r - 6656; J.src = w_out + (size_t)l * D * D; J.ldw = D; J.dst = (unsigned char*)(WoutT + (size_t)l * D * D); J.ldt = 2 * D; kt = q >> 5; nt = q & 31; }
                else { const int q = r - 7680; kt = q >> 5; nt = q & 31;
                    J.src = w_bp + (size_t)l * 1024 * D + (size_t)(64 * kt) * D + 64 * nt; J.ldw = D; J.dst = (unsigned char*)(WbpT + ((size_t)(l * 4 + (kt >> 2)) * 2048) * 256); J.ldt = 512; J.k0 = 64 * (kt & 3); J.n0 = 64 * nt; return; }
                J.k0 = 64 * kt; J.n0 = 64 * nt;
            } else if (it < 2 * T_LAYER + T_DENSE) { const int r = it - 2 * T_LAYER, j = r / 2816, q = r % 2816;
                if (j == 0) { J.src = ffn_g; J.ldw = DFF; J.dst = (unsigned char*)FF1T; J.ldt = 2 * D; J.mode = 1; kt = q / 88; nt = q % 88; }
                else if (j == 1) { J.src = ffn_u; J.ldw = DFF; J.dst = (unsigned char*)FF1T; J.ldt = 2 * D; J.mode = 1; J.row_off = 128; kt = q / 88; nt = q % 88; }
                else { J.src = ffn_d; J.ldw = D; J.dst = (unsigned char*)FF2T; J.ldt = 2 * DFF; kt = q >> 5; nt = q & 31; }
                J.k0 = 64 * kt; J.n0 = 64 * nt;
            } else { const int r = it - 2 * T_LAYER - T_DENSE, e = r / T_DENSE, r2 = r % T_DENSE, j = r2 / 2816, q = r2 % 2816; J.kind = 1;
                if (j == 0) { J.src = exp_g + (size_t)e * D * DFF; J.ldw = DFF; J.dst = EF1T + (size_t)e * FFN * D; J.ldt = D; J.mode = 1; kt = q / 176; nt = q % 176; }
                else if (j == 1) { J.src = exp_u + (size_t)e * D * DFF; J.ldw = DFF; J.dst = EF1T + (size_t)e * FFN * D; J.ldt = D; J.mode = 1; J.row_off = 128; kt = q / 176; nt = q % 176; }
                else { J.src = exp_d + (size_t)e * DFF * D; J.ldw = D; J.dst = EF2T + (size_t)e * D * DFF; J.ldt = DFF; kt = q >> 6; nt = q & 63; }
                J.k0 = 128 * kt; J.n0 = 32 * nt;
            }
            J.src += (size_t)J.k0 * J.ldw + J.n0;
        };
        if (gw < T_ALL) {
            TrJob J, Jn; f32x4 R[16], Rn[16];
            decode(gw, J); tr_load(J, R, lane);
            for (int it = gw; it < T_ALL; it += NGW) {
                const bool more = it + NGW < T_ALL;
                if (more) { decode(it + NGW, Jn); tr_load(Jn, Rn, lane); }
                tr_finish(J, R, Tl, lane, PNS && J.kind == 1);
                if (more) { J = Jn;
#pragma unroll
                    for (int i = 0; i < 16; ++i) R[i] = Rn[i]; }
            }
        }
        norm_rows<false>(x_in, ln_mix, Hb, gw, NGW, lane, nullptr, nullptr, nullptr, nullptr);
    }
    SEAM(0);
#ifdef PROBE_XBAR
    if (hi - lo > 1) for (int i = 0; i < PROBE_XBAR; ++i) xcd_barrier(bar);
#endif

    layer_phases<0>(args, lds, bar, lo, hi, tid, lane, wave, G, bx, vcu, gw, NGW);
    layer_phases<1>(args, lds, bar, lo, hi, tid, lane, wave, G, bx, vcu, gw, NGW);
    if (IN(N_PHASES - 1)) {
        f32x4 nx[8]; v2u na[8], nc[8]; float nw1 = 0.f, nw2 = 0.f;
#define FINAL_FETCH(mm) do { const int m_ = (mm); const GAS f32x4* xr_ = (const GAS f32x4*)(xo + (size_t)m_ * D) + lane; \
            const int s1_ = slot_of_tok[2 * m_], s2_ = slot_of_tok[2 * m_ + 1]; nw1 = tok_w[2 * m_]; nw2 = tok_w[2 * m_ + 1]; \
            const GAS v2u* y1_ = (const GAS v2u*)(YS + (size_t)s1_ * D) + lane; const GAS v2u* y2_ = (const GAS v2u*)(YS + (size_t)s2_ * D) + lane; \
            _Pragma("unroll") for (int j = 0; j < 8; ++j) { nx[j] = xr_[64 * j]; na[j] = y1_[64 * j]; nc[j] = y2_[64 * j]; } } while (0)
        if (gw < M) FINAL_FETCH(gw);
        for (int m = gw; m < M; m += NGW) {
            GAS f32x4* xr = (GAS f32x4*)(xo + (size_t)m * D) + lane;
            const float w1 = nw1, w2 = nw2;
            f32x4 v[8]; float s = 0.f;
#pragma unroll
            for (int j = 0; j < 8; ++j) { const v2u a = na[j], c = nc[j]; f32x4 t = nx[j];
                t.x += w1 * bfl(a.x) + w2 * bfl(c.x); t.y += w1 * bfh(a.x) + w2 * bfh(c.x); t.z += w1 * bfl(a.y) + w2 * bfl(c.y); t.w += w1 * bfh(a.y) + w2 * bfh(c.y);
                v[j] = t; s += (t.x * t.x + t.y * t.y) + (t.z * t.z + t.w * t.w); }
            if (m + NGW < M) FINAL_FETCH(m + NGW);
            const float rstd = 1.0f / sqrtf(wave_sum(s) * (1.0f / D) + EPS);
#pragma unroll
            for (int j = 0; j < 8; ++j) { const f32x4 g4 = ((const GAS f32x4*)ln_final)[lane + 64 * j]; xr[64 * j] = v[j] * rstd * g4; }
        }
    }
#undef IN
#undef SEAM
}

#ifndef MK_ONE_LAUNCH
#define MK_ONE_LAUNCH 1
#endif
#ifndef PROBE_DUP
#define PROBE_DUP -1
#endif
#ifndef PROBE_REP
#define PROBE_REP 1
#endif
extern "C" void kernel_launch(void* const* d_in, const int* in_sizes, int n_in, void* d_out, int out_size, void* d_ws, size_t ws_size, hipStream_t stream) {
    static int grid = 0;
    if (grid == 0) {
        if (n_in != 20 || in_sizes[0] != M * D || out_size != M * D || ws_size < WS_END) { fprintf(stderr, "kernel_launch: unexpected shapes / workspace (n_in %d, in0 %d, out %d, ws %zu < %zu); nothing launched\n", n_in, n_in > 0 ? in_sizes[0] : -1, out_size, ws_size, (size_t)WS_END); grid = -1; return; }
        int dev = 0, cus = 0, per_cu = 0;
        if (hipGetDevice(&dev) != hipSuccess || hipDeviceGetAttribute(&cus, hipDeviceAttributeMultiprocessorCount, dev) != hipSuccess) { grid = -1; return; }
        if (hipFuncSetAttribute((const void*)fwd, hipFuncAttributeMaxDynamicSharedMemorySize, LDS_BYTES) != hipSuccess) { fprintf(stderr, "kernel_launch: hipFuncSetAttribute failed\n"); grid = -1; return; }
        if (hipOccupancyMaxActiveBlocksPerMultiprocessor(&per_cu, (const void*)fwd, NWAVES * 64, LDS_BYTES) != hipSuccess || per_cu < 1) { fprintf(stderr, "kernel_launch: occupancy query reports %d workgroups per CU\n", per_cu); }
        (void)hipGetLastError();
        grid = cus;
    }
    if (grid < 0) return;
    if (hipMemsetAsync((char*)d_ws + WS_CTL, 0, CTL_ZERO_BYTES, stream) != hipSuccess) return;
    Args a{};
    for (int i = 0; i < 20; ++i) a.in[i] = (const float*)d_in[i];
    a.out = (float*)d_out; a.ws = (unsigned char*)d_ws;
#if MK_ONE_LAUNCH
    a.ph_lo = 0; a.ph_hi = N_PHASES; a.li = 0;
    hipLaunchKernelGGL(fwd, dim3(grid), dim3(NWAVES * 64), LDS_BYTES, stream, a);
#else
    for (int p = 0; p < N_PHASES; ++p) { a.ph_lo = p; a.ph_hi = p + 1;
        if (p == PROBE_DUP) { a.li = 7; for (int r = 0; r < PROBE_REP; ++r) hipLaunchKernelGGL(fwd, dim3(grid), dim3(NWAVES * 64), LDS_BYTES, stream, a); }
        a.li = 0; hipLaunchKernelGGL(fwd, dim3(grid), dim3(NWAVES * 64), LDS_BYTES, stream, a); }
#endif
}
```

```cpp
#include <hip/hip_runtime.h>
#include <cstdio>
#include <cstdint>

namespace pg8 {
#define PG8_LAS __attribute__((address_space(3)))
typedef unsigned short bf16_t;
typedef short bf16x8 __attribute__((ext_vector_type(8)));
typedef float f32x4 __attribute__((ext_vector_type(4)));
typedef unsigned u32x4 __attribute__((ext_vector_type(4)));
typedef unsigned u32x2 __attribute__((ext_vector_type(2)));
constexpr int BM = 256, BK = 64, HALF = 128, HTB = HALF * BK * 2  , STAGE_BYTES = 8 * HTB, NXCD = 8, WGM = 8;

__host__ __device__ __forceinline__ int lds_byte(int r, int c) { const int st = (r >> 4) * 2 + (c >> 5), rr = r & 15, cc = c & 31, ob = rr * 64 + cc * 2; return st * 1024 + (ob ^ (((ob >> 9) & 1) << 5)); }
__host__ __device__ __forceinline__ void stage_rc(int b, int& R, int& C) { const int st = b / 1024, sb = b % 1024, swz = sb ^ (((sb >> 9) & 1) << 5); R = (st >> 1) * 16 + swz / 64; C = (st & 1) * 32 + (swz % 64) / 2; }
__host__ __device__ __forceinline__ int perm32(int rho) { const int n = rho >> 4, i = rho & 15; return 8 * (i >> 2) + 4 * n + (i & 3); }

struct Unit { int pm, pn, be; };
struct Gemm { const bf16_t* A; const bf16_t* Bt; int M, N, K; size_t bstride; int lda, ldb; };

struct StaticOrder {
    int nM, nN, nwg, G, c;
    __host__ __device__ void init(int M, int N, int G_, int c_) { nM = M / BM; nN = N / BM; nwg = nM * nN; G = G_; c = c_; }
    __host__ __device__ bool next(int i, Unit& u) const {
        const long L = (long)i * G + c; if (L >= nwg) return false;
        int wgid = (int)L; { const int q = nwg / NXCD, r = nwg % NXCD, xcd = wgid % NXCD, off = wgid / NXCD; wgid = (xcd < r ? xcd * (q + 1) : r * (q + 1) + (xcd - r) * q) + off; }
        const int nig = WGM * nN, gid = wgid / nig, fm = gid * WGM, gsz = (nM - fm) < WGM ? (nM - fm) : WGM;
        u.pm = fm + ((wgid % nig) % gsz); u.pn = (wgid % nig) / gsz; u.be = 0; return true;
    }
    __device__ __forceinline__ void a_ready(const Unit&) const {}
    __device__ __forceinline__ void done(const Unit&) const {}
};
struct PoolOrder {
    int G, c;
    __device__ __forceinline__ bool next(int i, Unit& u) const { const int L = i * G + c; if (L >= 64) return false; u.pm = L; u.pn = 0; u.be = L >> 3; return true; }
    __device__ __forceinline__ void a_ready(const Unit&) const {}
    __device__ __forceinline__ void done(const Unit&) const {}
};
struct MoeOrder {
    int nM, nN, nwg, G, c; int pe[8];
    __device__ __forceinline__ void init(const unsigned* cnt, int nN_, int G_, int c_) {
        int p = 0;
#pragma unroll
        for (int e = 0; e < 8; ++e) { p += (int)((__hip_atomic_load(cnt + e, __ATOMIC_RELAXED, __HIP_MEMORY_SCOPE_AGENT) + 255u) >> 8); pe[e] = p; }
        nM = p; nN = nN_; nwg = nM * nN; G = G_; c = c_;
    }
    __device__ __forceinline__ bool next(int i, Unit& u) const {
        const long L = (long)i * G + c; if (L >= nwg) return false;
        int wgid = (int)L; { const int q = nwg / NXCD, r = nwg % NXCD, xcd = wgid % NXCD, off = wgid / NXCD; wgid = (xcd < r ? xcd * (q + 1) : r * (q + 1) + (xcd - r) * q) + off; }
        const int nig = WGM * nN, gid = wgid / nig, fm = gid * WGM, gsz = (nM - fm) < WGM ? (nM - fm) : WGM;
        u.pm = fm + ((wgid % nig) % gsz); u.pn = (wgid % nig) / gsz;
        int be = 0;
#pragma unroll
        for (int e = 0; e < 7; ++e) be += (u.pm >= pe[e]) ? 1 : 0;
        u.be = be; return true;
    }
    __device__ __forceinline__ void a_ready(const Unit&) const {}
    __device__ __forceinline__ void done(const Unit&) const {}
};

__device__ __forceinline__ unsigned cvt_pk_bf16(float lo, float hi) { unsigned r; asm volatile("v_cvt_pk_bf16_f32 %0, %1, %2" : "=v"(r) : "v"(lo), "v"(hi)); return r; }
__device__ __forceinline__ float bf_lo(unsigned w) { return __uint_as_float(w << 16); }
__device__ __forceinline__ float bf_hi(unsigned w) { return __uint_as_float(w & 0xffff0000u); }
__device__ __forceinline__ float fsigmoid(float x) { return __builtin_amdgcn_rcpf(1.0f + __expf(-x)); }
__device__ __forceinline__ float fsilu(float x) { return x * __builtin_amdgcn_rcpf(1.0f + __expf(-x)); }
__device__ __forceinline__ float flogsig(float x) { return fminf(x, 0.0f) - __logf(1.0f + __expf(-fabsf(x))); }

constexpr int ZP_ = 11264;
struct EpiZ {
    static constexpr bool PERM = true, AFTER_DRAIN = false;
    bf16_t* Zb;
    __device__ __forceinline__ void operator()(const f32x4 (&acc)[2][2][4][2], const Unit& u, int wr, int wc, int fr, int fq) const {
        const int row0 = u.pm * BM + wr * 64 + fr; const int pn = u.pn;
        const int mode = (pn >= 16 && pn < 24) ? 1 : (pn >= 28 ? 2 : 0);
        const int col0 = pn * BM + wc * 32 + 8 * fq;
#pragma unroll
        for (int ai = 0; ai < 2; ++ai)
#pragma unroll
            for (int m = 0; m < 4; ++m) { bf16_t* rowp = Zb + (size_t)(row0 + ai * HALF + m * 16) * ZP_ + col0;
#pragma unroll
                for (int bj = 0; bj < 2; ++bj) { f32x4 v0 = acc[ai][bj][m][0], v1 = acc[ai][bj][m][1];
                    if (mode == 1) {
#pragma unroll
                        for (int j = 0; j < 4; ++j) { v0[j] = fsilu(v0[j]); v1[j] = fsilu(v1[j]); } }
                    else if (mode == 2) {
#pragma unroll
                        for (int j = 0; j < 4; ++j) { v0[j] = fsigmoid(v0[j]); v1[j] = fsigmoid(v1[j]); } }
                    u32x4 w; w.x = cvt_pk_bf16(v0[0], v0[1]); w.y = cvt_pk_bf16(v0[2], v0[3]); w.z = cvt_pk_bf16(v1[0], v1[1]); w.w = cvt_pk_bf16(v1[2], v1[3]);
                    *(u32x4*)(rowp + bj * HALF) = w; } }
    }
};
template <bool ACCUM> struct EpiGate {
    static constexpr bool PERM = true, AFTER_DRAIN = false;
    bf16_t* U; int ldu; const bf16_t* G; int ldg;
    __device__ __forceinline__ void operator()(const f32x4 (&acc)[2][2][4][2], const Unit& u, int wr, int wc, int fr, int fq) const {
        const int row0 = u.pm * BM + wr * 64 + fr, col0 = u.pn * BM + wc * 32 + 8 * fq;
#pragma unroll
        for (int ai = 0; ai < 2; ++ai)
#pragma unroll
            for (int m = 0; m < 4; ++m) { const size_t r = (size_t)(row0 + ai * HALF + m * 16); bf16_t* up = U + r * ldu + col0; const bf16_t* gp = G + r * ldg + col0;
#pragma unroll
                for (int bj = 0; bj < 2; ++bj) { const u32x4 gw = *(const u32x4*)(gp + bj * HALF); f32x4 v0 = acc[ai][bj][m][0], v1 = acc[ai][bj][m][1];
                    v0[0] *= bf_lo(gw.x); v0[1] *= bf_hi(gw.x); v0[2] *= bf_lo(gw.y); v0[3] *= bf_hi(gw.y); v1[0] *= bf_lo(gw.z); v1[1] *= bf_hi(gw.z); v1[2] *= bf_lo(gw.w); v1[3] *= bf_hi(gw.w);
                    if (ACCUM) { const u32x4 ow = *(const u32x4*)(up + bj * HALF);
                        v0[0] += bf_lo(ow.x); v0[1] += bf_hi(ow.x); v0[2] += bf_lo(ow.y); v0[3] += bf_hi(ow.y); v1[0] += bf_lo(ow.z); v1[1] += bf_hi(ow.z); v1[2] += bf_lo(ow.w); v1[3] += bf_hi(ow.w); }
                    u32x4 w; w.x = cvt_pk_bf16(v0[0], v0[1]); w.y = cvt_pk_bf16(v0[2], v0[3]); w.z = cvt_pk_bf16(v1[0], v1[1]); w.w = cvt_pk_bf16(v1[2], v1[3]);
                    *(u32x4*)(up + bj * HALF) = w; } }
    }
};
struct EpiRes {
    static constexpr bool PERM = false, AFTER_DRAIN = false;
    const float* base; float* out; int ldc;
    __device__ __forceinline__ void operator()(const f32x4 (&acc)[2][2][4][2], const Unit& u, int wr, int wc, int fr, int fq) const {
        const int row0 = u.pm * BM + wr * 64 + fr, col0 = u.pn * BM + wc * 32 + 4 * fq;
#pragma unroll
        for (int ai = 0; ai < 2; ++ai)
#pragma unroll
            for (int m = 0; m < 4; ++m) { const size_t off = (size_t)(row0 + ai * HALF + m * 16) * ldc + col0;
#pragma unroll
                for (int bj = 0; bj < 2; ++bj)
#pragma unroll
                    for (int n = 0; n < 2; ++n) { const f32x4 bs = *(const f32x4*)(base + off + bj * HALF + n * 16); *(f32x4*)(out + off + bj * HALF + n * 16) = bs + acc[ai][bj][m][n]; } }
    }
};
struct EpiSwiGLU {
    static constexpr bool PERM = true, AFTER_DRAIN = false;
    bf16_t* Hm; int ldh;
    __device__ __forceinline__ void operator()(const f32x4 (&acc)[2][2][4][2], const Unit& u, int wr, int wc, int fr, int fq) const {
        const int row0 = u.pm * BM + wr * 64 + fr, colh = u.pn * HALF + wc * 32 + 8 * fq;
#pragma unroll
        for (int ai = 0; ai < 2; ++ai)
#pragma unroll
            for (int m = 0; m < 4; ++m) { bf16_t* rowp = Hm + (size_t)(row0 + ai * HALF + m * 16) * ldh + colh;
                const f32x4 g0 = acc[ai][0][m][0], g1 = acc[ai][0][m][1], u0 = acc[ai][1][m][0], u1 = acc[ai][1][m][1];
                u32x4 w; w.x = cvt_pk_bf16(fsilu(g0[0]) * u0[0], fsilu(g0[1]) * u0[1]); w.y = cvt_pk_bf16(fsilu(g0[2]) * u0[2], fsilu(g0[3]) * u0[3]);
                w.z = cvt_pk_bf16(fsilu(g1[0]) * u1[0], fsilu(g1[1]) * u1[1]); w.w = cvt_pk_bf16(fsilu(g1[2]) * u1[2], fsilu(g1[3]) * u1[3]);
                *(u32x4*)rowp = w; }
    }
};
struct EpiBf16 {
    static constexpr bool PERM = true, AFTER_DRAIN = false;
    bf16_t* O; int ldc;
    __device__ __forceinline__ void operator()(const f32x4 (&acc)[2][2][4][2], const Unit& u, int wr, int wc, int fr, int fq) const {
        const int row0 = u.pm * BM + wr * 64 + fr, col0 = u.pn * BM + wc * 32 + 8 * fq;
#pragma unroll
        for (int ai = 0; ai < 2; ++ai)
#pragma unroll
            for (int m = 0; m < 4; ++m) { bf16_t* rowp = O + (size_t)(row0 + ai * HALF + m * 16) * ldc + col0;
#pragma unroll
                for (int bj = 0; bj < 2; ++bj) { const f32x4 v0 = acc[ai][bj][m][0], v1 = acc[ai][bj][m][1];
                    u32x4 w; w.x = cvt_pk_bf16(v0[0], v0[1]); w.y = cvt_pk_bf16(v0[2], v0[3]); w.z = cvt_pk_bf16(v1[0], v1[1]); w.w = cvt_pk_bf16(v1[2], v1[3]);
                    *(u32x4*)(rowp + bj * HALF) = w; } }
    }
};

typedef int i32x8 __attribute__((ext_vector_type(8)));
typedef int i32x4 __attribute__((ext_vector_type(4)));
constexpr int FP8_WSCALE = 127 - 6;
__device__ __forceinline__ i32x8 pg8_cat(const bf16x8& a, const bf16x8& b) { return __builtin_shufflevector(__builtin_bit_cast(i32x4, a), __builtin_bit_cast(i32x4, b), 0, 1, 2, 3, 4, 5, 6, 7); }
__device__ __forceinline__ unsigned pk4_fp8(float a, float b, float c, float d) { int w = __builtin_amdgcn_cvt_pk_fp8_f32(a, b, 0, false); w = __builtin_amdgcn_cvt_pk_fp8_f32(c, d, w, true); return (unsigned)w; }
struct EpiSwiGLU8 {
    static constexpr bool PERM = true, AFTER_DRAIN = false;
    unsigned char* Hm; int ldh;
    __device__ __forceinline__ void operator()(const f32x4 (&acc)[2][2][4][2], const Unit& u, int wr, int wc, int fr, int fq) const {
        const int row0 = u.pm * BM + wr * 64 + fr, colh = u.pn * HALF + wc * 32 + 8 * fq;
#pragma unroll
        for (int ai = 0; ai < 2; ++ai)
#pragma unroll
            for (int m = 0; m < 4; ++m) { unsigned char* rowp = Hm + (size_t)(row0 + ai * HALF + m * 16) * ldh + colh;
                const f32x4 g0 = acc[ai][0][m][0], g1 = acc[ai][0][m][1], u0 = acc[ai][1][m][0], u1 = acc[ai][1][m][1];
                u32x2 w; w.x = pk4_fp8(fsilu(g0[0]) * u0[0], fsilu(g0[1]) * u0[1], fsilu(g0[2]) * u0[2], fsilu(g0[3]) * u0[3]);
                w.y = pk4_fp8(fsilu(g1[0]) * u1[0], fsilu(g1[1]) * u1[1], fsilu(g1[2]) * u1[2], fsilu(g1[3]) * u1[3]);
                *(u32x2*)rowp = w; }
    }
};

struct EpiPoolW {
    static constexpr bool PERM = true, AFTER_DRAIN = false;
    bf16_t* O;
    __device__ __forceinline__ void operator()(const f32x4 (&acc)[2][2][4][2], const Unit& u, int wr, int wc, int fr, int fq) const {
        const int l = u.pm >> 5, g = (u.pm >> 3) & 3, np = u.pm & 7;
        const int row0 = np * BM + wr * 64 + fr, col0 = 2048 + 256 * g + wc * 32 + 8 * fq;
        bf16_t* base = O + (size_t)l * 2048 * 3072;
#pragma unroll
        for (int ai = 0; ai < 2; ++ai)
#pragma unroll
            for (int m = 0; m < 4; ++m) { bf16_t* rowp = base + (size_t)(row0 + ai * HALF + m * 16) * 3072 + col0;
#pragma unroll
                for (int bj = 0; bj < 2; ++bj) { const f32x4 v0 = acc[ai][bj][m][0], v1 = acc[ai][bj][m][1];
                    u32x4 w; w.x = cvt_pk_bf16(v0[0], v0[1]); w.y = cvt_pk_bf16(v0[2], v0[3]); w.z = cvt_pk_bf16(v1[0], v1[1]); w.w = cvt_pk_bf16(v1[2], v1[3]);
                    *(u32x4*)(rowp + bj * HALF) = w; } }
    }
};

template <class Epi, class Sched, bool ALIGN_EPI = false, bool SP2 = false, bool FP8 = false>
__device__ __forceinline__ void gemm_phase(PG8_LAS unsigned char* lds, const Gemm g, const Sched& S, const Epi& E) {
    int tid_ = threadIdx.x; asm volatile("" : "+v"(tid_));
    const int tid = tid_, wid = __builtin_amdgcn_readfirstlane(tid >> 6), lane = tid & 63, wr = wid >> 2, wc = wid & 3, fr = lane & 15, fq = lane >> 4;
    const int K = g.K, nt = K / BK;
    unsigned voffA[2], voffB[2];
#pragma unroll
    for (int i = 0; i < 2; ++i) { int R, C; stage_rc(tid * 16 + i * 8192, R, C); const int Rb = Epi::PERM ? ((R & ~31) + perm32(R & 31)) : R;
        voffA[i] = (unsigned)(R * g.lda + C) * 2u; voffB[i] = (unsigned)(Rb * g.ldb + C) * 2u; }
    const size_t kstep = (size_t)(BK * 2);
    const size_t hstepA = (size_t)HALF * g.lda * 2, hstepB = (size_t)HALF * g.ldb * 2;
    const size_t tstepA = 2 * hstepA, tstepB = 2 * hstepB;
    const unsigned ldsw = (unsigned)wid * 1024u;
    const int aoff = lds_byte(wr * 64 + fr, fq * 8), boff = lds_byte(wc * 32 + fr, fq * 8);
#define PG8_SA(b, h) (((b) * 2 + (h)) * HTB)
#define PG8_SB(b, h) ((4 + (b) * 2 + (h)) * HTB)
#define PG8_STAGE(bufoff, gbase, voff) do { _Pragma("unroll") for (int _i = 0; _i < 2; ++_i) \
        __builtin_amdgcn_global_load_lds((const unsigned*)((const char*)(gbase) + (voff)[_i]), (PG8_LAS unsigned*)(lds + (bufoff) + ldsw + _i * 8192), 16, 0, 0); } while (0)
#define PG8_LDA(dst, b, h) do { if constexpr (FP8) { _Pragma("unroll") for (int m = 0; m < 4; ++m) { dst##8[m].lo = *(const PG8_LAS i32x4*)(lds + PG8_SA(b, h) + aoff + m * 2048); dst##8[m].hi = *(const PG8_LAS i32x4*)(lds + PG8_SA(b, h) + aoff + m * 2048 + 1024); } } \
        else { _Pragma("unroll") for (int m = 0; m < 4; ++m) _Pragma("unroll") for (int k = 0; k < 2; ++k) dst[m][k] = *(const PG8_LAS bf16x8*)(lds + PG8_SA(b, h) + aoff + m * 2048 + k * 1024); } } while (0)
#define PG8_LDB(dst, b, h) do { if constexpr (FP8) { _Pragma("unroll") for (int n = 0; n < 2; ++n) { dst##8[n].lo = *(const PG8_LAS i32x4*)(lds + PG8_SB(b, h) + boff + n * 2048); dst##8[n].hi = *(const PG8_LAS i32x4*)(lds + PG8_SB(b, h) + boff + n * 2048 + 1024); } } \
        else { _Pragma("unroll") for (int n = 0; n < 2; ++n) _Pragma("unroll") for (int k = 0; k < 2; ++k) dst[n][k] = *(const PG8_LAS bf16x8*)(lds + PG8_SB(b, h) + boff + n * 2048 + k * 1024); } } while (0)
#define PG8_MMA(ai, bj, At, Bt) do { __builtin_amdgcn_s_setprio(1); \
        if constexpr (FP8) { _Pragma("unroll") for (int m = 0; m < 4; ++m) _Pragma("unroll") for (int n = 0; n < 2; ++n) \
            asm volatile("v_mfma_scale_f32_16x16x128_f8f6f4 %0, %1, %2, %0, %3, %4 op_sel_hi:[0,0,0]" : "+v"(acc[ai][bj][m][n]) : "v"(Bt##8[n]), "v"(At##8[m]), "v"(fp8_sw), "v"(fp8_sa)); } \
        else { _Pragma("unroll") for (int m = 0; m < 4; ++m) _Pragma("unroll") for (int n = 0; n < 2; ++n) _Pragma("unroll") for (int k = 0; k < 2; ++k) \
            acc[ai][bj][m][n] = __builtin_amdgcn_mfma_f32_16x16x32_bf16(Bt[n][k], At[m][k], acc[ai][bj][m][n], 0, 0, 0); } \
        __builtin_amdgcn_s_setprio(0); } while (0)
#define PG8_WAIT_V(n) asm volatile("s_waitcnt vmcnt(" #n ")" ::: "memory")
#define PG8_WAIT_L(n) asm volatile("s_waitcnt lgkmcnt(" #n ")" ::: "memory")
#define PG8_BAR __builtin_amdgcn_s_barrier()
#define PG8_SCHED __builtin_amdgcn_sched_barrier(0)
    Unit cur, nxt; int ui = 0;
    if (!S.next(0, cur)) return;
    f32x4 acc[2][2][4][2];
#pragma unroll
    for (int a = 0; a < 2; ++a)
#pragma unroll
        for (int b = 0; b < 2; ++b)
#pragma unroll
            for (int m = 0; m < 4; ++m)
#pragma unroll
                for (int n = 0; n < 2; ++n) acc[a][b][m][n] = (f32x4){0.f, 0.f, 0.f, 0.f};
    bf16x8 At[4][2], B0[2][2], B1[2][2]; i32x8 At8[4], B08[2], B18[2]; const int fp8_sw = FP8_WSCALE, fp8_sa = 127;
    const char* cA = (const char*)g.A + (size_t)cur.pm * tstepA; const char* cB = (const char*)g.Bt + (size_t)cur.be * g.bstride + (size_t)cur.pn * tstepB;
    S.a_ready(cur);
    if constexpr (SP2) {
        PG8_STAGE(PG8_SB(0, 0), cB, voffB); PG8_STAGE(PG8_SB(0, 1), cB + hstepB, voffB); PG8_STAGE(PG8_SA(0, 0), cA, voffA); PG8_STAGE(PG8_SA(0, 1), cA + hstepA, voffA);
        if (wr == 1) PG8_BAR;
        PG8_WAIT_V(2); PG8_BAR;
        PG8_STAGE(PG8_SB(1, 0), cB + kstep, voffB); PG8_STAGE(PG8_SA(1, 0), cA + kstep, voffA); PG8_STAGE(PG8_SB(1, 1), cB + hstepB + kstep, voffB);
        PG8_WAIT_V(6); PG8_BAR;
    } else {
        PG8_STAGE(PG8_SB(0, 0), cB, voffB); PG8_STAGE(PG8_SA(0, 0), cA, voffA); PG8_STAGE(PG8_SB(0, 1), cB + hstepB, voffB); PG8_STAGE(PG8_SA(0, 1), cA + hstepA, voffA);
        if (wr == 1) PG8_BAR;
        PG8_WAIT_V(4); PG8_BAR;
        PG8_STAGE(PG8_SB(1, 0), cB + kstep, voffB); PG8_STAGE(PG8_SA(1, 0), cA + kstep, voffA); PG8_STAGE(PG8_SB(1, 1), cB + hstepB + kstep, voffB);
        PG8_WAIT_V(6); PG8_BAR;
    }
    for (;;) {
        const bool has_next = S.next(ui + 1, nxt);
        const char* nA = has_next ? (const char*)g.A + (size_t)nxt.pm * tstepA : cA; const char* nB = has_next ? (const char*)g.Bt + (size_t)nxt.be * g.bstride + (size_t)nxt.pn * tstepB : cB;
        for (int t = 0; t < nt; t += 2) {
            const bool last = (t == nt - 2);
            const char* a1 = cA + (size_t)(t + 1) * kstep;
            const char* a2 = last ? nA : cA + (size_t)(t + 2) * kstep; const char* b2 = last ? nB : cB + (size_t)(t + 2) * kstep;
            const char* a3 = a2 + kstep; const char* b3 = b2 + kstep;
            if (last && has_next) S.a_ready(nxt);
            if constexpr (SP2) {
            PG8_LDB(B0, 0, 0); PG8_LDB(B1, 0, 1); PG8_SCHED; PG8_LDA(At, 0, 0); PG8_STAGE(PG8_SA(1, 1), a1 + hstepA, voffA);
            PG8_WAIT_V(8); PG8_WAIT_L(0); PG8_BAR; PG8_MMA(0, 0, At, B0); PG8_MMA(0, 1, At, B1); PG8_BAR; PG8_SCHED;
            PG8_LDA(At, 0, 1); PG8_STAGE(PG8_SB(0, 0), b2, voffB); PG8_STAGE(PG8_SB(0, 1), b2 + hstepB, voffB); PG8_STAGE(PG8_SA(0, 0), a2, voffA);
            PG8_WAIT_V(8); PG8_WAIT_L(0); PG8_BAR; PG8_MMA(1, 0, At, B0); PG8_MMA(1, 1, At, B1); PG8_BAR; PG8_SCHED;
            PG8_LDB(B0, 1, 0); PG8_LDB(B1, 1, 1); PG8_SCHED; PG8_LDA(At, 1, 0); PG8_STAGE(PG8_SA(0, 1), a2 + hstepA, voffA);
            PG8_WAIT_V(8); PG8_WAIT_L(0); PG8_BAR; PG8_MMA(0, 0, At, B0); PG8_MMA(0, 1, At, B1); PG8_BAR; PG8_SCHED;
            PG8_LDA(At, 1, 1); PG8_STAGE(PG8_SB(1, 0), b3, voffB); PG8_STAGE(PG8_SB(1, 1), b3 + hstepB, voffB); PG8_STAGE(PG8_SA(1, 0), a3, voffA);
            PG8_WAIT_V(8); PG8_WAIT_L(0); PG8_BAR; PG8_MMA(1, 0, At, B0); PG8_MMA(1, 1, At, B1); PG8_BAR; PG8_SCHED;
            } else {
            PG8_LDB(B0, 0, 0); PG8_SCHED; PG8_LDA(At, 0, 0); PG8_STAGE(PG8_SA(1, 1), a1 + hstepA, voffA);
            PG8_WAIT_L(8); PG8_BAR; PG8_WAIT_L(0); PG8_MMA(0, 0, At, B0); PG8_BAR; PG8_SCHED;
            PG8_LDB(B1, 0, 1); PG8_STAGE(PG8_SB(0, 0), b2, voffB);
            PG8_BAR; PG8_WAIT_L(0); PG8_MMA(0, 1, At, B1); PG8_BAR;
            PG8_LDA(At, 0, 1); PG8_STAGE(PG8_SA(0, 0), a2, voffA);
            PG8_BAR; PG8_WAIT_L(0); PG8_MMA(1, 0, At, B0); PG8_BAR; PG8_SCHED;
            PG8_STAGE(PG8_SB(0, 1), b2 + hstepB, voffB);
            PG8_WAIT_V(6); PG8_BAR; PG8_MMA(1, 1, At, B1); PG8_BAR;
            PG8_LDB(B0, 1, 0); PG8_SCHED; PG8_LDA(At, 1, 0); PG8_STAGE(PG8_SA(0, 1), a2 + hstepA, voffA);
            PG8_WAIT_L(8); PG8_BAR; PG8_WAIT_L(0); PG8_MMA(0, 0, At, B0); PG8_BAR; PG8_SCHED;
            PG8_LDB(B1, 1, 1); PG8_STAGE(PG8_SB(1, 0), b3, voffB);
            PG8_BAR; PG8_WAIT_L(0); PG8_MMA(0, 1, At, B1); PG8_BAR;
            PG8_LDA(At, 1, 1); PG8_STAGE(PG8_SA(1, 0), a3, voffA);
            PG8_BAR; PG8_WAIT_L(0); PG8_MMA(1, 0, At, B0); PG8_BAR; PG8_SCHED;
            PG8_STAGE(PG8_SB(1, 1), b3 + hstepB, voffB);
            PG8_WAIT_V(6); PG8_BAR; PG8_MMA(1, 1, At, B1); PG8_BAR;
            }
        }
        if constexpr (FP8) asm volatile("s_nop 15\n\ts_nop 15" ::: "memory");
        if constexpr (ALIGN_EPI) { if (wr == 0) PG8_BAR; }
        if constexpr (!Epi::AFTER_DRAIN) { E(acc, cur, wr, wc, fr, fq); S.done(cur); }
        if (!has_next) break;
#pragma unroll
        for (int a = 0; a < 2; ++a)
#pragma unroll
            for (int b = 0; b < 2; ++b)
#pragma unroll
                for (int m = 0; m < 4; ++m)
#pragma unroll
                    for (int n = 0; n < 2; ++n) acc[a][b][m][n] = (f32x4){0.f, 0.f, 0.f, 0.f};
        cur = nxt; cA = nA; cB = nB; ++ui;
        if constexpr (ALIGN_EPI) { if (wr == 1) PG8_BAR; }
    }
    PG8_WAIT_V(0);
    if constexpr (!ALIGN_EPI) { if (wr == 0) PG8_BAR; }
    PG8_BAR;
    if constexpr (Epi::AFTER_DRAIN) { E.fused(acc, cur, wr, wc, fr, fq, lds, wid, lane); S.done(cur); }
#undef PG8_SA
#undef PG8_SB
#undef PG8_STAGE
#undef PG8_LDA
#undef PG8_LDB
#undef PG8_MMA
#undef PG8_WAIT_V
#undef PG8_WAIT_L
#undef PG8_BAR
#undef PG8_SCHED
}
}

#ifndef DENSE_FP8
#define DENSE_FP8 0
#endif
constexpr int NWAVES = 8;
constexpr int BATCH = 2, SEQ = 8192, M = BATCH * SEQ, D = 2048, NH = 4, HK = 256, HV = 512, PW = 1024, DFF = 5632, NE = 8, DIN = 11280;
constexpr int ZN = 12288;
constexpr int ZP = 11264;
constexpr int ZC_Q = 0, ZC_K = 1024, ZC_V = 2048, ZC_R = 4096, ZC_P = 6144, ZC_GA = 7168, ZC_GB = 9216;
constexpr int KCAT = 3072;
constexpr int FFN = 2 * DFF;
constexpr int MAXSLOT = 2 * M + NE * 256;
constexpr float EPS = 1e-6f;
static_assert(pg8::ZP_ == ZP, "pitch");

constexpr size_t MiB = 1u << 20;
constexpr size_t WS_CTL = 0, CTL_ZERO_BYTES = 65536;
constexpr size_t WS_TOKSLOT = 1 * MiB, WS_WSLOT = 1 * MiB + 256 * 1024, WS_TOKE = 2 * MiB, WS_TOKW = 2 * MiB + 256 * 1024;
constexpr size_t WS_WIN = 4 * MiB, WS_BCAT = 100 * MiB, WS_WOUT = 124 * MiB, WS_FF1 = 140 * MiB, WS_FF2 = 184 * MiB, WS_EF1 = 206 * MiB, WS_EF2 = 558 * MiB;
constexpr size_t WS_HB = 734 * MiB, WS_ZB = 798 * MiB, WS_LA = 1172 * MiB, WS_OF = 1236 * MiB, WS_ACAT = 1364 * MiB, WS_U = 1460 * MiB, WS_END = 1524 * MiB;
constexpr size_t WS_HMID = WS_ZB, WS_HPERM = WS_ACAT;
static_assert(WS_WIN + 2 * (size_t)ZN * D * 2 <= WS_BCAT && WS_BCAT + 2 * (size_t)D * KCAT * 2 <= WS_WOUT && WS_WOUT + 2 * (size_t)D * D * 2 <= WS_FF1, "ws map 1");
static_assert(WS_FF1 + (size_t)FFN * D * 2 <= WS_FF2 && WS_FF2 + (size_t)D * DFF * 2 <= WS_EF1 && WS_EF1 + 8 * (size_t)FFN * D * 2 <= WS_EF2 && WS_EF2 + 8 * (size_t)D * DFF * 2 <= WS_HB, "ws map 2");
static_assert(WS_HB + (size_t)M * D * 2 <= WS_ZB && WS_ZB + (size_t)M * ZP * 2 <= WS_LA && WS_HMID + (size_t)MAXSLOT * DFF * 2 <= WS_LA && WS_LA + (size_t)M * 1024 * 4 <= WS_OF, "ws map 3");
static_assert(WS_OF + (size_t)M * D * 4 <= WS_ACAT && WS_ACAT + (size_t)M * KCAT * 2 <= WS_U && WS_U + (size_t)M * D * 2 <= WS_END && WS_HPERM + (size_t)MAXSLOT * D * 2 <= WS_END, "ws map 4");
static_assert((size_t)MAXSLOT * 4 <= 256 * 1024 && (size_t)M * 2 * 4 <= 256 * 1024, "ctl tables");
constexpr int CW_TMO = 0, CW_CODE = 1, CW_BAR = 4096, CW_CNT = 8192, CW_FILL = 8256;

constexpr int RING_OFF = 0, RING_BYTES = 131072;
constexpr int LDSCTL_OFF = RING_BYTES, MISC_OFF = LDSCTL_OFF + 320;
constexpr int LDS_BYTES = 147456;

#define GAS __attribute__((address_space(1)))
#define LAS __attribute__((address_space(3)))
typedef unsigned short bf16;
typedef unsigned v4u __attribute__((ext_vector_type(4)));
typedef unsigned v2u __attribute__((ext_vector_type(2)));
typedef float f32x4 __attribute__((ext_vector_type(4)));
typedef GAS unsigned gu32;
#define RLX_AGENT __ATOMIC_RELAXED, __HIP_MEMORY_SCOPE_AGENT
#define LDS_WAIT() asm volatile("s_waitcnt lgkmcnt(0)" ::: "memory")
#define VM_WAIT() asm volatile("s_waitcnt vmcnt(0)" ::: "memory")
__device__ __forceinline__ unsigned f2bf(float f) { unsigned u = __builtin_bit_cast(unsigned, f); return (u + 0x7fffu + ((u >> 16) & 1u)) >> 16; }
__device__ __forceinline__ unsigned pk2(float lo, float hi) { return f2bf(lo) | (f2bf(hi) << 16); }
__device__ __forceinline__ float bfl(unsigned w) { return __uint_as_float(w << 16); }
__device__ __forceinline__ float bfh(unsigned w) { return __uint_as_float(w & 0xffff0000u); }
__device__ __forceinline__ float wave_sum(float v) {
#pragma unroll
    for (int o = 1; o < 64; o <<= 1) v += __shfl_xor(v, o);
    return v;
}
typedef __bf16 gl_bf2 __attribute__((ext_vector_type(2)));
typedef float gl_f2 __attribute__((ext_vector_type(2)));
__device__ __forceinline__ unsigned pkbf(float lo, float hi) { gl_f2 v = {lo, hi}; return __builtin_bit_cast(unsigned, __builtin_convertvector(v, gl_bf2)); }
__device__ __forceinline__ int opq(int x) { asm volatile("" : "+v"(x)); return x; }
#define XB_TMO      128
#define XB_XCNT(j)  (256  + 64 * (j))
#define XB_XSUB(j)  (1280 + 64 * (j))
#define XB_XGEN(j)  (2304 + 64 * (j))
#define XB_TOP      3328
#define XB_TOPGEN   3392
#define XCD_BAR_WORDS 3456
#define XB_SPIN_CAP (1u << 18)

__device__ __forceinline__ unsigned xb_ld(unsigned* p)              { return __hip_atomic_load(p, __ATOMIC_RELAXED, __HIP_MEMORY_SCOPE_AGENT); }
__device__ __forceinline__ unsigned xb_add(unsigned* p, unsigned v) { return __hip_atomic_fetch_add(p, v, __ATOMIC_RELAXED, __HIP_MEMORY_SCOPE_AGENT); }
__device__ __forceinline__ unsigned xb_xcc_id() { return (unsigned)__builtin_amdgcn_s_getreg((3 << 11) | 20) & 0xFu; }
#define XB_SPIN(cond, bar) do { unsigned _sp = 0; while (cond) { __builtin_amdgcn_s_sleep(1); \
    if ((++_sp & 255u) == 0u) { if (xb_ld(&(bar)[XB_TMO])) break; if (_sp > XB_SPIN_CAP) { atomicAdd(&(bar)[XB_TMO], 1u); break; } } } } while (0)

struct XcdBarrier {
    unsigned* bar; unsigned x;
    volatile LAS unsigned* st;
};

__device__ __forceinline__ XcdBarrier xcd_barrier_post(unsigned* bar, volatile LAS unsigned* st) {
    XcdBarrier b; b.bar = bar; b.x = xb_xcc_id(); b.st = st;
    if (threadIdx.x == 0) (void)xb_add(&bar[XB_XCNT(b.x)], 1u);
    return b;
}
__device__ __forceinline__ void xcd_barrier_complete(unsigned* bar, unsigned x, unsigned& nloc, unsigned& nx) {
    const unsigned G = gridDim.x * gridDim.y * gridDim.z;
    unsigned sum, cnt, mine, sp = 0u;
    for (;;) {
        sum = 0u; cnt = 0u; mine = 0u;
#pragma unroll
        for (unsigned j = 0; j < 16; ++j) { const unsigned c = xb_ld(&bar[XB_XCNT(j)]); sum += c; cnt += (c > 0u) ? 1u : 0u; mine = (j == x) ? c : mine; }
        if (sum == G) break;
        __builtin_amdgcn_s_sleep(1);
        if ((++sp & 255u) == 0u) { if (xb_ld(&bar[XB_TMO])) break; if (sp > XB_SPIN_CAP) { atomicAdd(&bar[XB_TMO], 1u); break; } }
    }
    nloc = mine > 0u ? mine : 1u; nx = cnt > 0u ? cnt : 1u;
}

__device__ __forceinline__ void xcd_barrier(const XcdBarrier& b) {
    asm volatile("s_waitcnt vmcnt(0)" ::: "memory");
    __syncthreads();
    if (threadIdx.x == 0) {
        unsigned* bar = b.bar;
        __builtin_amdgcn_s_waitcnt(0);
        unsigned nloc = b.st[0], nx = b.st[1];
        if (nloc == 0u) { xcd_barrier_complete(bar, b.x, nloc, nx); b.st[0] = nloc; b.st[1] = nx; }
        const unsigned old = xb_add(&bar[XB_XSUB(b.x)], 1u);
        const unsigned gen = old / nloc;
        if (old + 1u == (gen + 1u) * nloc) {
            __builtin_amdgcn_fence(__ATOMIC_RELEASE, "agent");
            asm volatile("s_waitcnt vmcnt(0)" ::: "memory");
            const unsigned og = xb_add(&bar[XB_TOP], 1u);
            const unsigned tg = og / nx;
            if (og + 1u == (tg + 1u) * nx) xb_add(&bar[XB_TOPGEN], 1u);
            else XB_SPIN(xb_ld(&bar[XB_TOPGEN]) == tg, bar);
            __builtin_amdgcn_fence(__ATOMIC_ACQUIRE, "agent");
            xb_add(&bar[XB_XGEN(b.x)], 1u);
            asm volatile("s_waitcnt vmcnt(0)" ::: "memory");
        } else {
            XB_SPIN(xb_ld(&bar[XB_XGEN(b.x)]) == gen, bar);
            __builtin_amdgcn_fence(__ATOMIC_ACQUIRE, "agent");
            asm volatile("s_waitcnt vmcnt(0)" ::: "memory");
        }
    }
    __syncthreads();
}

struct TrJob { const float* src; unsigned char* dst; int ldw, ldt, k0, n0, mode, row_off, kind; };
__device__ __forceinline__ int tr_drow(int nn, int mode, int row_off) { return mode ? (256 * (nn >> 7) + (nn & 127) + row_off) : (row_off + nn); }
__device__ __forceinline__ void tr_load(const TrJob& J, f32x4 (&R)[16], int lane) {
    if (J.kind == 0) { const int nq = lane & 15, kr = lane >> 4; const float* b = J.src + (size_t)(4 * kr) * J.ldw + 4 * nq;
#pragma unroll
        for (int jq = 0; jq < 4; ++jq)
#pragma unroll
            for (int x = 0; x < 4; ++x) R[4 * jq + x] = __builtin_nontemporal_load((const GAS f32x4*)(b + (size_t)(16 * jq + x) * J.ldw));
    } else { const int nq = lane & 7, kr = lane >> 3; const float* b = J.src + (size_t)(4 * kr) * J.ldw + 4 * nq;
#pragma unroll
        for (int jq = 0; jq < 4; ++jq)
#pragma unroll
            for (int x = 0; x < 4; ++x) R[4 * jq + x] = __builtin_nontemporal_load((const GAS f32x4*)(b + (size_t)(32 * jq + x) * J.ldw)); }
}
__device__ __forceinline__ void tr_finish(const TrJob& J, const f32x4 (&R)[16], LAS unsigned* T, int lane, int nostore) {
    if (J.kind == 0) { const int nq = lane & 15, kr = lane >> 4;
#pragma unroll
        for (int jq = 0; jq < 4; ++jq)
#pragma unroll
            for (int i = 0; i < 4; ++i) { T[(4 * nq + i) * 33 + 8 * jq + 2 * kr] = pkbf(R[4 * jq][i], R[4 * jq + 1][i]); T[(4 * nq + i) * 33 + 8 * jq + 2 * kr + 1] = pkbf(R[4 * jq + 2][i], R[4 * jq + 3][i]); }
        LDS_WAIT(); asm volatile("" ::: "memory");
#pragma unroll
        for (int r = 0; r < 8; ++r) { const int t = lane + 64 * r, n = t >> 3, c = t & 7; const LAS unsigned* s = T + n * 33 + 4 * c;
            v4u o; o.x = s[0]; o.y = s[1]; o.z = s[2]; o.w = s[3];
            if (!nostore || o.x == 0x12345678u) *(GAS v4u*)(J.dst + (size_t)tr_drow(J.n0 + n, J.mode, J.row_off) * J.ldt + 2 * J.k0 + 16 * c) = o; }
    } else { const int nq = lane & 7, kr = lane >> 3;
#pragma unroll
        for (int jq = 0; jq < 4; ++jq)
#pragma unroll
            for (int i = 0; i < 4; ++i) T[(4 * nq + i) * 33 + 8 * jq + kr] = pg8::pk4_fp8(R[4 * jq][i] * 64.0f, R[4 * jq + 1][i] * 64.0f, R[4 * jq + 2][i] * 64.0f, R[4 * jq + 3][i] * 64.0f);
        LDS_WAIT(); asm volatile("" ::: "memory");
#pragma unroll
        for (int r = 0; r < 4; ++r) { const int t = lane + 64 * r, n = t >> 3, c = t & 7; const LAS unsigned* s = T + n * 33 + 4 * c;
            v4u o; o.x = s[0]; o.y = s[1]; o.z = s[2]; o.w = s[3];
            if (!nostore || o.x == 0x12345678u) *(GAS v4u*)(J.dst + (size_t)tr_drow(J.n0 + n, J.mode, J.row_off) * J.ldt + J.k0 + 16 * c) = o; } }
    LDS_WAIT(); asm volatile("" ::: "memory");
}

template <bool ROUTE, bool OUT8 = false>
__device__ __forceinline__ void norm_rows(const float* X, const float* gain, bf16* out, int gw, int NGW, int lane0,
                                          const LAS float* rw, int* tok_e, float* tok_w, LAS unsigned* hist) {
    const int lane = opq(lane0);
    f32x4 nx[8];
    if (gw < M) { const GAS f32x4* xr = (const GAS f32x4*)(X + (size_t)gw * D) + lane;
#pragma unroll
        for (int j = 0; j < 8; ++j) nx[j] = xr[64 * j]; }
    for (int m = gw; m < M; m += NGW) {
        f32x4 v[8]; float s = 0.f;
#pragma unroll
        for (int j = 0; j < 8; ++j) { v[j] = nx[j]; s += (v[j].x * v[j].x + v[j].y * v[j].y) + (v[j].z * v[j].z + v[j].w * v[j].w); }
        if (m + NGW < M) { const GAS f32x4* xr = (const GAS f32x4*)(X + (size_t)(m + NGW) * D) + lane;
#pragma unroll
            for (int j = 0; j < 8; ++j) nx[j] = xr[64 * j]; }
        const float rstd = 1.0f / sqrtf(wave_sum(s) * (1.0f / D) + EPS);
        GAS unsigned long long* o8 = (GAS unsigned long long*)(out + (size_t)m * D) + lane;
#pragma unroll
        for (int j = 0; j < 8; ++j) { const f32x4 g4 = ((const GAS f32x4*)gain)[lane + 64 * j]; v[j] = v[j] * rstd * g4;
            if (OUT8) ((GAS unsigned*)((unsigned char*)out + (size_t)m * D))[lane + 64 * j] = pg8::pk4_fp8(v[j].x, v[j].y, v[j].z, v[j].w);
            else o8[64 * j] = (unsigned long long)pk2(v[j].x, v[j].y) | ((unsigned long long)pk2(v[j].z, v[j].w) << 32); }
        if (ROUTE) {
            float lg[8];
#pragma unroll
            for (int e = 0; e < 8; ++e) lg[e] = 0.f;
#pragma unroll
            for (int j = 0; j < 8; ++j)
#pragma unroll
                for (int i = 0; i < 4; ++i) { const int k = 4 * (lane + 64 * j) + i; const f32x4 r0 = *(const LAS f32x4*)(rw + k * 8), r1 = *(const LAS f32x4*)(rw + k * 8 + 4); const float hv = v[j][i];
                    lg[0] += hv * r0.x; lg[1] += hv * r0.y; lg[2] += hv * r0.z; lg[3] += hv * r0.w; lg[4] += hv * r1.x; lg[5] += hv * r1.y; lg[6] += hv * r1.z; lg[7] += hv * r1.w; }
#pragma unroll
            for (int e = 0; e < 8; ++e) lg[e] = wave_sum(lg[e]);
            float v1 = lg[0]; int i1 = 0;
#pragma unroll
            for (int e = 1; e < 8; ++e) if (lg[e] > v1) { v1 = lg[e]; i1 = e; }
            float v2 = -3.0e38f; int i2 = 0;
#pragma unroll
            for (int e = 0; e < 8; ++e) if (e != i1 && lg[e] > v2) { v2 = lg[e]; i2 = e; }
            const float ex = __expf(v2 - v1), w1 = 1.0f / (1.0f + ex), w2 = ex * w1;
            if (lane == 0) { tok_e[2 * m] = i1; tok_e[2 * m + 1] = i2; tok_w[2 * m] = w1; tok_w[2 * m + 1] = w2;
                __hip_atomic_fetch_add(hist + i1, 1u, __ATOMIC_RELAXED, __HIP_MEMORY_SCOPE_WORKGROUP); __hip_atomic_fetch_add(hist + i2, 1u, __ATOMIC_RELAXED, __HIP_MEMORY_SCOPE_WORKGROUP); }
        }
    }
}


typedef short gl_bf16x8 __attribute__((ext_vector_type(8)));
typedef short gl_s16x4 __attribute__((ext_vector_type(4)));
__device__ __forceinline__ unsigned off_q(unsigned row, unsigned ch) { return 512u * row + 16u * (ch ^ (row & 15u)); }
__device__ __forceinline__ unsigned off_a(unsigned row, unsigned ch) { return 128u * row + 16u * (ch ^ (row & 7u)); }
__device__ __forceinline__ unsigned off_b(unsigned row, unsigned ch) { return 256u * row + 16u * (ch ^ (((row & 3u) << 2) | ((row >> 2) & 3u))); }
__device__ __forceinline__ gl_bf16x8 tr_frag(unsigned base, unsigned lane, unsigned c) {
    const unsigned g = lane >> 4, q = (lane & 15u) >> 2, p = lane & 3u;
    const unsigned a0 = base + off_b(8u * g + q, 2u * c + (p >> 1)) + 8u * (p & 1u), a1 = base + off_b(8u * g + 4u + q, 2u * c + (p >> 1)) + 8u * (p & 1u);
    const gl_s16x4 lo = __builtin_amdgcn_ds_read_tr16_b64_v4i16((LAS gl_s16x4*)a0), hi = __builtin_amdgcn_ds_read_tr16_b64_v4i16((LAS gl_s16x4*)a1);
    return __builtin_shufflevector(lo, hi, 0, 1, 2, 3, 4, 5, 6, 7);
}
#define GLA_MFMA(a, b, c) __builtin_amdgcn_mfma_f32_16x16x32_bf16((a), (b), (c), 0, 0, 0)
constexpr int GLA_NSEG = 8, GLA_CPS = 16;
constexpr int GL_QT = 0, GL_KE = 32768, GL_V = 65536, GL_ATT = 81920, GL_DEC = 90112;

__device__ __forceinline__ void gla_g0(LAS unsigned char* lds, bf16* Zb, const bf16* Hb, const bf16* WA1T, const float* w_alpha, const float* b_alpha, bf16* ATT, float* DEC, int bx, int G, int tid0, int lane0, int wave) {
    const int tid = opq(tid0), lane = tid & 63; (void)lane0;
    LAS float* sB = (LAS float*)lds; LAS unsigned char* sQ = lds + 65536; LAS unsigned char* sK = lds + 98304;
    LAS float* sP = (LAS float*)(lds + 65536);
    LAS float* sA1 = (LAS float*)(lds + 131072 + 1024);
    const unsigned li = lane & 15, g = lane >> 4;
    for (int uc = bx; uc < 256; uc += G) {
        const int b = uc >> 7, c = uc & 127; const size_t row0 = (size_t)b * SEQ + (size_t)c * 64;
        __syncthreads();
        { f32x4 pa[4];
#pragma unroll
            for (int mt = 0; mt < 4; ++mt) pa[mt] = (f32x4){0.f, 0.f, 0.f, 0.f};
#pragma unroll
            for (int s2 = 0; s2 < 4; ++s2) { gl_bf16x8 bf[2], af[2][4];
#pragma unroll
                for (int ss = 0; ss < 2; ++ss) { const int s = 8 * wave + 2 * s2 + ss; bf[ss] = *(const GAS gl_bf16x8*)(WA1T + (size_t)li * D + 32 * s + 8 * g);
#pragma unroll
                    for (int mt = 0; mt < 4; ++mt) af[ss][mt] = *(const GAS gl_bf16x8*)(Hb + (row0 + 16 * mt + li) * D + 32 * s + 8 * g); }
#pragma unroll
                for (int ss = 0; ss < 2; ++ss)
#pragma unroll
                    for (int mt = 0; mt < 4; ++mt) pa[mt] = GLA_MFMA(af[ss][mt], bf[ss], pa[mt]); }
#pragma unroll
            for (int mt = 0; mt < 4; ++mt)
#pragma unroll
                for (int j = 0; j < 4; ++j) sP[(wave * 64 + 16 * mt + 4 * g + j) * 16 + li] = pa[mt][j]; }
        __syncthreads();
#pragma unroll
        for (int e2 = 0; e2 < 2; ++e2) { const int e = tid + 512 * e2; float s = 0.f;
#pragma unroll
            for (int w = 0; w < 8; ++w) s += sP[w * 1024 + e];
            sA1[e] = s; }
        for (int h = 0; h < 4; ++h) {
        const int u = (b << 9) | (c << 2) | h;
        __syncthreads();
        v4u q8r[4], k8r[4];
#pragma unroll
        for (int i = 0; i < 4; ++i) { const int n = tid + 512 * i, r = n >> 5, ch = n & 31;
            q8r[i] = *(const GAS v4u*)(Zb + (row0 + r) * ZP + ZC_Q + h * 256 + 8 * ch); k8r[i] = *(const GAS v4u*)(Zb + (row0 + r) * ZP + ZC_K + h * 256 + 8 * ch); }
        {
            const int d = tid & 255, hf = tid >> 8; float wa[16];
#pragma unroll
            for (int r = 0; r < 16; ++r) wa[r] = w_alpha[r * 1024 + h * 256 + d];
            const float ba = b_alpha[h * 256 + d];
            float vv[32];
#pragma unroll
            for (int t = 0; t < 32; ++t) { const LAS f32x4* ap = (const LAS f32x4*)(sA1 + (32 * hf + t) * 16); const f32x4 a0 = ap[0], a1 = ap[1], a2 = ap[2], a3 = ap[3];
                float s = ba + (a0.x * wa[0] + a0.y * wa[1]) + (a0.z * wa[2] + a0.w * wa[3]) + (a1.x * wa[4] + a1.y * wa[5]) + (a1.z * wa[6] + a1.w * wa[7])
                             + (a2.x * wa[8] + a2.y * wa[9]) + (a2.z * wa[10] + a2.w * wa[11]) + (a3.x * wa[12] + a3.y * wa[13]) + (a3.z * wa[14] + a3.w * wa[15]);
                vv[t] = pg8::flogsig(s) * 0.0625f; }
#pragma unroll
            for (int t = 1; t < 32; ++t) vv[t] += vv[t - 1];
            LAS float* tot = (LAS float*)(lds + 65536);
            if (hf == 0) tot[d] = vv[31];
            __syncthreads();
            const float add = hf ? tot[d] : 0.f;
#pragma unroll
            for (int t = 0; t < 32; ++t) sB[(32 * hf + t) * 256 + d] = vv[t] + add;
        }
        __syncthreads();
#pragma unroll
        for (int i = 0; i < 4; ++i) { const int n = tid + 512 * i, r = n >> 5, ch = n & 31;
            bf16* qp = Zb + (row0 + r) * ZP + ZC_Q + h * 256; bf16* kp = Zb + (row0 + r) * ZP + ZC_K + h * 256;
            const v4u q8 = q8r[i], k8 = k8r[i];
            const f32x4 b0 = *(const LAS f32x4*)(sB + r * 256 + 8 * ch), b1 = *(const LAS f32x4*)(sB + r * 256 + 8 * ch + 4);
            const f32x4 l0 = *(const LAS f32x4*)(sB + 63 * 256 + 8 * ch), l1 = *(const LAS f32x4*)(sB + 63 * 256 + 8 * ch + 4);
            const float qv[8] = {bfl(q8.x), bfh(q8.x), bfl(q8.y), bfh(q8.y), bfl(q8.z), bfh(q8.z), bfl(q8.w), bfh(q8.w)};
            const float kv[8] = {bfl(k8.x), bfh(k8.x), bfl(k8.y), bfh(k8.y), bfl(k8.z), bfh(k8.z), bfl(k8.w), bfh(k8.w)};
            const float bb[8] = {b0.x, b0.y, b0.z, b0.w, b1.x, b1.y, b1.z, b1.w}; const float bl[8] = {l0.x, l0.y, l0.z, l0.w, l1.x, l1.y, l1.z, l1.w};
            float qt[8], kt[8], ke[8];
#pragma unroll
            for (int e = 0; e < 8; ++e) { qt[e] = qv[e] * __expf(bb[e]) * 0.0625f; kt[e] = kv[e] * __expf(-bb[e]); ke[e] = kv[e] * __expf(bl[e] - bb[e]); }
            v4u qw, kw, ew; qw.x = pkbf(qt[0], qt[1]); qw.y = pkbf(qt[2], qt[3]); qw.z = pkbf(qt[4], qt[5]); qw.w = pkbf(qt[6], qt[7]);
            kw.x = pkbf(kt[0], kt[1]); kw.y = pkbf(kt[2], kt[3]); kw.z = pkbf(kt[4], kt[5]); kw.w = pkbf(kt[6], kt[7]);
            ew.x = pkbf(ke[0], ke[1]); ew.y = pkbf(ke[2], ke[3]); ew.z = pkbf(ke[4], ke[5]); ew.w = pkbf(ke[6], ke[7]);
            *(LAS v4u*)(sQ + off_q(r, ch)) = qw; *(LAS v4u*)(sK + off_q(r, ch)) = kw;
            *(GAS v4u*)(kp + 8 * ch) = ew;
            const int p0 = 32 * (ch >> 2) + 16 * (ch & 1) + 4 * ((ch >> 1) & 1);
            v2u w0, w1; w0.x = qw.x; w0.y = qw.y; w1.x = qw.z; w1.y = qw.w;
            *(GAS v2u*)(qp + p0) = w0; *(GAS v2u*)(qp + p0 + 8) = w1; }
        if (tid < 256) DEC[((size_t)b * 128 + c) * 1024 + h * 256 + tid] = __expf(sB[63 * 256 + tid]);
        __syncthreads();
#pragma unroll
        for (int tt = 0; tt < 2; ++tt) { const int T = 2 * wave + tt, jt = T >> 2, it = T & 3;
            f32x4 acc = {0.f, 0.f, 0.f, 0.f};
            if (jt <= it) {
#pragma unroll
                for (int s = 0; s < 8; ++s) { const gl_bf16x8 a = *(const LAS gl_bf16x8*)(sK + off_q(16 * jt + li, 4 * s + g)), bq = *(const LAS gl_bf16x8*)(sQ + off_q(16 * it + li, 4 * s + g));
                    acc = GLA_MFMA(a, bq, acc); } }
            const int i = 16 * it + (int)li, j0 = 16 * jt + 4 * (int)g;
            v2u w; w.x = pkbf(j0 + 0 <= i ? acc[0] : 0.f, j0 + 1 <= i ? acc[1] : 0.f); w.y = pkbf(j0 + 2 <= i ? acc[2] : 0.f, j0 + 3 <= i ? acc[3] : 0.f);
            *(GAS v2u*)(ATT + (size_t)u * 4096 + i * 64 + j0) = w; }
        }
    }
}

struct GlaRegs { v4u k[4], q[4], v[2], a; f32x4 d; };
template <bool WITH_Q>
__device__ __forceinline__ void gla_issue(GlaRegs& R, const bf16* Zb, const bf16* ATT, const float* DEC, int b, int c, int h, int sl, int tid) {
    const size_t row0 = (size_t)b * SEQ + (size_t)c * 64;
#pragma unroll
    for (int i = 0; i < 4; ++i) { const int n = tid + 512 * i, r = n >> 5, ch = n & 31;
        R.k[i] = *(const GAS v4u*)(Zb + (row0 + r) * ZP + ZC_K + h * 256 + 8 * ch);
        if (WITH_Q) R.q[i] = *(const GAS v4u*)(Zb + (row0 + r) * ZP + ZC_Q + h * 256 + 8 * ch); }
#pragma unroll
    for (int i = 0; i < 2; ++i) { const int n = tid + 512 * i, r = n >> 4, ch = n & 15; R.v[i] = *(const GAS v4u*)(Zb + (row0 + r) * ZP + ZC_V + h * 512 + sl * 128 + 8 * ch); }
    if (WITH_Q) { const int r = tid >> 3, ch = tid & 7; const unsigned u = ((unsigned)b << 9) | ((unsigned)c << 2) | (unsigned)h; R.a = *(const GAS v4u*)(ATT + (size_t)u * 4096 + r * 64 + 8 * ch); }
    if (tid < 64) R.d = *(const GAS f32x4*)(DEC + ((size_t)b * 128 + c) * 1024 + h * 256 + 4 * tid);
}
template <bool WITH_Q>
__device__ __forceinline__ void gla_commit(const GlaRegs& R, LAS unsigned char* lds, int tid) {
#pragma unroll
    for (int i = 0; i < 4; ++i) { const int n = tid + 512 * i, r = n >> 5, ch = n & 31;
        *(LAS v4u*)(lds + GL_KE + ((r >> 5) * 2 + (ch >> 4)) * 8192 + off_b(r & 31, ch & 15)) = R.k[i];
        if (WITH_Q) *(LAS v4u*)(lds + GL_QT + off_q(r, ch)) = R.q[i]; }
#pragma unroll
    for (int i = 0; i < 2; ++i) { const int n = tid + 512 * i, r = n >> 4, ch = n & 15; *(LAS v4u*)(lds + GL_V + (r >> 5) * 8192 + off_b(r & 31, ch)) = R.v[i]; }
    if (WITH_Q) { const int r = tid >> 3, ch = tid & 7; *(LAS v4u*)(lds + GL_ATT + off_a(r, ch)) = R.a; }
    if (tid < 64) ((LAS f32x4*)(lds + GL_DEC))[tid] = R.d;
}
__device__ __forceinline__ void gla_update(LAS unsigned char* lds, f32x4 (&S)[16], const gl_bf16x8 (&vf)[2], unsigned lane, unsigned g) {
    const unsigned lbase = (unsigned)(size_t)lds;
#pragma unroll
    for (int i2 = 0; i2 < 8; ++i2) {
        f32x4 d4[2]; gl_bf16x8 kf[2][2];
#pragma unroll
        for (int ii = 0; ii < 2; ++ii) { const int i = 2 * i2 + ii; d4[ii] = *(const LAS f32x4*)(lds + GL_DEC + 4 * (16 * i + 4 * g));
            kf[ii][0] = tr_frag(lbase + GL_KE + (0 * 2 + (i >> 3)) * 8192, lane, i & 7); kf[ii][1] = tr_frag(lbase + GL_KE + (1 * 2 + (i >> 3)) * 8192, lane, i & 7); }
        __builtin_amdgcn_sched_barrier(0);
#pragma unroll
        for (int ii = 0; ii < 2; ++ii) { const int i = 2 * i2 + ii; S[i] = S[i] * d4[ii]; S[i] = GLA_MFMA(kf[ii][0], vf[0], S[i]); S[i] = GLA_MFMA(kf[ii][1], vf[1], S[i]); }
        __builtin_amdgcn_sched_barrier(0);
    }
}

__device__ __forceinline__ void gla_g1(LAS unsigned char* lds, const bf16* Zb, const float* DEC, float* SL, float* DSEG, int bx, int G, int tid0, int lane0, int wave) {
    const int tid = opq(tid0), lane = tid & 63; (void)lane0;
    const unsigned li = lane & 15, g = lane >> 4; const unsigned lbase = (unsigned)(size_t)lds;
    for (int un = bx; un < 256; un += G) {
        const int seg = un & 7, bh = un >> 5, sl = (un >> 3) & 3, b = bh >> 2, h = bh & 3;
        if (seg == 7) continue;
        f32x4 S[16];
#pragma unroll
        for (int i = 0; i < 16; ++i) S[i] = (f32x4){0.f, 0.f, 0.f, 0.f};
        float dprod = 1.0f;
        GlaRegs R; gla_issue<false>(R, Zb, nullptr, DEC, b, seg * GLA_CPS, h, sl, tid);
        for (int cc = 0; cc < GLA_CPS; ++cc) {
            __syncthreads();
            gla_commit<false>(R, lds, tid);
            __syncthreads();
            if (cc + 1 < GLA_CPS) gla_issue<false>(R, Zb, nullptr, DEC, b, seg * GLA_CPS + cc + 1, h, sl, tid);
            if (tid < 256) dprod *= ((LAS float*)(lds + GL_DEC))[tid];
            unsigned lv = (unsigned)lane; asm volatile("" : "+v"(lv));
            gl_bf16x8 vf[2]; vf[0] = tr_frag(lbase + GL_V, lv, wave); vf[1] = tr_frag(lbase + GL_V + 8192, lv, wave);
            gla_update(lds, S, vf, lv, lv >> 4);
        }
        float* pp = SL + ((size_t)(bh * 7 + seg) * 256 + 4 * g) * 512 + sl * 128 + 16 * wave + li;
#pragma unroll
        for (int i = 0; i < 16; ++i) { asm volatile("" : "+v"(pp));
#pragma unroll
            for (int r = 0; r < 4; ++r) pp[r * 512] = S[i][r];
            pp += 16 * 512; }
        if (sl == 0 && tid < 256) DSEG[(bh * 7 + seg) * 256 + tid] = dprod;
    }
}
__device__ __forceinline__ void gla_g2(float* SL, const float* DSEG, int gtid, int NT) {
    for (int it = gtid; it < 8 * 256 * 128; it += NT) { const int bh = it >> 15, dk = (it >> 7) & 255, d4 = it & 127;
        f32x4 s = {0.f, 0.f, 0.f, 0.f};
        for (int seg = 0; seg < 7; ++seg) { GAS f32x4* p = (GAS f32x4*)(SL + ((size_t)(bh * 7 + seg) * 256 + dk) * 512) + d4; const float d = DSEG[(bh * 7 + seg) * 256 + dk];
            s = s * d + *p; *p = s; } }
}
__device__ __forceinline__ void gla_g3_chunk(LAS unsigned char* lds, f32x4 (&S)[16], GlaRegs& R, const bf16* Zb, const bf16* ATT, const float* DEC, float* OF,
                                             int b, int c, int h, int sl, int c_next, bool refill, bool do_update, int tid, int lane, int wave) {
    const unsigned lbase = (unsigned)(size_t)lds;
    __syncthreads();
    gla_commit<true>(R, lds, tid);
    __syncthreads();
    if (refill) gla_issue<true>(R, Zb, ATT, DEC, b, c_next, h, sl, tid);
    unsigned lv = (unsigned)lane; asm volatile("" : "+v"(lv));
    const unsigned li = lv & 15, g = lv >> 4;
    gl_bf16x8 vf[2]; vf[0] = tr_frag(lbase + GL_V, lv, wave); vf[1] = tr_frag(lbase + GL_V + 8192, lv, wave);
    f32x4 o[4];
#pragma unroll
    for (int nt = 0; nt < 4; ++nt) o[nt] = (f32x4){0.f, 0.f, 0.f, 0.f};
#pragma unroll
    for (int s = 0; s < 8; ++s) {
        gl_bf16x8 qf[4];
#pragma unroll
        for (int nt = 0; nt < 4; ++nt) qf[nt] = *(const LAS gl_bf16x8*)(lds + GL_QT + off_q(16 * nt + li, 4 * s + g));
        v4u aw; aw.x = pkbf(S[2 * s][0], S[2 * s][1]); aw.y = pkbf(S[2 * s][2], S[2 * s][3]); aw.z = pkbf(S[2 * s + 1][0], S[2 * s + 1][1]); aw.w = pkbf(S[2 * s + 1][2], S[2 * s + 1][3]);
        const gl_bf16x8 af = __builtin_bit_cast(gl_bf16x8, aw);
        __builtin_amdgcn_sched_barrier(0);
#pragma unroll
        for (int nt = 0; nt < 4; ++nt) o[nt] = GLA_MFMA(af, qf[nt], o[nt]);
        __builtin_amdgcn_sched_barrier(0);
    }
    { gl_bf16x8 tf[6];
#pragma unroll
        for (int nt = 0; nt < 4; ++nt) tf[nt] = *(const LAS gl_bf16x8*)(lds + GL_ATT + off_a(16 * nt + li, g));
#pragma unroll
        for (int nt = 2; nt < 4; ++nt) tf[2 + nt] = *(const LAS gl_bf16x8*)(lds + GL_ATT + off_a(16 * nt + li, 4 + g));
        __builtin_amdgcn_sched_barrier(0);
#pragma unroll
        for (int nt = 0; nt < 4; ++nt) o[nt] = GLA_MFMA(vf[0], tf[nt], o[nt]);
#pragma unroll
        for (int nt = 2; nt < 4; ++nt) o[nt] = GLA_MFMA(vf[1], tf[2 + nt], o[nt]);
        __builtin_amdgcn_sched_barrier(0); }
    bf16* op = (bf16*)OF + ((size_t)b * SEQ + (size_t)c * 64 + li) * D + h * 512 + sl * 128 + 16 * wave + 4 * g;
#pragma unroll
    for (int nt = 0; nt < 4; ++nt) { v2u w; w.x = pkbf(o[nt][0], o[nt][1]); w.y = pkbf(o[nt][2], o[nt][3]); *(GAS v2u*)(op + (size_t)(16 * nt) * D) = w; }
    if (do_update) gla_update(lds, S, vf, lv, g);
}
__device__ __forceinline__ void gla_g3(LAS unsigned char* lds, const bf16* Zb, const bf16* ATT, const float* DEC, const float* SL, float* OF, int bx, int G, int tid0, int lane0, int wave) {
    const int tid = opq(tid0), lane = tid & 63; (void)lane0;
    const unsigned li = lane & 15, g = lane >> 4;
    for (int un = bx; un < 256; un += G) {
        const int seg = un & 7, bh = un >> 5, sl = (un >> 3) & 3, b = bh >> 2, h = bh & 3;
        f32x4 S[16];
        if (seg == 0) {
#pragma unroll
            for (int i = 0; i < 16; ++i) S[i] = (f32x4){0.f, 0.f, 0.f, 0.f};
        } else { const float* pp = SL + ((size_t)(bh * 7 + seg - 1) * 256 + 4 * g) * 512 + sl * 128 + 16 * wave + li;
#pragma unroll
            for (int i = 0; i < 16; ++i) { asm volatile("" : "+v"(pp));
#pragma unroll
                for (int r = 0; r < 4; ++r) S[i][r] = pp[r * 512];
                pp += 16 * 512; } }
        const int c0 = seg * GLA_CPS;
        GlaRegs RA; gla_issue<true>(RA, Zb, ATT, DEC, b, c0, h, sl, tid);
        for (int cc = 0; cc < GLA_CPS; ++cc)
            gla_g3_chunk(lds, S, RA, Zb, ATT, DEC, OF, b, c0 + cc, h, sl, c0 + cc + 1, cc + 1 < GLA_CPS, cc + 1 < GLA_CPS, tid, lane, wave);
    }
}

struct Args { const float* in[20]; float* out; unsigned char* ws; int ph_lo, ph_hi, li, pad; };
constexpr int PH_PER_LAYER = 12, N_PHASES = 2 + 2 * PH_PER_LAYER;

#define IN(k) (lo <= (k) && (k) < hi)
#define SEAM(k) do { if (IN(k) && IN((k) + 1)) xcd_barrier(bar); } while (0)
template <int l> __device__ __forceinline__ void layer_phases(const Args& args, LAS unsigned char* lds, const XcdBarrier& bar, const int lo, const int hi,
                                                             const int tid, const int lane, const int wave, const int G, const int bx, const int vcu, const int gw, const int NGW) {
    unsigned char* ws = args.ws;
    gu32* ctl = (gu32*)(ws + WS_CTL);
    const float* x_in = args.in[0]; const float* ln_mix = args.in[1]; const float* w_in = args.in[2]; const float* w_alpha = args.in[3]; const float* b_alpha = args.in[4];
    const float* gla_norm = args.in[5]; const float* w_pool = args.in[6]; const float* pool_scale = args.in[7]; const float* w_bg = args.in[8]; const float* w_bp = args.in[9];
    const float* w_out = args.in[10]; const float* ln_ffn = args.in[11]; const float* ffn_g = args.in[12]; const float* ffn_u = args.in[13]; const float* ffn_d = args.in[14];
    const float* router_w = args.in[15]; const float* exp_g = args.in[16]; const float* exp_u = args.in[17]; const float* exp_d = args.in[18]; const float* ln_final = args.in[19];
    float* xo = args.out;
    bf16* WinT = (bf16*)(ws + WS_WIN); bf16* BcatT = (bf16*)(ws + WS_BCAT); bf16* WoutT = (bf16*)(ws + WS_WOUT); bf16* FF1T = (bf16*)(ws + WS_FF1); bf16* FF2T = (bf16*)(ws + WS_FF2);
    unsigned char* EF1T = ws + WS_EF1; unsigned char* EF2T = ws + WS_EF2;
    bf16* Hb = (bf16*)(ws + WS_HB); bf16* Zb = (bf16*)(ws + WS_ZB); float* LA = (float*)(ws + WS_LA); float* OF = (float*)(ws + WS_OF);
    bf16* Acat = (bf16*)(ws + WS_ACAT); bf16* Ub = (bf16*)(ws + WS_U); bf16* Hmid = (bf16*)(ws + WS_HMID); unsigned char* Hmid8 = ws + WS_HMID; unsigned char* Hperm8 = ws + WS_HPERM;
    bf16* WA1T = (bf16*)(ws + WS_CTL + 3 * MiB); bf16* WbpT = (bf16*)(ws + WS_OF); bf16* WpS = (bf16*)(ws + WS_OF + 8 * MiB);
    int* slot_of_tok = (int*)(ws + WS_TOKSLOT); int* tok_e = (int*)(ws + WS_TOKE); float* tok_w = (float*)(ws + WS_TOKW); bf16* YS = (bf16*)(ws + WS_LA);
    unsigned* cnt = (unsigned*)(ctl + CW_CNT); unsigned* fill = (unsigned*)(ctl + CW_FILL);

    constexpr int pb = 1 + PH_PER_LAYER * l;
        if (IN(pb + 0)) {
            pg8::Gemm g{Hb, WinT + (size_t)l * ZN * D, M, ZP, D, 0, D, D}; pg8::StaticOrder S; S.init(M, ZP, G, bx);
            pg8::EpiZ E{Zb};
            pg8::gemm_phase<pg8::EpiZ, pg8::StaticOrder, true, true>(lds + RING_OFF, g, S, E);
        }
        SEAM(pb + 0);
        bf16* ATT = (bf16*)(ws + WS_LA); float* DEC = (float*)(ws + WS_LA + 8 * MiB); float* DSEG = (float*)(ws + WS_LA + 10 * MiB); float* SL = (float*)(ws + WS_U);
        if (IN(pb + 1)) gla_g0(lds + RING_OFF, Zb, Hb, WA1T + (size_t)l * 16 * D, w_alpha + (size_t)l * 16 * 1024, b_alpha + l * 1024, ATT, DEC, bx, G, tid, lane, wave);
        SEAM(pb + 1);
        if (IN(pb + 2)) gla_g1(lds + RING_OFF, Zb, DEC, SL, DSEG, bx, G, tid, lane, wave);
        SEAM(pb + 2);
        if (IN(pb + 3)) {
            if (l == 0) {
                pg8::Gemm g{WbpT, WpS, 2 * 4 * 2048, 256, 256, (size_t)256 * 256 * 2, 256, 256}; pg8::PoolOrder S; S.G = G; S.c = bx;
                pg8::EpiPoolW E{BcatT};
                pg8::gemm_phase<pg8::EpiPoolW, pg8::PoolOrder, false, false>(lds + RING_OFF, g, S, E);
            }
            gla_g2(SL, DSEG, vcu * 512 + tid, G * 512);
        }
        SEAM(pb + 3);
        if (IN(pb + 4)) gla_g3(lds + RING_OFF, Zb, ATT, DEC, SL, OF, bx, G, tid, lane, wave);
        SEAM(pb + 4);
        if (IN(pb + 5)) {
            const float* gn = gla_norm + l * HV;
            for (int m = gw; m < M; m += NGW) {
                const f32x4 g0 = *(const GAS f32x4*)(gn + lane * 8), g1 = *(const GAS f32x4*)(gn + lane * 8 + 4);
#pragma unroll
                for (int h = 0; h < NH; ++h) {
                    const v4u ow = *(const GAS v4u*)((const bf16*)OF + (size_t)m * D + h * HV + lane * 8); f32x4 o0 = {bfl(ow.x), bfh(ow.x), bfl(ow.y), bfh(ow.y)}, o1 = {bfl(ow.z), bfh(ow.z), bfl(ow.w), bfh(ow.w)};
                    float s = (o0.x * o0.x + o0.y * o0.y) + (o0.z * o0.z + o0.w * o0.w) + (o1.x * o1.x + o1.y * o1.y) + (o1.z * o1.z + o1.w * o1.w);
                    const float rstd = 1.0f / sqrtf(wave_sum(s) * (1.0f / HV) + EPS);
                    const v4u rw = *(const GAS v4u*)(Zb + (size_t)m * ZP + ZC_R + h * HV + lane * 8);
                    o0 = o0 * rstd * g0; o1 = o1 * rstd * g1;
                    v4u w; w.x = pk2(o0.x * bfl(rw.x), o0.y * bfh(rw.x)); w.y = pk2(o0.z * bfl(rw.y), o0.w * bfh(rw.y)); w.z = pk2(o1.x * bfl(rw.z), o1.y * bfh(rw.z)); w.w = pk2(o1.z * bfl(rw.w), o1.w * bfh(rw.w));
                    *(GAS v4u*)(Acat + (size_t)m * KCAT + h * HV + lane * 8) = w;
                }
                const int t = m & (SEQ - 1), win = 2 << (lane >> 4), nw = (t + 1 < win) ? (t + 1) : win;
                float sm[16], p0[16];
#pragma unroll
                for (int i = 0; i < 16; ++i) { sm[i] = 0.f; p0[i] = 0.f; }
#pragma unroll
                for (int bt = 0; bt < 2; ++bt) {
                    v4u pa[8], pc[8];
#pragma unroll
                    for (int s = 0; s < 8; ++s) { const int sft = 8 * bt + s; pa[s] = (v4u){0u, 0u, 0u, 0u}; pc[s] = (v4u){0u, 0u, 0u, 0u};
                        if (sft < nw) { const GAS v4u* pp = (const GAS v4u*)(Zb + (size_t)(m - sft) * ZP + ZC_P + lane * 16); pa[s] = pp[0]; pc[s] = pp[1]; } }
#pragma unroll
                    for (int s = 0; s < 8; ++s) { const v4u a = pa[s], c = pc[s];
                        const float pv[16] = {bfl(a.x), bfh(a.x), bfl(a.y), bfh(a.y), bfl(a.z), bfh(a.z), bfl(a.w), bfh(a.w), bfl(c.x), bfh(c.x), bfl(c.y), bfh(c.y), bfl(c.z), bfh(c.z), bfl(c.w), bfh(c.w)};
#pragma unroll
                        for (int i = 0; i < 16; ++i) { sm[i] += pv[i]; if (bt == 0 && s == 0) p0[i] = pv[i]; } }
                }
                const float inv = 1.0f / (float)nw;
                v4u w0, w1;
                w0.x = pk2(sm[0] * inv - p0[0], sm[1] * inv - p0[1]); w0.y = pk2(sm[2] * inv - p0[2], sm[3] * inv - p0[3]); w0.z = pk2(sm[4] * inv - p0[4], sm[5] * inv - p0[5]); w0.w = pk2(sm[6] * inv - p0[6], sm[7] * inv - p0[7]);
                w1.x = pk2(sm[8] * inv - p0[8], sm[9] * inv - p0[9]); w1.y = pk2(sm[10] * inv - p0[10], sm[11] * inv - p0[11]); w1.z = pk2(sm[12] * inv - p0[12], sm[13] * inv - p0[13]); w1.w = pk2(sm[14] * inv - p0[14], sm[15] * inv - p0[15]);
                GAS v4u* mp = (GAS v4u*)(Acat + (size_t)m * KCAT + 2048 + lane * 16); mp[0] = w0; mp[1] = w1;
            }
        }
        SEAM(pb + 5);
        if (IN(pb + 6)) {
            pg8::Gemm g{Acat, BcatT + (size_t)l * D * KCAT, M, D, D, 0, KCAT, KCAT}; pg8::StaticOrder S; S.init(M, D, G, bx);
            pg8::EpiGate<false> E{Ub, D, Zb + ZC_GA, ZP};
            pg8::gemm_phase<pg8::EpiGate<false>, pg8::StaticOrder, true, true>(lds + RING_OFF, g, S, E);
        }
        if (IN(pb + 6)) {
            VM_WAIT(); __syncthreads();
            pg8::Gemm g{Acat + 2048, BcatT + (size_t)l * D * KCAT + 2048, M, D, 1024, 0, KCAT, KCAT}; pg8::StaticOrder S; S.init(M, D, G, bx);
            pg8::EpiGate<true> E{Ub, D, Zb + ZC_GB, ZP};
            pg8::gemm_phase<pg8::EpiGate<true>, pg8::StaticOrder, true, true>(lds + RING_OFF, g, S, E);
        }
        SEAM(pb + 6);
        if (IN(pb + 7)) {
            pg8::Gemm g{Ub, WoutT + (size_t)l * D * D, M, D, D, 0, D, D}; pg8::StaticOrder S; S.init(M, D, G, bx);
            pg8::EpiRes E{l == 0 ? x_in : (const float*)xo, xo, D};
            pg8::gemm_phase<pg8::EpiRes, pg8::StaticOrder, true, true>(lds + RING_OFF, g, S, E);
        }
        SEAM(pb + 7);
        if (IN(pb + 8)) {
            if (l == 0) norm_rows<false, DENSE_FP8>(xo, ln_ffn, Hb, gw, NGW, lane, nullptr, nullptr, nullptr, nullptr);
            else {
                LAS float* rw = (LAS float*)(lds + RING_OFF); LAS unsigned* hist = (LAS unsigned*)(lds + RING_OFF + 65536);
                for (int i = tid; i < D * NE / 4; i += 512) ((LAS f32x4*)rw)[i] = ((const GAS f32x4*)router_w)[i];
                if (tid < 8) hist[tid] = 0u;
                __syncthreads();
                norm_rows<true>(xo, ln_ffn + D, Hb, gw, NGW, lane, rw, tok_e, tok_w, hist);
                __syncthreads();
                if (tid < 8) __hip_atomic_fetch_add(cnt + tid, hist[tid], RLX_AGENT);
            }
        }
        SEAM(pb + 8);
        if (l == 0) {
            if (IN(pb + 9)) {
                pg8::StaticOrder S; S.init(M, FFN, G, bx);
                if constexpr (DENSE_FP8) { pg8::Gemm g{Hb, FF1T, M, FFN, D / 2, 0, D / 2, D / 2}; pg8::EpiSwiGLU8 E{Hmid8, DFF};
                    pg8::gemm_phase<pg8::EpiSwiGLU8, pg8::StaticOrder, true, true, true>(lds + RING_OFF, g, S, E); }
                else { pg8::Gemm g{Hb, FF1T, M, FFN, D, 0, D, D}; pg8::EpiSwiGLU E{Hmid, DFF};
                    pg8::gemm_phase<pg8::EpiSwiGLU, pg8::StaticOrder, true, true>(lds + RING_OFF, g, S, E); }
            }
            SEAM(pb + 9);
            if (IN(pb + 10)) {
                pg8::StaticOrder S; S.init(M, D, G, bx); pg8::EpiRes E{xo, xo, D};
                if constexpr (DENSE_FP8) { pg8::Gemm g{Hmid, FF2T, M, D, DFF / 2, 0, DFF / 2, DFF / 2}; pg8::gemm_phase<pg8::EpiRes, pg8::StaticOrder, true, true, true>(lds + RING_OFF, g, S, E); }
                else { pg8::Gemm g{Hmid, FF2T, M, D, DFF, 0, DFF, DFF}; pg8::gemm_phase<pg8::EpiRes, pg8::StaticOrder, true, true>(lds + RING_OFF, g, S, E); }
            }
            SEAM(pb + 10);
            if (IN(pb + 11)) norm_rows<false>(xo, ln_mix + D, Hb, gw, NGW, lane, nullptr, nullptr, nullptr, nullptr);
            SEAM(pb + 11);
        } else {
            if (IN(pb + 9)) {
                LAS unsigned* lcnt = (LAS unsigned*)(lds + RING_OFF); LAS unsigned* lbase = lcnt + 8; LAS int* lslot = (LAS int*)(lcnt + 16);
                int brow[8]; { int p = 0;
#pragma unroll
                    for (int e = 0; e < 8; ++e) { brow[e] = 256 * p; p += (int)((__hip_atomic_load(cnt + e, RLX_AGENT) + 255u) >> 8); } }
                for (int ch = bx; ch < M / 64; ch += G) {
                    __syncthreads();
                    if (tid < 8) lcnt[tid] = 0u;
                    __syncthreads();
                    int e = 0, tok = 0; unsigned rank = 0;
                    if (tid < 128) { tok = ch * 64 + (tid >> 1); e = tok_e[2 * tok + (tid & 1)]; rank = __hip_atomic_fetch_add(lcnt + e, 1u, __ATOMIC_RELAXED, __HIP_MEMORY_SCOPE_WORKGROUP); }
                    __syncthreads();
                    if (tid < 8) lbase[tid] = __hip_atomic_fetch_add(fill + tid, lcnt[tid], RLX_AGENT);
                    __syncthreads();
                    if (tid < 128) { int br = 0;
#pragma unroll
                        for (int q = 0; q < 8; ++q) br = (e == q) ? brow[q] : br;
                        const int slot = br + (int)lbase[e] + (int)rank; lslot[tid] = slot; slot_of_tok[2 * tok + (tid & 1)] = slot; }
                    __syncthreads();
                    for (int en = wave; en < 128; en += NWAVES) { const int tk = ch * 64 + (en >> 1), slot = lslot[en];
                        const GAS v4u* src = (const GAS v4u*)(Hb + (size_t)tk * D) + 4 * lane; GAS v4u* dst = (GAS v4u*)(Hperm8 + (size_t)slot * D) + 2 * lane;
#pragma unroll
                        for (int j = 0; j < 2; ++j) { const v4u a = src[2 * j], c = src[2 * j + 1]; v4u o;
                            o.x = pg8::pk4_fp8(bfl(a.x), bfh(a.x), bfl(a.y), bfh(a.y)); o.y = pg8::pk4_fp8(bfl(a.z), bfh(a.z), bfl(a.w), bfh(a.w));
                            o.z = pg8::pk4_fp8(bfl(c.x), bfh(c.x), bfl(c.y), bfh(c.y)); o.w = pg8::pk4_fp8(bfl(c.z), bfh(c.z), bfl(c.w), bfh(c.w)); dst[j] = o; } }
                }
            }
            SEAM(pb + 9);
            if (IN(pb + 10)) {
                pg8::Gemm g{(const bf16*)Hperm8, (const bf16*)EF1T, MAXSLOT, FFN, D / 2, (size_t)FFN * D, D / 2, D / 2}; pg8::MoeOrder S; S.init(cnt, FFN / 256, G, bx);
                pg8::EpiSwiGLU8 E{Hmid8, DFF};
                pg8::gemm_phase<pg8::EpiSwiGLU8, pg8::MoeOrder, true, true, true>(lds + RING_OFF, g, S, E);
            }
            SEAM(pb + 10);
            if (IN(pb + 11)) {
                pg8::Gemm g{(const bf16*)Hmid8, (const bf16*)EF2T, MAXSLOT, D, DFF / 2, (size_t)D * DFF, DFF / 2, DFF / 2}; pg8::MoeOrder S; S.init(cnt, D / 256, G, bx);
                pg8::EpiBf16 E{YS, D};
                pg8::gemm_phase<pg8::EpiBf16, pg8::MoeOrder, true, true, true>(lds + RING_OFF, g, S, E);
            }
            SEAM(pb + 11);
        }
}

__global__ void __launch_bounds__(NWAVES * 64, 2) fwd(Args args) {
    extern __shared__ __attribute__((aligned(16))) unsigned char lds_raw[];
    LAS unsigned char* lds = (LAS unsigned char*)lds_raw;
    volatile LAS unsigned* MISC = (volatile LAS unsigned*)(lds + MISC_OFF);
    const int tid = threadIdx.x, lane = tid & 63, wave = __builtin_amdgcn_readfirstlane(tid >> 6);
    const int G = gridDim.x, bx = blockIdx.x;
    const int vcu = (G % 8 == 0) ? (bx % 8) * (G / 8) + bx / 8 : bx;
    const int gw = vcu * NWAVES + wave, NGW = G * NWAVES;
    unsigned char* ws = args.ws;
    gu32* ctl = (gu32*)(ws + WS_CTL);
    const float* x_in = args.in[0]; const float* ln_mix = args.in[1]; const float* w_in = args.in[2]; const float* w_alpha = args.in[3]; const float* b_alpha = args.in[4];
    const float* gla_norm = args.in[5]; const float* w_pool = args.in[6]; const float* pool_scale = args.in[7]; const float* w_bg = args.in[8]; const float* w_bp = args.in[9];
    const float* w_out = args.in[10]; const float* ln_ffn = args.in[11]; const float* ffn_g = args.in[12]; const float* ffn_u = args.in[13]; const float* ffn_d = args.in[14];
    const float* router_w = args.in[15]; const float* exp_g = args.in[16]; const float* exp_u = args.in[17]; const float* exp_d = args.in[18]; const float* ln_final = args.in[19];
    float* xo = args.out;
    bf16* WinT = (bf16*)(ws + WS_WIN); bf16* BcatT = (bf16*)(ws + WS_BCAT); bf16* WoutT = (bf16*)(ws + WS_WOUT); bf16* FF1T = (bf16*)(ws + WS_FF1); bf16* FF2T = (bf16*)(ws + WS_FF2);
    unsigned char* EF1T = ws + WS_EF1; unsigned char* EF2T = ws + WS_EF2;
    bf16* Hb = (bf16*)(ws + WS_HB); bf16* Zb = (bf16*)(ws + WS_ZB); float* LA = (float*)(ws + WS_LA); float* OF = (float*)(ws + WS_OF);
    bf16* Acat = (bf16*)(ws + WS_ACAT); bf16* Ub = (bf16*)(ws + WS_U); bf16* Hmid = (bf16*)(ws + WS_HMID); unsigned char* Hmid8 = ws + WS_HMID; unsigned char* Hperm8 = ws + WS_HPERM;
    bf16* WA1T = (bf16*)(ws + WS_CTL + 3 * MiB); bf16* WbpT = (bf16*)(ws + WS_OF); bf16* WpS = (bf16*)(ws + WS_OF + 8 * MiB);
    int* slot_of_tok = (int*)(ws + WS_TOKSLOT); int* tok_e = (int*)(ws + WS_TOKE); float* tok_w = (float*)(ws + WS_TOKW); bf16* YS = (bf16*)(ws + WS_LA);
    unsigned* cnt = (unsigned*)(ctl + CW_CNT); unsigned* fill = (unsigned*)(ctl + CW_FILL);

    for (int u = tid; u < (LDS_BYTES - LDSCTL_OFF) / 4; u += NWAVES * 64) ((LAS unsigned*)(lds + LDSCTL_OFF))[u] = 0u;
    __syncthreads();
    const int lo = args.ph_lo, hi = args.ph_hi;
    XcdBarrier bar; bar.bar = (unsigned*)(ctl + CW_BAR); bar.x = 0; bar.st = nullptr;
    if (hi - lo > 1) bar = xcd_barrier_post((unsigned*)(ctl + CW_BAR), MISC + 8);

    if (IN(0)) {
        LAS unsigned* Tl = (LAS unsigned*)(lds + RING_OFF + wave * 16384);
#ifdef PROBE_NOW
        const int PNW = (args.li == 7);
#else
        constexpr int PNW = 0;
#endif
        for (int i = vcu * 512 + tid; i < 2 * 16 * D; i += G * 512) { const int l = i >> 15, r = (i >> 11) & 15, k = i & 2047; WA1T[i] = (bf16)f2bf(w_in[(size_t)l * D * DIN + (size_t)k * DIN + 6144 + r]); }
        for (int i = vcu * 512 + tid; i < 2 * 4 * 256 * 256 / 4; i += G * 512) { const int d4 = i & 63, lg = i >> 14;
            const f32x4 w = ((const GAS f32x4*)w_pool)[i], s = ((const GAS f32x4*)pool_scale)[lg * 64 + d4];
            v2u o; o.x = pkbf(w.x * s.x, w.y * s.y); o.y = pkbf(w.z * s.z, w.w * s.w); ((GAS v2u*)WpS)[i] = o; }
#ifdef PROBE_NOSTORE
        const int PNS = (args.li == 7);
#else
        constexpr int PNS = 0;
#endif
        constexpr int T_LAYER = 8192, T_DENSE = 8448, T_ALL = 2 * T_LAYER + T_DENSE + 8 * T_DENSE;
        auto decode = [&](int it, TrJob& J) {
            J.mode = 0; J.row_off = 0; J.kind = 0; int kt, nt;
            if (it < 2 * T_LAYER) { const int l = it / T_LAYER, r = it % T_LAYER; const float* wi = w_in + (size_t)l * D * DIN; unsigned char* wt = (unsigned char*)(WinT + (size_t)l * ZN * D);
                if (r < 3072) { J.src = wi; J.ldw = DIN; J.dst = wt; J.ldt = 2 * D; kt = r / 96; nt = r % 96; }
                else if (r < 5632) { const int q = r - 3072; J.src = wi + 6160; J.ldw = DIN; J.dst = wt; J.ldt = 2 * D; J.row_off = 6144; kt = q / 80; nt = q % 80; }
                else if (r < 6656) { const int q = r - 5632; J.src = w_bg + (size_t)l * D * D; J.ldw = D; J.dst = (unsigned char*)(BcatT + (size_t)l * D * KCAT); J.ldt = 2 * KCAT; kt = q >> 5; nt = q & 31; }
                else if (r < 7680) { const int q = r - 6656; J.src = w_out + (size_t)l * D * D; J.ldw = D; J.dst = (unsigned char*)(WoutT + (size_t)l * D * D); J.ldt = 2 * D; kt = q >> 5; nt = q & 31; }
                else { const int q = r - 7680; kt = q >> 5; nt = q & 31;
                    J.src = w_bp + (size_t)l * 1024 * D + (size_t)(64 * kt) * D + 64 * nt; J.ldw = D; J.dst = (unsigned char*)(WbpT + ((size_t)(l * 4 + (kt >> 2)) * 2048) * 256); J.ldt = 512; J.k0 = 64 * (kt & 3); J.n0 = 64 * nt; return; }
                J.k0 = 64 * kt; J.n0 = 64 * nt;
            } else if (it < 2 * T_LAYER + T_DENSE) { const int r = it - 2 * T_LAYER, j = r / 2816, q = r % 2816;
                if (DENSE_FP8) { J.kind = 1;
                    if (j == 0) { J.src = ffn_g; J.ldw = DFF; J.dst = (unsigned char*)FF1T; J.ldt = D; J.mode = 1; kt = q / 176; nt = q % 176; }
                    else if (j == 1) { J.src = ffn_u; J.ldw = DFF; J.dst = (unsigned char*)FF1T; J.ldt = D; J.mode = 1; J.row_off = 128; kt = q / 176; nt = q % 176; }
                    else { J.src = ffn_d; J.ldw = D; J.dst = (unsigned char*)FF2T; J.ldt = DFF; kt = q >> 6; nt = q & 63; }
                    J.k0 = 128 * kt; J.n0 = 32 * nt;
                } else {
                if (j == 0) { J.src = ffn_g; J.ldw = DFF; J.dst = (unsigned char*)FF1T; J.ldt = 2 * D; J.mode = 1; kt = q / 88; nt = q % 88; }
                else if (j == 1) { J.src = ffn_u; J.ldw = DFF; J.dst = (unsigned char*)FF1T; J.ldt = 2 * D; J.mode = 1; J.row_off = 128; kt = q / 88; nt = q % 88; }
                else { J.src = ffn_d; J.ldw = D; J.dst = (unsigned char*)FF2T; J.ldt = 2 * DFF; kt = q >> 5; nt = q & 31; }
                J.k0 = 64 * kt; J.n0 = 64 * nt; }
            } else { const int r = it - 2 * T_LAYER - T_DENSE, e = r / T_DENSE, r2 = r % T_DENSE, j = r2 / 2816, q = r2 % 2816; J.kind = 1;
                if (j == 0) { J.src = exp_g + (size_t)e * D * DFF; J.ldw = DFF; J.dst = EF1T + (size_t)e * FFN * D; J.ldt = D; J.mode = 1; kt = q / 176; nt = q % 176; }
                else if (j == 1) { J.src = exp_u + (size_t)e * D * DFF; J.ldw = DFF; J.dst = EF1T + (size_t)e * FFN * D; J.ldt = D; J.mode = 1; J.row_off = 128; kt = q / 176; nt = q % 176; }
                else { J.src = exp_d + (size_t)e * DFF * D; J.ldw = D; J.dst = EF2T + (size_t)e * D * DFF; J.ldt = DFF; kt = q >> 6; nt = q & 63; }
                J.k0 = 128 * kt; J.n0 = 32 * nt;
            }
            J.src += (size_t)J.k0 * J.ldw + J.n0;
        };
        if (gw < T_ALL) {
            TrJob J, Jn; f32x4 R[16], Rn[16];
            decode(gw, J); tr_load(J, R, lane);
            for (int it = gw; it < T_ALL; it += NGW) {
                const bool more = it + NGW < T_ALL;
                if (more) { decode(it + NGW, Jn); tr_load(Jn, Rn, lane); }
                tr_finish(J, R, Tl, lane, PNS && J.kind == 1);
                if (more) { J = Jn;
#pragma unroll
                    for (int i = 0; i < 16; ++i) R[i] = Rn[i]; }
            }
        }
        norm_rows<false>(x_in, ln_mix, Hb, gw, NGW, lane, nullptr, nullptr, nullptr, nullptr);
    }
    SEAM(0);
#ifdef PROBE_XBAR
    if (hi - lo > 1) for (int i = 0; i < PROBE_XBAR; ++i) xcd_barrier(bar);
#endif

    layer_phases<0>(args, lds, bar, lo, hi, tid, lane, wave, G, bx, vcu, gw, NGW);
    layer_phases<1>(args, lds, bar, lo, hi, tid, lane, wave, G, bx, vcu, gw, NGW);
    if (IN(N_PHASES - 1)) {
        f32x4 nx[8]; v2u na[8], nc[8]; float nw1 = 0.f, nw2 = 0.f;
#define FINAL_FETCH(mm) do { const int m_ = (mm); const GAS f32x4* xr_ = (const GAS f32x4*)(xo + (size_t)m_ * D) + lane; \
            const int s1_ = slot_of_tok[2 * m_], s2_ = slot_of_tok[2 * m_ + 1]; nw1 = tok_w[2 * m_]; nw2 = tok_w[2 * m_ + 1]; \
            const GAS v2u* y1_ = (const GAS v2u*)(YS + (size_t)s1_ * D) + lane; const GAS v2u* y2_ = (const GAS v2u*)(YS + (size_t)s2_ * D) + lane; \
            _Pragma("unroll") for (int j = 0; j < 8; ++j) { nx[j] = xr_[64 * j]; na[j] = y1_[64 * j]; nc[j] = y2_[64 * j]; } } while (0)
        if (gw < M) FINAL_FETCH(gw);
        for (int m = gw; m < M; m += NGW) {
            GAS f32x4* xr = (GAS f32x4*)(xo + (size_t)m * D) + lane;
            const float w1 = nw1, w2 = nw2;
            f32x4 v[8]; float s = 0.f;
#pragma unroll
            for (int j = 0; j < 8; ++j) { const v2u a = na[j], c = nc[j]; f32x4 t = nx[j];
                t.x += w1 * bfl(a.x) + w2 * bfl(c.x); t.y += w1 * bfh(a.x) + w2 * bfh(c.x); t.z += w1 * bfl(a.y) + w2 * bfl(c.y); t.w += w1 * bfh(a.y) + w2 * bfh(c.y);
                v[j] = t; s += (t.x * t.x + t.y * t.y) + (t.z * t.z + t.w * t.w); }
            if (m + NGW < M) FINAL_FETCH(m + NGW);
            const float rstd = 1.0f / sqrtf(wave_sum(s) * (1.0f / D) + EPS);
#pragma unroll
            for (int j = 0; j < 8; ++j) { const f32x4 g4 = ((const GAS f32x4*)ln_final)[lane + 64 * j]; xr[64 * j] = v[j] * rstd * g4; }
        }
    }
#undef IN
#undef SEAM
}

#ifndef MK_ONE_LAUNCH
#define MK_ONE_LAUNCH 1
#endif
#ifndef PROBE_DUP
#define PROBE_DUP -1
#endif
#ifndef PROBE_REP
#define PROBE_REP 1
#endif
extern "C" void kernel_launch(void* const* d_in, const int* in_sizes, int n_in, void* d_out, int out_size, void* d_ws, size_t ws_size, hipStream_t stream) {
    static int grid = 0;
    if (grid == 0) {
        if (n_in != 20 || in_sizes[0] != M * D || out_size != M * D || ws_size < WS_END) { fprintf(stderr, "kernel_launch: unexpected shapes / workspace (n_in %d, in0 %d, out %d, ws %zu < %zu); nothing launched\n", n_in, n_in > 0 ? in_sizes[0] : -1, out_size, ws_size, (size_t)WS_END); grid = -1; return; }
        int dev = 0, cus = 0, per_cu = 0;
        if (hipGetDevice(&dev) != hipSuccess || hipDeviceGetAttribute(&cus, hipDeviceAttributeMultiprocessorCount, dev) != hipSuccess) { grid = -1; return; }
        if (hipFuncSetAttribute((const void*)fwd, hipFuncAttributeMaxDynamicSharedMemorySize, LDS_BYTES) != hipSuccess) { fprintf(stderr, "kernel_launch: hipFuncSetAttribute failed\n"); grid = -1; return; }
        if (hipOccupancyMaxActiveBlocksPerMultiprocessor(&per_cu, (const void*)fwd, NWAVES * 64, LDS_BYTES) != hipSuccess || per_cu < 1) { fprintf(stderr, "kernel_launch: occupancy query reports %d workgroups per CU\n", per_cu); }
        (void)hipGetLastError();
        grid = cus;
    }
    if (grid < 0) return;
    if (hipMemsetAsync((char*)d_ws + WS_CTL, 0, CTL_ZERO_BYTES, stream) != hipSuccess) return;
    Args a{};
    for (int i = 0; i < 20; ++i) a.in[i] = (const float*)d_in[i];
    a.out = (float*)d_out; a.ws = (unsigned char*)d_ws;
#if MK_ONE_LAUNCH
    a.ph_lo = 0; a.ph_hi = N_PHASES; a.li = 0;
    hipLaunchKernelGGL(fwd, dim3(grid), dim3(NWAVES * 64), LDS_BYTES, stream, a);
#else
    for (int p = 0; p < N_PHASES; ++p) { a.ph_lo = p; a.ph_hi = p + 1;
        if (p == PROBE_DUP) { a.li = 7; for (int r = 0; r < PROBE_REP; ++r) hipLaunchKernelGGL(fwd, dim3(grid), dim3(NWAVES * 64), LDS_BYTES, stream, a); }
        a.li = 0; hipLaunchKernelGGL(fwd, dim3(grid), dim3(NWAVES * 64), LDS_BYTES, stream, a); }
#endif
}
```

```cpp
#include <hip/hip_runtime.h>
#include <cstdio>
#include <cstdint>

namespace pg8 {
#define PG8_LAS __attribute__((address_space(3)))
typedef unsigned short bf16_t;
typedef short bf16x8 __attribute__((ext_vector_type(8)));
typedef float f32x4 __attribute__((ext_vector_type(4)));
typedef unsigned u32x4 __attribute__((ext_vector_type(4)));
typedef unsigned u32x2 __attribute__((ext_vector_type(2)));
constexpr int BM = 256, BK = 64, HALF = 128, HTB = HALF * BK * 2  , STAGE_BYTES = 8 * HTB, NXCD = 8, WGM = 8;

__host__ __device__ __forceinline__ int lds_byte(int r, int c) { const int st = (r >> 4) * 2 + (c >> 5), rr = r & 15, cc = c & 31, ob = rr * 64 + cc * 2; return st * 1024 + (ob ^ (((ob >> 9) & 1) << 5)); }
__host__ __device__ __forceinline__ void stage_rc(int b, int& R, int& C) { const int st = b / 1024, sb = b % 1024, swz = sb ^ (((sb >> 9) & 1) << 5); R = (st >> 1) * 16 + swz / 64; C = (st & 1) * 32 + (swz % 64) / 2; }
__host__ __device__ __forceinline__ int perm32(int rho) { const int n = rho >> 4, i = rho & 15; return 8 * (i >> 2) + 4 * n + (i & 3); }

struct Unit { int pm, pn, be; };
struct Gemm { const bf16_t* A; const bf16_t* Bt; int M, N, K; size_t bstride; int lda, ldb; };

struct StaticOrder {
    int nM, nN, nwg, G, c;
    __host__ __device__ void init(int M, int N, int G_, int c_) { nM = M / BM; nN = N / BM; nwg = nM * nN; G = G_; c = c_; }
    __host__ __device__ bool next(int i, Unit& u) const {
        const long L = (long)i * G + c; if (L >= nwg) return false;
        int wgid = (int)L; { const int q = nwg / NXCD, r = nwg % NXCD, xcd = wgid % NXCD, off = wgid / NXCD; wgid = (xcd < r ? xcd * (q + 1) : r * (q + 1) + (xcd - r) * q) + off; }
        const int nig = WGM * nN, gid = wgid / nig, fm = gid * WGM, gsz = (nM - fm) < WGM ? (nM - fm) : WGM;
        u.pm = fm + ((wgid % nig) % gsz); u.pn = (wgid % nig) / gsz; u.be = 0; return true;
    }
    __device__ __forceinline__ void a_ready(const Unit&) const {}
    __device__ __forceinline__ void done(const Unit&) const {}
};
struct PoolOrder {
    int G, c;
    __device__ __forceinline__ bool next(int i, Unit& u) const { const int L = i * G + c; if (L >= 64) return false; u.pm = L; u.pn = 0; u.be = L >> 3; return true; }
    __device__ __forceinline__ void a_ready(const Unit&) const {}
    __device__ __forceinline__ void done(const Unit&) const {}
};
struct MoeOrder {
    int nM, nN, nwg, G, c; int pe[8];
    __device__ __forceinline__ void init(const unsigned* cnt, int nN_, int G_, int c_) {
        int p = 0;
#pragma unroll
        for (int e = 0; e < 8; ++e) { p += (int)((__hip_atomic_load(cnt + e, __ATOMIC_RELAXED, __HIP_MEMORY_SCOPE_AGENT) + 255u) >> 8); pe[e] = p; }
        nM = p; nN = nN_; nwg = nM * nN; G = G_; c = c_;
    }
    __device__ __forceinline__ bool next(int i, Unit& u) const {
        const long L = (long)i * G + c; if (L >= nwg) return false;
        int wgid = (int)L; { const int q = nwg / NXCD, r = nwg % NXCD, xcd = wgid % NXCD, off = wgid / NXCD; wgid = (xcd < r ? xcd * (q + 1) : r * (q + 1) + (xcd - r) * q) + off; }
        const int nig = WGM * nN, gid = wgid / nig, fm = gid * WGM, gsz = (nM - fm) < WGM ? (nM - fm) : WGM;
        u.pm = fm + ((wgid % nig) % gsz); u.pn = (wgid % nig) / gsz;
        int be = 0;
#pragma unroll
        for (int e = 0; e < 7; ++e) be += (u.pm >= pe[e]) ? 1 : 0;
        u.be = be; return true;
    }
    __device__ __forceinline__ void a_ready(const Unit&) const {}
    __device__ __forceinline__ void done(const Unit&) const {}
};

__device__ __forceinline__ unsigned cvt_pk_bf16(float lo, float hi) { unsigned r; asm volatile("v_cvt_pk_bf16_f32 %0, %1, %2" : "=v"(r) : "v"(lo), "v"(hi)); return r; }
__device__ __forceinline__ float bf_lo(unsigned w) { return __uint_as_float(w << 16); }
__device__ __forceinline__ float bf_hi(unsigned w) { return __uint_as_float(w & 0xffff0000u); }
__device__ __forceinline__ float fsigmoid(float x) { return __builtin_amdgcn_rcpf(1.0f + __expf(-x)); }
__device__ __forceinline__ float fsilu(float x) { return x * __builtin_amdgcn_rcpf(1.0f + __expf(-x)); }
__device__ __forceinline__ float flogsig(float x) { return fminf(x, 0.0f) - __logf(1.0f + __expf(-fabsf(x))); }

constexpr int ZP_ = 11264;
struct EpiZ {
    static constexpr bool PERM = true, AFTER_DRAIN = false;
    bf16_t* Zb;
    __device__ __forceinline__ void operator()(const f32x4 (&acc)[2][2][4][2], const Unit& u, int wr, int wc, int fr, int fq) const {
        const int row0 = u.pm * BM + wr * 64 + fr; const int pn = u.pn;
        const int mode = (pn >= 16 && pn < 24) ? 1 : (pn >= 28 ? 2 : 0);
        const int col0 = pn * BM + wc * 32 + 8 * fq;
#pragma unroll
        for (int ai = 0; ai < 2; ++ai)
#pragma unroll
            for (int m = 0; m < 4; ++m) { bf16_t* rowp = Zb + (size_t)(row0 + ai * HALF + m * 16) * ZP_ + col0;
#pragma unroll
                for (int bj = 0; bj < 2; ++bj) { f32x4 v0 = acc[ai][bj][m][0], v1 = acc[ai][bj][m][1];
                    if (mode == 1) {
#pragma unroll
                        for (int j = 0; j < 4; ++j) { v0[j] = fsilu(v0[j]); v1[j] = fsilu(v1[j]); } }
                    else if (mode == 2) {
#pragma unroll
                        for (int j = 0; j < 4; ++j) { v0[j] = fsigmoid(v0[j]); v1[j] = fsigmoid(v1[j]); } }
                    u32x4 w; w.x = cvt_pk_bf16(v0[0], v0[1]); w.y = cvt_pk_bf16(v0[2], v0[3]); w.z = cvt_pk_bf16(v1[0], v1[1]); w.w = cvt_pk_bf16(v1[2], v1[3]);
                    *(u32x4*)(rowp + bj * HALF) = w; } }
    }
};
template <bool ACCUM> struct EpiGate {
    static constexpr bool PERM = true, AFTER_DRAIN = false;
    bf16_t* U; int ldu; const bf16_t* G; int ldg;
    __device__ __forceinline__ void operator()(const f32x4 (&acc)[2][2][4][2], const Unit& u, int wr, int wc, int fr, int fq) const {
        const int row0 = u.pm * BM + wr * 64 + fr, col0 = u.pn * BM + wc * 32 + 8 * fq;
#pragma unroll
        for (int ai = 0; ai < 2; ++ai) {
            u32x4 gw[4][2], ow[4][2];
#pragma unroll
            for (int m = 0; m < 4; ++m) { const size_t r = (size_t)(row0 + ai * HALF + m * 16);
#pragma unroll
                for (int bj = 0; bj < 2; ++bj) { gw[m][bj] = *(const u32x4*)(G + r * ldg + col0 + bj * HALF); if (ACCUM) ow[m][bj] = *(const u32x4*)(U + r * ldu + col0 + bj * HALF); } }
            __builtin_amdgcn_sched_barrier(0);
#pragma unroll
            for (int m = 0; m < 4; ++m) { bf16_t* up = U + (size_t)(row0 + ai * HALF + m * 16) * ldu + col0;
#pragma unroll
                for (int bj = 0; bj < 2; ++bj) { const u32x4 g4 = gw[m][bj]; f32x4 v0 = acc[ai][bj][m][0], v1 = acc[ai][bj][m][1];
                    v0[0] *= bf_lo(g4.x); v0[1] *= bf_hi(g4.x); v0[2] *= bf_lo(g4.y); v0[3] *= bf_hi(g4.y); v1[0] *= bf_lo(g4.z); v1[1] *= bf_hi(g4.z); v1[2] *= bf_lo(g4.w); v1[3] *= bf_hi(g4.w);
                    if (ACCUM) { const u32x4 o4 = ow[m][bj];
                        v0[0] += bf_lo(o4.x); v0[1] += bf_hi(o4.x); v0[2] += bf_lo(o4.y); v0[3] += bf_hi(o4.y); v1[0] += bf_lo(o4.z); v1[1] += bf_hi(o4.z); v1[2] += bf_lo(o4.w); v1[3] += bf_hi(o4.w); }
                    u32x4 w; w.x = cvt_pk_bf16(v0[0], v0[1]); w.y = cvt_pk_bf16(v0[2], v0[3]); w.z = cvt_pk_bf16(v1[0], v1[1]); w.w = cvt_pk_bf16(v1[2], v1[3]);
                    *(u32x4*)(up + bj * HALF) = w; } }
            __builtin_amdgcn_sched_barrier(0);
        }
    }
};
struct EpiRes {
    static constexpr bool PERM = false, AFTER_DRAIN = false;
    const float* base; float* out; int ldc;
    __device__ __forceinline__ void operator()(const f32x4 (&acc)[2][2][4][2], const Unit& u, int wr, int wc, int fr, int fq) const {
        const int row0 = u.pm * BM + wr * 64 + fr, col0 = u.pn * BM + wc * 32 + 4 * fq;
#pragma unroll
        for (int ai = 0; ai < 2; ++ai) {
            f32x4 bs[4][2][2];
#pragma unroll
            for (int m = 0; m < 4; ++m) { const size_t off = (size_t)(row0 + ai * HALF + m * 16) * ldc + col0;
#pragma unroll
                for (int bj = 0; bj < 2; ++bj)
#pragma unroll
                    for (int n = 0; n < 2; ++n) bs[m][bj][n] = *(const f32x4*)(base + off + bj * HALF + n * 16); }
            __builtin_amdgcn_sched_barrier(0);
#pragma unroll
            for (int m = 0; m < 4; ++m) { const size_t off = (size_t)(row0 + ai * HALF + m * 16) * ldc + col0;
#pragma unroll
                for (int bj = 0; bj < 2; ++bj)
#pragma unroll
                    for (int n = 0; n < 2; ++n) *(f32x4*)(out + off + bj * HALF + n * 16) = bs[m][bj][n] + acc[ai][bj][m][n]; }
            __builtin_amdgcn_sched_barrier(0);
        }
    }
};
struct EpiSwiGLU {
    static constexpr bool PERM = true, AFTER_DRAIN = false;
    bf16_t* Hm; int ldh;
    __device__ __forceinline__ void operator()(const f32x4 (&acc)[2][2][4][2], const Unit& u, int wr, int wc, int fr, int fq) const {
        const int row0 = u.pm * BM + wr * 64 + fr, colh = u.pn * HALF + wc * 32 + 8 * fq;
#pragma unroll
        for (int ai = 0; ai < 2; ++ai)
#pragma unroll
            for (int m = 0; m < 4; ++m) { bf16_t* rowp = Hm + (size_t)(row0 + ai * HALF + m * 16) * ldh + colh;
                const f32x4 g0 = acc[ai][0][m][0], g1 = acc[ai][0][m][1], u0 = acc[ai][1][m][0], u1 = acc[ai][1][m][1];
                u32x4 w; w.x = cvt_pk_bf16(fsilu(g0[0]) * u0[0], fsilu(g0[1]) * u0[1]); w.y = cvt_pk_bf16(fsilu(g0[2]) * u0[2], fsilu(g0[3]) * u0[3]);
                w.z = cvt_pk_bf16(fsilu(g1[0]) * u1[0], fsilu(g1[1]) * u1[1]); w.w = cvt_pk_bf16(fsilu(g1[2]) * u1[2], fsilu(g1[3]) * u1[3]);
                *(u32x4*)rowp = w; }
    }
};
struct EpiBf16 {
    static constexpr bool PERM = true, AFTER_DRAIN = false;
    bf16_t* O; int ldc;
    __device__ __forceinline__ void operator()(const f32x4 (&acc)[2][2][4][2], const Unit& u, int wr, int wc, int fr, int fq) const {
        const int row0 = u.pm * BM + wr * 64 + fr, col0 = u.pn * BM + wc * 32 + 8 * fq;
#pragma unroll
        for (int ai = 0; ai < 2; ++ai)
#pragma unroll
            for (int m = 0; m < 4; ++m) { bf16_t* rowp = O + (size_t)(row0 + ai * HALF + m * 16) * ldc + col0;
#pragma unroll
                for (int bj = 0; bj < 2; ++bj) { const f32x4 v0 = acc[ai][bj][m][0], v1 = acc[ai][bj][m][1];
                    u32x4 w; w.x = cvt_pk_bf16(v0[0], v0[1]); w.y = cvt_pk_bf16(v0[2], v0[3]); w.z = cvt_pk_bf16(v1[0], v1[1]); w.w = cvt_pk_bf16(v1[2], v1[3]);
                    *(u32x4*)(rowp + bj * HALF) = w; } }
    }
};

typedef int i32x8 __attribute__((ext_vector_type(8)));
typedef int i32x4 __attribute__((ext_vector_type(4)));
constexpr int FP8_WSCALE = 127 - 6;
__device__ __forceinline__ i32x8 pg8_cat(const bf16x8& a, const bf16x8& b) { return __builtin_shufflevector(__builtin_bit_cast(i32x4, a), __builtin_bit_cast(i32x4, b), 0, 1, 2, 3, 4, 5, 6, 7); }
__device__ __forceinline__ unsigned pk4_fp8(float a, float b, float c, float d) { int w = __builtin_amdgcn_cvt_pk_fp8_f32(a, b, 0, false); w = __builtin_amdgcn_cvt_pk_fp8_f32(c, d, w, true); return (unsigned)w; }
struct EpiSwiGLU8 {
    static constexpr bool PERM = true, AFTER_DRAIN = false;
    unsigned char* Hm; int ldh;
    __device__ __forceinline__ void operator()(const f32x4 (&acc)[2][2][4][2], const Unit& u, int wr, int wc, int fr, int fq) const {
        const int row0 = u.pm * BM + wr * 64 + fr, colh = u.pn * HALF + wc * 32 + 8 * fq;
#pragma unroll
        for (int ai = 0; ai < 2; ++ai)
#pragma unroll
            for (int m = 0; m < 4; ++m) { unsigned char* rowp = Hm + (size_t)(row0 + ai * HALF + m * 16) * ldh + colh;
                const f32x4 g0 = acc[ai][0][m][0], g1 = acc[ai][0][m][1], u0 = acc[ai][1][m][0], u1 = acc[ai][1][m][1];
                u32x2 w; w.x = pk4_fp8(fsilu(g0[0]) * u0[0], fsilu(g0[1]) * u0[1], fsilu(g0[2]) * u0[2], fsilu(g0[3]) * u0[3]);
                w.y = pk4_fp8(fsilu(g1[0]) * u1[0], fsilu(g1[1]) * u1[1], fsilu(g1[2]) * u1[2], fsilu(g1[3]) * u1[3]);
                *(u32x2*)rowp = w; }
    }
};

struct EpiPoolW {
    static constexpr bool PERM = true, AFTER_DRAIN = false;
    bf16_t* O;
    __device__ __forceinline__ void operator()(const f32x4 (&acc)[2][2][4][2], const Unit& u, int wr, int wc, int fr, int fq) const {
        const int l = u.pm >> 5, g = (u.pm >> 3) & 3, np = u.pm & 7;
        const int row0 = np * BM + wr * 64 + fr, col0 = 2048 + 256 * g + wc * 32 + 8 * fq;
        bf16_t* base = O + (size_t)l * 2048 * 3072;
#pragma unroll
        for (int ai = 0; ai < 2; ++ai)
#pragma unroll
            for (int m = 0; m < 4; ++m) { bf16_t* rowp = base + (size_t)(row0 + ai * HALF + m * 16) * 3072 + col0;
#pragma unroll
                for (int bj = 0; bj < 2; ++bj) { const f32x4 v0 = acc[ai][bj][m][0], v1 = acc[ai][bj][m][1];
                    u32x4 w; w.x = cvt_pk_bf16(v0[0], v0[1]); w.y = cvt_pk_bf16(v0[2], v0[3]); w.z = cvt_pk_bf16(v1[0], v1[1]); w.w = cvt_pk_bf16(v1[2], v1[3]);
                    *(u32x4*)(rowp + bj * HALF) = w; } }
    }
};

template <class Epi, class Sched, bool ALIGN_EPI = false, bool SP2 = false, bool FP8 = false>
__device__ __forceinline__ void gemm_phase(PG8_LAS unsigned char* lds, const Gemm g, const Sched& S, const Epi& E) {
    int tid_ = threadIdx.x; asm volatile("" : "+v"(tid_));
    const int tid = tid_, wid = __builtin_amdgcn_readfirstlane(tid >> 6), lane = tid & 63, wr = wid >> 2, wc = wid & 3, fr = lane & 15, fq = lane >> 4;
    const int K = g.K, nt = K / BK;
    unsigned voffA[2], voffB[2];
#pragma unroll
    for (int i = 0; i < 2; ++i) { int R, C; stage_rc(tid * 16 + i * 8192, R, C); const int Rb = Epi::PERM ? ((R & ~31) + perm32(R & 31)) : R;
        voffA[i] = (unsigned)(R * g.lda + C) * 2u; voffB[i] = (unsigned)(Rb * g.ldb + C) * 2u; }
    const size_t kstep = (size_t)(BK * 2);
    const size_t hstepA = (size_t)HALF * g.lda * 2, hstepB = (size_t)HALF * g.ldb * 2;
    const size_t tstepA = 2 * hstepA, tstepB = 2 * hstepB;
    const unsigned ldsw = (unsigned)wid * 1024u;
    const int aoff = lds_byte(wr * 64 + fr, fq * 8), boff = lds_byte(wc * 32 + fr, fq * 8);
#define PG8_SA(b, h) (((b) * 2 + (h)) * HTB)
#define PG8_SB(b, h) ((4 + (b) * 2 + (h)) * HTB)
#define PG8_STAGE(bufoff, gbase, voff) do { _Pragma("unroll") for (int _i = 0; _i < 2; ++_i) \
        __builtin_amdgcn_global_load_lds((const unsigned*)((const char*)(gbase) + (voff)[_i]), (PG8_LAS unsigned*)(lds + (bufoff) + ldsw + _i * 8192), 16, 0, 0); } while (0)
#define PG8_LDA(dst, b, h) do { if constexpr (FP8) { _Pragma("unroll") for (int m = 0; m < 4; ++m) { dst##8[m].lo = *(const PG8_LAS i32x4*)(lds + PG8_SA(b, h) + aoff + m * 2048); dst##8[m].hi = *(const PG8_LAS i32x4*)(lds + PG8_SA(b, h) + aoff + m * 2048 + 1024); } } \
        else { _Pragma("unroll") for (int m = 0; m < 4; ++m) _Pragma("unroll") for (int k = 0; k < 2; ++k) dst[m][k] = *(const PG8_LAS bf16x8*)(lds + PG8_SA(b, h) + aoff + m * 2048 + k * 1024); } } while (0)
#define PG8_LDB(dst, b, h) do { if constexpr (FP8) { _Pragma("unroll") for (int n = 0; n < 2; ++n) { dst##8[n].lo = *(const PG8_LAS i32x4*)(lds + PG8_SB(b, h) + boff + n * 2048); dst##8[n].hi = *(const PG8_LAS i32x4*)(lds + PG8_SB(b, h) + boff + n * 2048 + 1024); } } \
        else { _Pragma("unroll") for (int n = 0; n < 2; ++n) _Pragma("unroll") for (int k = 0; k < 2; ++k) dst[n][k] = *(const PG8_LAS bf16x8*)(lds + PG8_SB(b, h) + boff + n * 2048 + k * 1024); } } while (0)
#define PG8_MMA(ai, bj, At, Bt) do { __builtin_amdgcn_s_setprio(1); \
        if constexpr (FP8) { _Pragma("unroll") for (int m = 0; m < 4; ++m) _Pragma("unroll") for (int n = 0; n < 2; ++n) \
            asm volatile("v_mfma_scale_f32_16x16x128_f8f6f4 %0, %1, %2, %0, %3, %4 op_sel_hi:[0,0,0]" : "+v"(acc[ai][bj][m][n]) : "v"(Bt##8[n]), "v"(At##8[m]), "v"(fp8_sw), "v"(fp8_sa)); } \
        else { _Pragma("unroll") for (int m = 0; m < 4; ++m) _Pragma("unroll") for (int n = 0; n < 2; ++n) _Pragma("unroll") for (int k = 0; k < 2; ++k) \
            acc[ai][bj][m][n] = __builtin_amdgcn_mfma_f32_16x16x32_bf16(Bt[n][k], At[m][k], acc[ai][bj][m][n], 0, 0, 0); } \
        __builtin_amdgcn_s_setprio(0); } while (0)
#define PG8_WAIT_V(n) asm volatile("s_waitcnt vmcnt(" #n ")" ::: "memory")
#define PG8_WAIT_L(n) asm volatile("s_waitcnt lgkmcnt(" #n ")" ::: "memory")
#define PG8_BAR __builtin_amdgcn_s_barrier()
#define PG8_SCHED __builtin_amdgcn_sched_barrier(0)
    Unit cur, nxt; int ui = 0;
    if (!S.next(0, cur)) return;
    f32x4 acc[2][2][4][2];
#pragma unroll
    for (int a = 0; a < 2; ++a)
#pragma unroll
        for (int b = 0; b < 2; ++b)
#pragma unroll
            for (int m = 0; m < 4; ++m)
#pragma unroll
                for (int n = 0; n < 2; ++n) acc[a][b][m][n] = (f32x4){0.f, 0.f, 0.f, 0.f};
    bf16x8 At[4][2], B0[2][2], B1[2][2]; i32x8 At8[4], B08[2], B18[2]; const int fp8_sw = FP8_WSCALE, fp8_sa = 127;
    const char* cA = (const char*)g.A + (size_t)cur.pm * tstepA; const char* cB = (const char*)g.Bt + (size_t)cur.be * g.bstride + (size_t)cur.pn * tstepB;
    S.a_ready(cur);
    if constexpr (SP2) {
        PG8_STAGE(PG8_SB(0, 0), cB, voffB); PG8_STAGE(PG8_SB(0, 1), cB + hstepB, voffB); PG8_STAGE(PG8_SA(0, 0), cA, voffA); PG8_STAGE(PG8_SA(0, 1), cA + hstepA, voffA);
        if (wr == 1) PG8_BAR;
        PG8_WAIT_V(2); PG8_BAR;
        PG8_STAGE(PG8_SB(1, 0), cB + kstep, voffB); PG8_STAGE(PG8_SA(1, 0), cA + kstep, voffA); PG8_STAGE(PG8_SB(1, 1), cB + hstepB + kstep, voffB);
        PG8_WAIT_V(6); PG8_BAR;
    } else {
        PG8_STAGE(PG8_SB(0, 0), cB, voffB); PG8_STAGE(PG8_SA(0, 0), cA, voffA); PG8_STAGE(PG8_SB(0, 1), cB + hstepB, voffB); PG8_STAGE(PG8_SA(0, 1), cA + hstepA, voffA);
        if (wr == 1) PG8_BAR;
        PG8_WAIT_V(4); PG8_BAR;
        PG8_STAGE(PG8_SB(1, 0), cB + kstep, voffB); PG8_STAGE(PG8_SA(1, 0), cA + kstep, voffA); PG8_STAGE(PG8_SB(1, 1), cB + hstepB + kstep, voffB);
        PG8_WAIT_V(6); PG8_BAR;
    }
    for (;;) {
        const bool has_next = S.next(ui + 1, nxt);
        const char* nA = has_next ? (const char*)g.A + (size_t)nxt.pm * tstepA : cA; const char* nB = has_next ? (const char*)g.Bt + (size_t)nxt.be * g.bstride + (size_t)nxt.pn * tstepB : cB;
        for (int t = 0; t < nt; t += 2) {
            const bool last = (t == nt - 2);
            const char* a1 = cA + (size_t)(t + 1) * kstep;
            const char* a2 = last ? nA : cA + (size_t)(t + 2) * kstep; const char* b2 = last ? nB : cB + (size_t)(t + 2) * kstep;
            const char* a3 = a2 + kstep; const char* b3 = b2 + kstep;
            if (last && has_next) S.a_ready(nxt);
            if constexpr (SP2) {
            PG8_LDB(B0, 0, 0); PG8_LDB(B1, 0, 1); PG8_SCHED; PG8_LDA(At, 0, 0); PG8_STAGE(PG8_SA(1, 1), a1 + hstepA, voffA);
            PG8_WAIT_V(8); PG8_WAIT_L(0); PG8_BAR; PG8_MMA(0, 0, At, B0); PG8_MMA(0, 1, At, B1); PG8_BAR; PG8_SCHED;
            PG8_LDA(At, 0, 1); PG8_STAGE(PG8_SB(0, 0), b2, voffB); PG8_STAGE(PG8_SB(0, 1), b2 + hstepB, voffB); PG8_STAGE(PG8_SA(0, 0), a2, voffA);
            PG8_WAIT_V(8); PG8_WAIT_L(0); PG8_BAR; PG8_MMA(1, 0, At, B0); PG8_MMA(1, 1, At, B1); PG8_BAR; PG8_SCHED;
            PG8_LDB(B0, 1, 0); PG8_LDB(B1, 1, 1); PG8_SCHED; PG8_LDA(At, 1, 0); PG8_STAGE(PG8_SA(0, 1), a2 + hstepA, voffA);
            PG8_WAIT_V(8); PG8_WAIT_L(0); PG8_BAR; PG8_MMA(0, 0, At, B0); PG8_MMA(0, 1, At, B1); PG8_BAR; PG8_SCHED;
            PG8_LDA(At, 1, 1); PG8_STAGE(PG8_SB(1, 0), b3, voffB); PG8_STAGE(PG8_SB(1, 1), b3 + hstepB, voffB); PG8_STAGE(PG8_SA(1, 0), a3, voffA);
            PG8_WAIT_V(8); PG8_WAIT_L(0); PG8_BAR; PG8_MMA(1, 0, At, B0); PG8_MMA(1, 1, At, B1); PG8_BAR; PG8_SCHED;
            } else {
            PG8_LDB(B0, 0, 0); PG8_SCHED; PG8_LDA(At, 0, 0); PG8_STAGE(PG8_SA(1, 1), a1 + hstepA, voffA);
            PG8_WAIT_L(8); PG8_BAR; PG8_WAIT_L(0); PG8_MMA(0, 0, At, B0); PG8_BAR; PG8_SCHED;
            PG8_LDB(B1, 0, 1); PG8_STAGE(PG8_SB(0, 0), b2, voffB);
            PG8_BAR; PG8_WAIT_L(0); PG8_MMA(0, 1, At, B1); PG8_BAR;
            PG8_LDA(At, 0, 1); PG8_STAGE(PG8_SA(0, 0), a2, voffA);
            PG8_BAR; PG8_WAIT_L(0); PG8_MMA(1, 0, At, B0); PG8_BAR; PG8_SCHED;
            PG8_STAGE(PG8_SB(0, 1), b2 + hstepB, voffB);
            PG8_WAIT_V(6); PG8_BAR; PG8_MMA(1, 1, At, B1); PG8_BAR;
            PG8_LDB(B0, 1, 0); PG8_SCHED; PG8_LDA(At, 1, 0); PG8_STAGE(PG8_SA(0, 1), a2 + hstepA, voffA);
            PG8_WAIT_L(8); PG8_BAR; PG8_WAIT_L(0); PG8_MMA(0, 0, At, B0); PG8_BAR; PG8_SCHED;
            PG8_LDB(B1, 1, 1); PG8_STAGE(PG8_SB(1, 0), b3, voffB);
            PG8_BAR; PG8_WAIT_L(0); PG8_MMA(0, 1, At, B1); PG8_BAR;
            PG8_LDA(At, 1, 1); PG8_STAGE(PG8_SA(1, 0), a3, voffA);
            PG8_BAR; PG8_WAIT_L(0); PG8_MMA(1, 0, At, B0); PG8_BAR; PG8_SCHED;
            PG8_STAGE(PG8_SB(1, 1), b3 + hstepB, voffB);
            PG8_WAIT_V(6); PG8_BAR; PG8_MMA(1, 1, At, B1); PG8_BAR;
            }
        }
        if constexpr (FP8) asm volatile("s_nop 15\n\ts_nop 15" ::: "memory");
        if constexpr (ALIGN_EPI) { if (wr == 0) PG8_BAR; }
        if constexpr (!Epi::AFTER_DRAIN) { E(acc, cur, wr, wc, fr, fq); S.done(cur); }
        if (!has_next) break;
#pragma unroll
        for (int a = 0; a < 2; ++a)
#pragma unroll
            for (int b = 0; b < 2; ++b)
#pragma unroll
                for (int m = 0; m < 4; ++m)
#pragma unroll
                    for (int n = 0; n < 2; ++n) acc[a][b][m][n] = (f32x4){0.f, 0.f, 0.f, 0.f};
        cur = nxt; cA = nA; cB = nB; ++ui;
        if constexpr (ALIGN_EPI) { if (wr == 1) PG8_BAR; }
    }
    PG8_WAIT_V(0);
    if constexpr (!ALIGN_EPI) { if (wr == 0) PG8_BAR; }
    PG8_BAR;
    if constexpr (Epi::AFTER_DRAIN) { E.fused(acc, cur, wr, wc, fr, fq, lds, wid, lane); S.done(cur); }
#undef PG8_SA
#undef PG8_SB
#undef PG8_STAGE
#undef PG8_LDA
#undef PG8_LDB
#undef PG8_MMA
#undef PG8_WAIT_V
#undef PG8_WAIT_L
#undef PG8_BAR
#undef PG8_SCHED
}
}

#ifndef DENSE_FP8
#define DENSE_FP8 0
#endif
constexpr int NWAVES = 8;
constexpr int BATCH = 2, SEQ = 8192, M = BATCH * SEQ, D = 2048, NH = 4, HK = 256, HV = 512, PW = 1024, DFF = 5632, NE = 8, DIN = 11280;
constexpr int ZN = 12288;
constexpr int ZP = 11264;
constexpr int ZC_Q = 0, ZC_K = 1024, ZC_V = 2048, ZC_R = 4096, ZC_P = 6144, ZC_GA = 7168, ZC_GB = 9216;
constexpr int KCAT = 3072;
constexpr int FFN = 2 * DFF;
constexpr int MAXSLOT = 2 * M + NE * 256;
constexpr float EPS = 1e-6f;
static_assert(pg8::ZP_ == ZP, "pitch");

constexpr size_t MiB = 1u << 20;
constexpr size_t WS_CTL = 0, CTL_ZERO_BYTES = 65536;
constexpr size_t WS_TOKSLOT = 1 * MiB, WS_WSLOT = 1 * MiB + 256 * 1024, WS_TOKE = 2 * MiB, WS_TOKW = 2 * MiB + 256 * 1024;
constexpr size_t WS_WIN = 4 * MiB, WS_BCAT = 100 * MiB, WS_WOUT = 124 * MiB, WS_FF1 = 140 * MiB, WS_FF2 = 184 * MiB, WS_EF1 = 206 * MiB, WS_EF2 = 558 * MiB;
constexpr size_t WS_HB = 734 * MiB, WS_ZB = 798 * MiB, WS_LA = 1172 * MiB, WS_OF = 1236 * MiB, WS_ACAT = 1364 * MiB, WS_U = 1460 * MiB, WS_END = 1524 * MiB;
constexpr size_t WS_HMID = WS_ZB, WS_HPERM = WS_ACAT;
static_assert(WS_WIN + 2 * (size_t)ZN * D * 2 <= WS_BCAT && WS_BCAT + 2 * (size_t)D * KCAT * 2 <= WS_WOUT && WS_WOUT + 2 * (size_t)D * D * 2 <= WS_FF1, "ws map 1");
static_assert(WS_FF1 + (size_t)FFN * D * 2 <= WS_FF2 && WS_FF2 + (size_t)D * DFF * 2 <= WS_EF1 && WS_EF1 + 8 * (size_t)FFN * D * 2 <= WS_EF2 && WS_EF2 + 8 * (size_t)D * DFF * 2 <= WS_HB, "ws map 2");
static_assert(WS_HB + (size_t)M * D * 2 <= WS_ZB && WS_ZB + (size_t)M * ZP * 2 <= WS_LA && WS_HMID + (size_t)MAXSLOT * DFF * 2 <= WS_LA && WS_LA + (size_t)M * 1024 * 4 <= WS_OF, "ws map 3");
static_assert(WS_OF + (size_t)M * D * 4 <= WS_ACAT && WS_ACAT + (size_t)M * KCAT * 2 <= WS_U && WS_U + (size_t)M * D * 2 <= WS_END && WS_HPERM + (size_t)MAXSLOT * D * 2 <= WS_END, "ws map 4");
static_assert((size_t)MAXSLOT * 4 <= 256 * 1024 && (size_t)M * 2 * 4 <= 256 * 1024, "ctl tables");
constexpr int CW_TMO = 0, CW_CODE = 1, CW_BAR = 4096, CW_CNT = 8192, CW_FILL = 8256;

constexpr int RING_OFF = 0, RING_BYTES = 131072;
constexpr int LDSCTL_OFF = RING_BYTES, MISC_OFF = LDSCTL_OFF + 320;
constexpr int LDS_BYTES = 147456;

#define GAS __attribute__((address_space(1)))
#define LAS __attribute__((address_space(3)))
typedef unsigned short bf16;
typedef unsigned v4u __attribute__((ext_vector_type(4)));
typedef unsigned v2u __attribute__((ext_vector_type(2)));
typedef float f32x4 __attribute__((ext_vector_type(4)));
typedef GAS unsigned gu32;
#define RLX_AGENT __ATOMIC_RELAXED, __HIP_MEMORY_SCOPE_AGENT
#define LDS_WAIT() asm volatile("s_waitcnt lgkmcnt(0)" ::: "memory")
#define VM_WAIT() asm volatile("s_waitcnt vmcnt(0)" ::: "memory")
__device__ __forceinline__ unsigned f2bf(float f) { unsigned u = __builtin_bit_cast(unsigned, f); return (u + 0x7fffu + ((u >> 16) & 1u)) >> 16; }
__device__ __forceinline__ unsigned pk2(float lo, float hi) { return f2bf(lo) | (f2bf(hi) << 16); }
__device__ __forceinline__ float bfl(unsigned w) { return __uint_as_float(w << 16); }
__device__ __forceinline__ float bfh(unsigned w) { return __uint_as_float(w & 0xffff0000u); }
__device__ __forceinline__ float wave_sum(float v) {
#pragma unroll
    for (int o = 1; o < 64; o <<= 1) v += __shfl_xor(v, o);
    return v;
}
typedef __bf16 gl_bf2 __attribute__((ext_vector_type(2)));
typedef float gl_f2 __attribute__((ext_vector_type(2)));
__device__ __forceinline__ unsigned pkbf(float lo, float hi) { gl_f2 v = {lo, hi}; return __builtin_bit_cast(unsigned, __builtin_convertvector(v, gl_bf2)); }
__device__ __forceinline__ int opq(int x) { asm volatile("" : "+v"(x)); return x; }
#define XB_TMO      128
#define XB_XCNT(j)  (256  + 64 * (j))
#define XB_XSUB(j)  (1280 + 64 * (j))
#define XB_XGEN(j)  (2304 + 64 * (j))
#define XB_TOP      3328
#define XB_TOPGEN   3392
#define XCD_BAR_WORDS 3456
#define XB_SPIN_CAP (1u << 18)

__device__ __forceinline__ unsigned xb_ld(unsigned* p)              { return __hip_atomic_load(p, __ATOMIC_RELAXED, __HIP_MEMORY_SCOPE_AGENT); }
__device__ __forceinline__ unsigned xb_add(unsigned* p, unsigned v) { return __hip_atomic_fetch_add(p, v, __ATOMIC_RELAXED, __HIP_MEMORY_SCOPE_AGENT); }
__device__ __forceinline__ unsigned xb_xcc_id() { return (unsigned)__builtin_amdgcn_s_getreg((3 << 11) | 20) & 0xFu; }
#define XB_SPIN(cond, bar) do { unsigned _sp = 0; while (cond) { __builtin_amdgcn_s_sleep(1); \
    if ((++_sp & 255u) == 0u) { if (xb_ld(&(bar)[XB_TMO])) break; if (_sp > XB_SPIN_CAP) { atomicAdd(&(bar)[XB_TMO], 1u); break; } } } } while (0)

struct XcdBarrier {
    unsigned* bar; unsigned x;
    volatile LAS unsigned* st;
};

__device__ __forceinline__ XcdBarrier xcd_barrier_post(unsigned* bar, volatile LAS unsigned* st) {
    XcdBarrier b; b.bar = bar; b.x = xb_xcc_id(); b.st = st;
    if (threadIdx.x == 0) (void)xb_add(&bar[XB_XCNT(b.x)], 1u);
    return b;
}
__device__ __forceinline__ void xcd_barrier_complete(unsigned* bar, unsigned x, unsigned& nloc, unsigned& nx) {
    const unsigned G = gridDim.x * gridDim.y * gridDim.z;
    unsigned sum, cnt, mine, sp = 0u;
    for (;;) {
        sum = 0u; cnt = 0u; mine = 0u;
#pragma unroll
        for (unsigned j = 0; j < 16; ++j) { const unsigned c = xb_ld(&bar[XB_XCNT(j)]); sum += c; cnt += (c > 0u) ? 1u : 0u; mine = (j == x) ? c : mine; }
        if (sum == G) break;
        __builtin_amdgcn_s_sleep(1);
        if ((++sp & 255u) == 0u) { if (xb_ld(&bar[XB_TMO])) break; if (sp > XB_SPIN_CAP) { atomicAdd(&bar[XB_TMO], 1u); break; } }
    }
    nloc = mine > 0u ? mine : 1u; nx = cnt > 0u ? cnt : 1u;
}

__device__ __forceinline__ void xcd_barrier(const XcdBarrier& b) {
    asm volatile("s_waitcnt vmcnt(0)" ::: "memory");
    __syncthreads();
    if (threadIdx.x == 0) {
        unsigned* bar = b.bar;
        __builtin_amdgcn_s_waitcnt(0);
        unsigned nloc = b.st[0], nx = b.st[1];
        if (nloc == 0u) { xcd_barrier_complete(bar, b.x, nloc, nx); b.st[0] = nloc; b.st[1] = nx; }
        const unsigned old = xb_add(&bar[XB_XSUB(b.x)], 1u);
        const unsigned gen = old / nloc;
        if (old + 1u == (gen + 1u) * nloc) {
            __builtin_amdgcn_fence(__ATOMIC_RELEASE, "agent");
            asm volatile("s_waitcnt vmcnt(0)" ::: "memory");
            const unsigned og = xb_add(&bar[XB_TOP], 1u);
            const unsigned tg = og / nx;
            if (og + 1u == (tg + 1u) * nx) xb_add(&bar[XB_TOPGEN], 1u);
            else XB_SPIN(xb_ld(&bar[XB_TOPGEN]) == tg, bar);
            __builtin_amdgcn_fence(__ATOMIC_ACQUIRE, "agent");
            xb_add(&bar[XB_XGEN(b.x)], 1u);
            asm volatile("s_waitcnt vmcnt(0)" ::: "memory");
        } else {
            XB_SPIN(xb_ld(&bar[XB_XGEN(b.x)]) == gen, bar);
            __builtin_amdgcn_fence(__ATOMIC_ACQUIRE, "agent");
            asm volatile("s_waitcnt vmcnt(0)" ::: "memory");
        }
    }
    __syncthreads();
}

struct TrJob { const float* src; unsigned char* dst; int ldw, ldt, k0, n0, mode, row_off, kind; };
__device__ __forceinline__ int tr_drow(int nn, int mode, int row_off) { return mode ? (256 * (nn >> 7) + (nn & 127) + row_off) : (row_off + nn); }
__device__ __forceinline__ void tr_load(const TrJob& J, f32x4 (&R)[16], int lane) {
    if (J.kind == 0) { const int nq = lane & 15, kr = lane >> 4; const float* b = J.src + (size_t)(4 * kr) * J.ldw + 4 * nq;
#pragma unroll
        for (int jq = 0; jq < 4; ++jq)
#pragma unroll
            for (int x = 0; x < 4; ++x) R[4 * jq + x] = __builtin_nontemporal_load((const GAS f32x4*)(b + (size_t)(16 * jq + x) * J.ldw));
    } else { const int nq = lane & 7, kr = lane >> 3; const float* b = J.src + (size_t)(4 * kr) * J.ldw + 4 * nq;
#pragma unroll
        for (int jq = 0; jq < 4; ++jq)
#pragma unroll
            for (int x = 0; x < 4; ++x) R[4 * jq + x] = __builtin_nontemporal_load((const GAS f32x4*)(b + (size_t)(32 * jq + x) * J.ldw)); }
}
__device__ __forceinline__ void tr_finish(const TrJob& J, const f32x4 (&R)[16], LAS unsigned* T, int lane, int nostore) {
    if (J.kind == 0) { const int nq = lane & 15, kr = lane >> 4;
#pragma unroll
        for (int jq = 0; jq < 4; ++jq)
#pragma unroll
            for (int i = 0; i < 4; ++i) { T[(4 * nq + i) * 33 + 8 * jq + 2 * kr] = pkbf(R[4 * jq][i], R[4 * jq + 1][i]); T[(4 * nq + i) * 33 + 8 * jq + 2 * kr + 1] = pkbf(R[4 * jq + 2][i], R[4 * jq + 3][i]); }
        LDS_WAIT(); asm volatile("" ::: "memory");
#pragma unroll
        for (int r = 0; r < 8; ++r) { const int t = lane + 64 * r, n = t >> 3, c = t & 7; const LAS unsigned* s = T + n * 33 + 4 * c;
            v4u o; o.x = s[0]; o.y = s[1]; o.z = s[2]; o.w = s[3];
            if (!nostore || o.x == 0x12345678u) *(GAS v4u*)(J.dst + (size_t)tr_drow(J.n0 + n, J.mode, J.row_off) * J.ldt + 2 * J.k0 + 16 * c) = o; }
    } else { const int nq = lane & 7, kr = lane >> 3;
#pragma unroll
        for (int jq = 0; jq < 4; ++jq)
#pragma unroll
            for (int i = 0; i < 4; ++i) T[(4 * nq + i) * 33 + 8 * jq + kr] = pg8::pk4_fp8(R[4 * jq][i] * 64.0f, R[4 * jq + 1][i] * 64.0f, R[4 * jq + 2][i] * 64.0f, R[4 * jq + 3][i] * 64.0f);
        LDS_WAIT(); asm volatile("" ::: "memory");
#pragma unroll
        for (int r = 0; r < 4; ++r) { const int t = lane + 64 * r, n = t >> 3, c = t & 7; const LAS unsigned* s = T + n * 33 + 4 * c;
            v4u o; o.x = s[0]; o.y = s[1]; o.z = s[2]; o.w = s[3];
            if (!nostore || o.x == 0x12345678u) *(GAS v4u*)(J.dst + (size_t)tr_drow(J.n0 + n, J.mode, J.row_off) * J.ldt + J.k0 + 16 * c) = o; } }
    LDS_WAIT(); asm volatile("" ::: "memory");
}

template <bool ROUTE, bool OUT8 = false>
__device__ __forceinline__ void norm_rows(const float* X, const float* gain, bf16* out, int gw, int NGW, int lane0,
                                          const LAS float* rw, int* tok_e, float* tok_w, LAS unsigned* hist) {
    const int lane = opq(lane0);
    f32x4 nx[8];
    if (gw < M) { const GAS f32x4* xr = (const GAS f32x4*)(X + (size_t)gw * D) + lane;
#pragma unroll
        for (int j = 0; j < 8; ++j) nx[j] = xr[64 * j]; }
    for (int m = gw; m < M; m += NGW) {
        f32x4 v[8]; float s = 0.f;
#pragma unroll
        for (int j = 0; j < 8; ++j) { v[j] = nx[j]; s += (v[j].x * v[j].x + v[j].y * v[j].y) + (v[j].z * v[j].z + v[j].w * v[j].w); }
        if (m + NGW < M) { const GAS f32x4* xr = (const GAS f32x4*)(X + (size_t)(m + NGW) * D) + lane;
#pragma unroll
            for (int j = 0; j < 8; ++j) nx[j] = xr[64 * j]; }
        const float rstd = 1.0f / sqrtf(wave_sum(s) * (1.0f / D) + EPS);
        GAS unsigned long long* o8 = (GAS unsigned long long*)(out + (size_t)m * D) + lane;
#pragma unroll
        for (int j = 0; j < 8; ++j) { const f32x4 g4 = ((const GAS f32x4*)gain)[lane + 64 * j]; v[j] = v[j] * rstd * g4;
            if (OUT8) ((GAS unsigned*)((unsigned char*)out + (size_t)m * D))[lane + 64 * j] = pg8::pk4_fp8(v[j].x, v[j].y, v[j].z, v[j].w);
            else o8[64 * j] = (unsigned long long)pk2(v[j].x, v[j].y) | ((unsigned long long)pk2(v[j].z, v[j].w) << 32); }
        if (ROUTE) {
            float lg[8];
#pragma unroll
            for (int e = 0; e < 8; ++e) lg[e] = 0.f;
#pragma unroll
            for (int j = 0; j < 8; ++j)
#pragma unroll
                for (int i = 0; i < 4; ++i) { const int k = 4 * (lane + 64 * j) + i; const f32x4 r0 = *(const LAS f32x4*)(rw + k * 8), r1 = *(const LAS f32x4*)(rw + k * 8 + 4); const float hv = v[j][i];
                    lg[0] += hv * r0.x; lg[1] += hv * r0.y; lg[2] += hv * r0.z; lg[3] += hv * r0.w; lg[4] += hv * r1.x; lg[5] += hv * r1.y; lg[6] += hv * r1.z; lg[7] += hv * r1.w; }
#pragma unroll
            for (int e = 0; e < 8; ++e) lg[e] = wave_sum(lg[e]);
            float v1 = lg[0]; int i1 = 0;
#pragma unroll
            for (int e = 1; e < 8; ++e) if (lg[e] > v1) { v1 = lg[e]; i1 = e; }
            float v2 = -3.0e38f; int i2 = 0;
#pragma unroll
            for (int e = 0; e < 8; ++e) if (e != i1 && lg[e] > v2) { v2 = lg[e]; i2 = e; }
            const float ex = __expf(v2 - v1), w1 = 1.0f / (1.0f + ex), w2 = ex * w1;
            if (lane == 0) { tok_e[2 * m] = i1; tok_e[2 * m + 1] = i2; tok_w[2 * m] = w1; tok_w[2 * m + 1] = w2;
                __hip_atomic_fetch_add(hist + i1, 1u, __ATOMIC_RELAXED, __HIP_MEMORY_SCOPE_WORKGROUP); __hip_atomic_fetch_add(hist + i2, 1u, __ATOMIC_RELAXED, __HIP_MEMORY_SCOPE_WORKGROUP); }
        }
    }
}


typedef short gl_bf16x8 __attribute__((ext_vector_type(8)));
typedef short gl_s16x4 __attribute__((ext_vector_type(4)));
__device__ __forceinline__ unsigned off_q(unsigned row, unsigned ch) { return 512u * row + 16u * (ch ^ (row & 15u)); }
__device__ __forceinline__ unsigned off_a(unsigned row, unsigned ch) { return 128u * row + 16u * (ch ^ (row & 7u)); }
__device__ __forceinline__ unsigned off_b(unsigned row, unsigned ch) { return 256u * row + 16u * (ch ^ (((row & 3u) << 2) | ((row >> 2) & 3u))); }
__device__ __forceinline__ gl_bf16x8 tr_frag(unsigned base, unsigned lane, unsigned c) {
    const unsigned g = lane >> 4, q = (lane & 15u) >> 2, p = lane & 3u;
    const unsigned a0 = base + off_b(8u * g + q, 2u * c + (p >> 1)) + 8u * (p & 1u), a1 = base + off_b(8u * g + 4u + q, 2u * c + (p >> 1)) + 8u * (p & 1u);
    const gl_s16x4 lo = __builtin_amdgcn_ds_read_tr16_b64_v4i16((LAS gl_s16x4*)a0), hi = __builtin_amdgcn_ds_read_tr16_b64_v4i16((LAS gl_s16x4*)a1);
    return __builtin_shufflevector(lo, hi, 0, 1, 2, 3, 4, 5, 6, 7);
}
#define GLA_MFMA(a, b, c) __builtin_amdgcn_mfma_f32_16x16x32_bf16((a), (b), (c), 0, 0, 0)
constexpr int GLA_NSEG = 8, GLA_CPS = 16;
constexpr int GL_QT = 0, GL_KE = 32768, GL_V = 65536, GL_ATT = 81920, GL_DEC = 90112;

__device__ __forceinline__ void gla_g0(LAS unsigned char* lds, bf16* Zb, const bf16* Hb, const bf16* WA1T, const float* w_alpha, const float* b_alpha, bf16* ATT, float* DEC, int bx, int G, int tid0, int lane0, int wave) {
    const int tid = opq(tid0), lane = tid & 63; (void)lane0;
    LAS float* sB = (LAS float*)lds; LAS unsigned char* sQ = lds + 65536; LAS unsigned char* sK = lds + 98304;
    LAS float* sP = (LAS float*)(lds + 65536);
    LAS float* sA1 = (LAS float*)(lds + 131072 + 1024);
    const unsigned li = lane & 15, g = lane >> 4;
    for (int uc = bx; uc < 256; uc += G) {
        const int b = uc >> 7, c = uc & 127; const size_t row0 = (size_t)b * SEQ + (size_t)c * 64;
        __syncthreads();
        { f32x4 pa[4];
#pragma unroll
            for (int mt = 0; mt < 4; ++mt) pa[mt] = (f32x4){0.f, 0.f, 0.f, 0.f};
#pragma unroll
            for (int s2 = 0; s2 < 4; ++s2) { gl_bf16x8 bf[2], af[2][4];
#pragma unroll
                for (int ss = 0; ss < 2; ++ss) { const int s = 8 * wave + 2 * s2 + ss; bf[ss] = *(const GAS gl_bf16x8*)(WA1T + (size_t)li * D + 32 * s + 8 * g);
#pragma unroll
                    for (int mt = 0; mt < 4; ++mt) af[ss][mt] = *(const GAS gl_bf16x8*)(Hb + (row0 + 16 * mt + li) * D + 32 * s + 8 * g); }
#pragma unroll
                for (int ss = 0; ss < 2; ++ss)
#pragma unroll
                    for (int mt = 0; mt < 4; ++mt) pa[mt] = GLA_MFMA(af[ss][mt], bf[ss], pa[mt]); }
#pragma unroll
            for (int mt = 0; mt < 4; ++mt)
#pragma unroll
                for (int j = 0; j < 4; ++j) sP[(wave * 64 + 16 * mt + 4 * g + j) * 16 + li] = pa[mt][j]; }
        __syncthreads();
#pragma unroll
        for (int e2 = 0; e2 < 2; ++e2) { const int e = tid + 512 * e2; float s = 0.f;
#pragma unroll
            for (int w = 0; w < 8; ++w) s += sP[w * 1024 + e];
            sA1[e] = s; }
        for (int h = 0; h < 4; ++h) {
        const int u = (b << 9) | (c << 2) | h;
        __syncthreads();
        v4u q8r[4], k8r[4];
#pragma unroll
        for (int i = 0; i < 4; ++i) { const int n = tid + 512 * i, r = n >> 5, ch = n & 31;
            q8r[i] = *(const GAS v4u*)(Zb + (row0 + r) * ZP + ZC_Q + h * 256 + 8 * ch); k8r[i] = *(const GAS v4u*)(Zb + (row0 + r) * ZP + ZC_K + h * 256 + 8 * ch); }
        {
            const int d = tid & 255, hf = tid >> 8; float wa[16];
#pragma unroll
            for (int r = 0; r < 16; ++r) wa[r] = w_alpha[r * 1024 + h * 256 + d];
            const float ba = b_alpha[h * 256 + d];
            float vv[32];
#pragma unroll
            for (int t = 0; t < 32; ++t) { const LAS f32x4* ap = (const LAS f32x4*)(sA1 + (32 * hf + t) * 16); const f32x4 a0 = ap[0], a1 = ap[1], a2 = ap[2], a3 = ap[3];
                float s = ba + (a0.x * wa[0] + a0.y * wa[1]) + (a0.z * wa[2] + a0.w * wa[3]) + (a1.x * wa[4] + a1.y * wa[5]) + (a1.z * wa[6] + a1.w * wa[7])
                             + (a2.x * wa[8] + a2.y * wa[9]) + (a2.z * wa[10] + a2.w * wa[11]) + (a3.x * wa[12] + a3.y * wa[13]) + (a3.z * wa[14] + a3.w * wa[15]);
                vv[t] = pg8::flogsig(s) * 0.0625f; }
#pragma unroll
            for (int t = 1; t < 32; ++t) vv[t] += vv[t - 1];
            LAS float* tot = (LAS float*)(lds + 65536);
            if (hf == 0) tot[d] = vv[31];
            __syncthreads();
            const float add = hf ? tot[d] : 0.f;
#pragma unroll
            for (int t = 0; t < 32; ++t) sB[(32 * hf + t) * 256 + d] = vv[t] + add;
        }
        __syncthreads();
#pragma unroll
        for (int i = 0; i < 4; ++i) { const int n = tid + 512 * i, r = n >> 5, ch = n & 31;
            bf16* qp = Zb + (row0 + r) * ZP + ZC_Q + h * 256; bf16* kp = Zb + (row0 + r) * ZP + ZC_K + h * 256;
            const v4u q8 = q8r[i], k8 = k8r[i];
            const f32x4 b0 = *(const LAS f32x4*)(sB + r * 256 + 8 * ch), b1 = *(const LAS f32x4*)(sB + r * 256 + 8 * ch + 4);
            const f32x4 l0 = *(const LAS f32x4*)(sB + 63 * 256 + 8 * ch), l1 = *(const LAS f32x4*)(sB + 63 * 256 + 8 * ch + 4);
            const float qv[8] = {bfl(q8.x), bfh(q8.x), bfl(q8.y), bfh(q8.y), bfl(q8.z), bfh(q8.z), bfl(q8.w), bfh(q8.w)};
            const float kv[8] = {bfl(k8.x), bfh(k8.x), bfl(k8.y), bfh(k8.y), bfl(k8.z), bfh(k8.z), bfl(k8.w), bfh(k8.w)};
            const float bb[8] = {b0.x, b0.y, b0.z, b0.w, b1.x, b1.y, b1.z, b1.w}; const float bl[8] = {l0.x, l0.y, l0.z, l0.w, l1.x, l1.y, l1.z, l1.w};
            float qt[8], kt[8], ke[8];
#pragma unroll
            for (int e = 0; e < 8; ++e) { qt[e] = qv[e] * __expf(bb[e]) * 0.0625f; kt[e] = kv[e] * __expf(-bb[e]); ke[e] = kv[e] * __expf(bl[e] - bb[e]); }
            v4u qw, kw, ew; qw.x = pkbf(qt[0], qt[1]); qw.y = pkbf(qt[2], qt[3]); qw.z = pkbf(qt[4], qt[5]); qw.w = pkbf(qt[6], qt[7]);
            kw.x = pkbf(kt[0], kt[1]); kw.y = pkbf(kt[2], kt[3]); kw.z = pkbf(kt[4], kt[5]); kw.w = pkbf(kt[6], kt[7]);
            ew.x = pkbf(ke[0], ke[1]); ew.y = pkbf(ke[2], ke[3]); ew.z = pkbf(ke[4], ke[5]); ew.w = pkbf(ke[6], ke[7]);
            *(LAS v4u*)(sQ + off_q(r, ch)) = qw; *(LAS v4u*)(sK + off_q(r, ch)) = kw;
            *(GAS v4u*)(kp + 8 * ch) = ew;
            const int p0 = 32 * (ch >> 2) + 16 * (ch & 1) + 4 * ((ch >> 1) & 1);
            v2u w0, w1; w0.x = qw.x; w0.y = qw.y; w1.x = qw.z; w1.y = qw.w;
            *(GAS v2u*)(qp + p0) = w0; *(GAS v2u*)(qp + p0 + 8) = w1; }
        if (tid < 256) DEC[((size_t)b * 128 + c) * 1024 + h * 256 + tid] = __expf(sB[63 * 256 + tid]);
        __syncthreads();
#pragma unroll
        for (int tt = 0; tt < 2; ++tt) { const int T = 2 * wave + tt, jt = T >> 2, it = T & 3;
            f32x4 acc = {0.f, 0.f, 0.f, 0.f};
            if (jt <= it) {
#pragma unroll
                for (int s = 0; s < 8; ++s) { const gl_bf16x8 a = *(const LAS gl_bf16x8*)(sK + off_q(16 * jt + li, 4 * s + g)), bq = *(const LAS gl_bf16x8*)(sQ + off_q(16 * it + li, 4 * s + g));
                    acc = GLA_MFMA(a, bq, acc); } }
            const int i = 16 * it + (int)li, j0 = 16 * jt + 4 * (int)g;
            v2u w; w.x = pkbf(j0 + 0 <= i ? acc[0] : 0.f, j0 + 1 <= i ? acc[1] : 0.f); w.y = pkbf(j0 + 2 <= i ? acc[2] : 0.f, j0 + 3 <= i ? acc[3] : 0.f);
            *(GAS v2u*)(ATT + (size_t)u * 4096 + i * 64 + j0) = w; }
        }
    }
}

struct GlaRegs { v4u k[4], q[4], v[2], a; f32x4 d; };
template <bool WITH_Q>
__device__ __forceinline__ void gla_issue(GlaRegs& R, const bf16* Zb, const bf16* ATT, const float* DEC, int b, int c, int h, int sl, int tid) {
    const size_t row0 = (size_t)b * SEQ + (size_t)c * 64;
#pragma unroll
    for (int i = 0; i < 4; ++i) { const int n = tid + 512 * i, r = n >> 5, ch = n & 31;
        R.k[i] = *(const GAS v4u*)(Zb + (row0 + r) * ZP + ZC_K + h * 256 + 8 * ch);
        if (WITH_Q) R.q[i] = *(const GAS v4u*)(Zb + (row0 + r) * ZP + ZC_Q + h * 256 + 8 * ch); }
#pragma unroll
    for (int i = 0; i < 2; ++i) { const int n = tid + 512 * i, r = n >> 4, ch = n & 15; R.v[i] = *(const GAS v4u*)(Zb + (row0 + r) * ZP + ZC_V + h * 512 + sl * 128 + 8 * ch); }
    if (WITH_Q) { const int r = tid >> 3, ch = tid & 7; const unsigned u = ((unsigned)b << 9) | ((unsigned)c << 2) | (unsigned)h; R.a = *(const GAS v4u*)(ATT + (size_t)u * 4096 + r * 64 + 8 * ch); }
    if (tid < 64) R.d = *(const GAS f32x4*)(DEC + ((size_t)b * 128 + c) * 1024 + h * 256 + 4 * tid);
}
template <bool WITH_Q>
__device__ __forceinline__ void gla_commit(const GlaRegs& R, LAS unsigned char* lds, int tid) {
#pragma unroll
    for (int i = 0; i < 4; ++i) { const int n = tid + 512 * i, r = n >> 5, ch = n & 31;
        *(LAS v4u*)(lds + GL_KE + ((r >> 5) * 2 + (ch >> 4)) * 8192 + off_b(r & 31, ch & 15)) = R.k[i];
        if (WITH_Q) *(LAS v4u*)(lds + GL_QT + off_q(r, ch)) = R.q[i]; }
#pragma unroll
    for (int i = 0; i < 2; ++i) { const int n = tid + 512 * i, r = n >> 4, ch = n & 15; *(LAS v4u*)(lds + GL_V + (r >> 5) * 8192 + off_b(r & 31, ch)) = R.v[i]; }
    if (WITH_Q) { const int r = tid >> 3, ch = tid & 7; *(LAS v4u*)(lds + GL_ATT + off_a(r, ch)) = R.a; }
    if (tid < 64) ((LAS f32x4*)(lds + GL_DEC))[tid] = R.d;
}
__device__ __forceinline__ void gla_update(LAS unsigned char* lds, f32x4 (&S)[16], const gl_bf16x8 (&vf)[2], unsigned lane, unsigned g) {
    const unsigned lbase = (unsigned)(size_t)lds;
#pragma unroll
    for (int i2 = 0; i2 < 8; ++i2) {
        f32x4 d4[2]; gl_bf16x8 kf[2][2];
#pragma unroll
        for (int ii = 0; ii < 2; ++ii) { const int i = 2 * i2 + ii; d4[ii] = *(const LAS f32x4*)(lds + GL_DEC + 4 * (16 * i + 4 * g));
            kf[ii][0] = tr_frag(lbase + GL_KE + (0 * 2 + (i >> 3)) * 8192, lane, i & 7); kf[ii][1] = tr_frag(lbase + GL_KE + (1 * 2 + (i >> 3)) * 8192, lane, i & 7); }
        __builtin_amdgcn_sched_barrier(0);
#pragma unroll
        for (int ii = 0; ii < 2; ++ii) { const int i = 2 * i2 + ii; S[i] = S[i] * d4[ii]; S[i] = GLA_MFMA(kf[ii][0], vf[0], S[i]); S[i] = GLA_MFMA(kf[ii][1], vf[1], S[i]); }
        __builtin_amdgcn_sched_barrier(0);
    }
}

__device__ __forceinline__ void gla_g1(LAS unsigned char* lds, const bf16* Zb, const float* DEC, float* SL, float* DSEG, int bx, int G, int tid0, int lane0, int wave) {
    const int tid = opq(tid0), lane = tid & 63; (void)lane0;
    const unsigned li = lane & 15, g = lane >> 4; const unsigned lbase = (unsigned)(size_t)lds;
    for (int un = bx; un < 256; un += G) {
        const int seg = un & 7, bh = un >> 5, sl = (un >> 3) & 3, b = bh >> 2, h = bh & 3;
        if (seg == 7) continue;
        f32x4 S[16];
#pragma unroll
        for (int i = 0; i < 16; ++i) S[i] = (f32x4){0.f, 0.f, 0.f, 0.f};
        float dprod = 1.0f;
        GlaRegs R; gla_issue<false>(R, Zb, nullptr, DEC, b, seg * GLA_CPS, h, sl, tid);
        for (int cc = 0; cc < GLA_CPS; ++cc) {
            __syncthreads();
            gla_commit<false>(R, lds, tid);
            __syncthreads();
            if (cc + 1 < GLA_CPS) gla_issue<false>(R, Zb, nullptr, DEC, b, seg * GLA_CPS + cc + 1, h, sl, tid);
            if (tid < 256) dprod *= ((LAS float*)(lds + GL_DEC))[tid];
            unsigned lv = (unsigned)lane; asm volatile("" : "+v"(lv));
            gl_bf16x8 vf[2]; vf[0] = tr_frag(lbase + GL_V, lv, wave); vf[1] = tr_frag(lbase + GL_V + 8192, lv, wave);
            gla_update(lds, S, vf, lv, lv >> 4);
        }
        float* pp = SL + ((size_t)(bh * 7 + seg) * 256 + 4 * g) * 512 + sl * 128 + 16 * wave + li;
#pragma unroll
        for (int i = 0; i < 16; ++i) { asm volatile("" : "+v"(pp));
#pragma unroll
            for (int r = 0; r < 4; ++r) pp[r * 512] = S[i][r];
            pp += 16 * 512; }
        if (sl == 0 && tid < 256) DSEG[(bh * 7 + seg) * 256 + tid] = dprod;
    }
}
__device__ __forceinline__ void gla_g2(float* SL, const float* DSEG, int gtid, int NT) {
    for (int it = gtid; it < 8 * 256 * 128; it += NT) { const int bh = it >> 15, dk = (it >> 7) & 255, d4 = it & 127;
        f32x4 s = {0.f, 0.f, 0.f, 0.f};
        for (int seg = 0; seg < 7; ++seg) { GAS f32x4* p = (GAS f32x4*)(SL + ((size_t)(bh * 7 + seg) * 256 + dk) * 512) + d4; const float d = DSEG[(bh * 7 + seg) * 256 + dk];
            s = s * d + *p; *p = s; } }
}
__device__ __forceinline__ void gla_g3_chunk(LAS unsigned char* lds, f32x4 (&S)[16], GlaRegs& R, const bf16* Zb, const bf16* ATT, const float* DEC, float* OF,
                                             int b, int c, int h, int sl, int c_next, bool refill, bool do_update, int tid, int lane, int wave) {
    const unsigned lbase = (unsigned)(size_t)lds;
    __syncthreads();
    gla_commit<true>(R, lds, tid);
    __syncthreads();
    if (refill) gla_issue<true>(R, Zb, ATT, DEC, b, c_next, h, sl, tid);
    unsigned lv = (unsigned)lane; asm volatile("" : "+v"(lv));
    const unsigned li = lv & 15, g = lv >> 4;
    gl_bf16x8 vf[2]; vf[0] = tr_frag(lbase + GL_V, lv, wave); vf[1] = tr_frag(lbase + GL_V + 8192, lv, wave);
    f32x4 o[4];
#pragma unroll
    for (int nt = 0; nt < 4; ++nt) o[nt] = (f32x4){0.f, 0.f, 0.f, 0.f};
#pragma unroll
    for (int s = 0; s < 8; ++s) {
        gl_bf16x8 qf[4];
#pragma unroll
        for (int nt = 0; nt < 4; ++nt) qf[nt] = *(const LAS gl_bf16x8*)(lds + GL_QT + off_q(16 * nt + li, 4 * s + g));
        v4u aw; aw.x = pkbf(S[2 * s][0], S[2 * s][1]); aw.y = pkbf(S[2 * s][2], S[2 * s][3]); aw.z = pkbf(S[2 * s + 1][0], S[2 * s + 1][1]); aw.w = pkbf(S[2 * s + 1][2], S[2 * s + 1][3]);
        const gl_bf16x8 af = __builtin_bit_cast(gl_bf16x8, aw);
        __builtin_amdgcn_sched_barrier(0);
#pragma unroll
        for (int nt = 0; nt < 4; ++nt) o[nt] = GLA_MFMA(af, qf[nt], o[nt]);
        __builtin_amdgcn_sched_barrier(0);
    }
    { gl_bf16x8 tf[6];
#pragma unroll
        for (int nt = 0; nt < 4; ++nt) tf[nt] = *(const LAS gl_bf16x8*)(lds + GL_ATT + off_a(16 * nt + li, g));
#pragma unroll
        for (int nt = 2; nt < 4; ++nt) tf[2 + nt] = *(const LAS gl_bf16x8*)(lds + GL_ATT + off_a(16 * nt + li, 4 + g));
        __builtin_amdgcn_sched_barrier(0);
#pragma unroll
        for (int nt = 0; nt < 4; ++nt) o[nt] = GLA_MFMA(vf[0], tf[nt], o[nt]);
#pragma unroll
        for (int nt = 2; nt < 4; ++nt) o[nt] = GLA_MFMA(vf[1], tf[2 + nt], o[nt]);
        __builtin_amdgcn_sched_barrier(0); }
    bf16* op = (bf16*)OF + ((size_t)b * SEQ + (size_t)c * 64 + li) * D + h * 512 + sl * 128 + 16 * wave + 4 * g;
#pragma unroll
    for (int nt = 0; nt < 4; ++nt) { v2u w; w.x = pkbf(o[nt][0], o[nt][1]); w.y = pkbf(o[nt][2], o[nt][3]); *(GAS v2u*)(op + (size_t)(16 * nt) * D) = w; }
    if (do_update) gla_update(lds, S, vf, lv, g);
}
__device__ __forceinline__ void gla_g3(LAS unsigned char* lds, const bf16* Zb, const bf16* ATT, const float* DEC, const float* SL, float* OF, int bx, int G, int tid0, int lane0, int wave) {
    const int tid = opq(tid0), lane = tid & 63; (void)lane0;
    const unsigned li = lane & 15, g = lane >> 4;
    for (int un = bx; un < 256; un += G) {
        const int seg = un & 7, bh = un >> 5, sl = (un >> 3) & 3, b = bh >> 2, h = bh & 3;
        f32x4 S[16];
        if (seg == 0) {
#pragma unroll
            for (int i = 0; i < 16; ++i) S[i] = (f32x4){0.f, 0.f, 0.f, 0.f};
        } else { const float* pp = SL + ((size_t)(bh * 7 + seg - 1) * 256 + 4 * g) * 512 + sl * 128 + 16 * wave + li;
#pragma unroll
            for (int i = 0; i < 16; ++i) { asm volatile("" : "+v"(pp));
#pragma unroll
                for (int r = 0; r < 4; ++r) S[i][r] = pp[r * 512];
                pp += 16 * 512; } }
        const int c0 = seg * GLA_CPS;
        GlaRegs RA; gla_issue<true>(RA, Zb, ATT, DEC, b, c0, h, sl, tid);
        for (int cc = 0; cc < GLA_CPS; ++cc)
            gla_g3_chunk(lds, S, RA, Zb, ATT, DEC, OF, b, c0 + cc, h, sl, c0 + cc + 1, cc + 1 < GLA_CPS, cc + 1 < GLA_CPS, tid, lane, wave);
    }
}

struct Args { const float* in[20]; float* out; unsigned char* ws; int ph_lo, ph_hi, li, pad; };
constexpr int PH_PER_LAYER = 12, N_PHASES = 2 + 2 * PH_PER_LAYER;

#define IN(k) (lo <= (k) && (k) < hi)
#define SEAM(k) do { if (IN(k) && IN((k) + 1)) xcd_barrier(bar); } while (0)
template <int l> __device__ __forceinline__ void layer_phases(const Args& args, LAS unsigned char* lds, const XcdBarrier& bar, const int lo, const int hi,
                                                             const int tid, const int lane, const int wave, const int G, const int bx, const int vcu, const int gw, const int NGW) {
    unsigned char* ws = args.ws;
    gu32* ctl = (gu32*)(ws + WS_CTL);
    const float* x_in = args.in[0]; const float* ln_mix = args.in[1]; const float* w_in = args.in[2]; const float* w_alpha = args.in[3]; const float* b_alpha = args.in[4];
    const float* gla_norm = args.in[5]; const float* w_pool = args.in[6]; const float* pool_scale = args.in[7]; const float* w_bg = args.in[8]; const float* w_bp = args.in[9];
    const float* w_out = args.in[10]; const float* ln_ffn = args.in[11]; const float* ffn_g = args.in[12]; const float* ffn_u = args.in[13]; const float* ffn_d = args.in[14];
    const float* router_w = args.in[15]; const float* exp_g = args.in[16]; const float* exp_u = args.in[17]; const float* exp_d = args.in[18]; const float* ln_final = args.in[19];
    float* xo = args.out;
    bf16* WinT = (bf16*)(ws + WS_WIN); bf16* BcatT = (bf16*)(ws + WS_BCAT); bf16* WoutT = (bf16*)(ws + WS_WOUT); bf16* FF1T = (bf16*)(ws + WS_FF1); bf16* FF2T = (bf16*)(ws + WS_FF2);
    unsigned char* EF1T = ws + WS_EF1; unsigned char* EF2T = ws + WS_EF2;
    bf16* Hb = (bf16*)(ws + WS_HB); bf16* Zb = (bf16*)(ws + WS_ZB); float* LA = (float*)(ws + WS_LA); float* OF = (float*)(ws + WS_OF);
    bf16* Acat = (bf16*)(ws + WS_ACAT); bf16* Ub = (bf16*)(ws + WS_U); bf16* Hmid = (bf16*)(ws + WS_HMID); unsigned char* Hmid8 = ws + WS_HMID; unsigned char* Hperm8 = ws + WS_HPERM;
    bf16* WA1T = (bf16*)(ws + WS_CTL + 3 * MiB); bf16* WbpT = (bf16*)(ws + WS_OF); bf16* WpS = (bf16*)(ws + WS_OF + 8 * MiB);
    int* slot_of_tok = (int*)(ws + WS_TOKSLOT); int* tok_e = (int*)(ws + WS_TOKE); float* tok_w = (float*)(ws + WS_TOKW); bf16* YS = (bf16*)(ws + WS_LA);
    unsigned* cnt = (unsigned*)(ctl + CW_CNT); unsigned* fill = (unsigned*)(ctl + CW_FILL);

    constexpr int pb = 1 + PH_PER_LAYER * l;
        if (IN(pb + 0)) {
            pg8::Gemm g{Hb, WinT + (size_t)l * ZN * D, M, ZP, D, 0, D, D}; pg8::StaticOrder S; S.init(M, ZP, G, bx);
            pg8::EpiZ E{Zb};
            pg8::gemm_phase<pg8::EpiZ, pg8::StaticOrder, true, true>(lds + RING_OFF, g, S, E);
        }
        SEAM(pb + 0);
        bf16* ATT = (bf16*)(ws + WS_LA); float* DEC = (float*)(ws + WS_LA + 8 * MiB); float* DSEG = (float*)(ws + WS_LA + 10 * MiB); float* SL = (float*)(ws + WS_U);
        if (IN(pb + 1)) gla_g0(lds + RING_OFF, Zb, Hb, WA1T + (size_t)l * 16 * D, w_alpha + (size_t)l * 16 * 1024, b_alpha + l * 1024, ATT, DEC, bx, G, tid, lane, wave);
        SEAM(pb + 1);
        if (IN(pb + 2)) gla_g1(lds + RING_OFF, Zb, DEC, SL, DSEG, bx, G, tid, lane, wave);
        SEAM(pb + 2);
        if (IN(pb + 3)) {
            if (l == 0) {
                pg8::Gemm g{WbpT, WpS, 2 * 4 * 2048, 256, 256, (size_t)256 * 256 * 2, 256, 256}; pg8::PoolOrder S; S.G = G; S.c = bx;
                pg8::EpiPoolW E{BcatT};
                pg8::gemm_phase<pg8::EpiPoolW, pg8::PoolOrder, false, false>(lds + RING_OFF, g, S, E);
            }
            gla_g2(SL, DSEG, vcu * 512 + tid, G * 512);
        }
        SEAM(pb + 3);
        if (IN(pb + 4)) gla_g3(lds + RING_OFF, Zb, ATT, DEC, SL, OF, bx, G, tid, lane, wave);
        SEAM(pb + 4);
        if (IN(pb + 5)) {
            const float* gn = gla_norm + l * HV;
            for (int m = gw; m < M; m += NGW) {
                const f32x4 g0 = *(const GAS f32x4*)(gn + lane * 8), g1 = *(const GAS f32x4*)(gn + lane * 8 + 4);
#pragma unroll
                for (int h = 0; h < NH; ++h) {
                    const v4u ow = *(const GAS v4u*)((const bf16*)OF + (size_t)m * D + h * HV + lane * 8); f32x4 o0 = {bfl(ow.x), bfh(ow.x), bfl(ow.y), bfh(ow.y)}, o1 = {bfl(ow.z), bfh(ow.z), bfl(ow.w), bfh(ow.w)};
                    float s = (o0.x * o0.x + o0.y * o0.y) + (o0.z * o0.z + o0.w * o0.w) + (o1.x * o1.x + o1.y * o1.y) + (o1.z * o1.z + o1.w * o1.w);
                    const float rstd = 1.0f / sqrtf(wave_sum(s) * (1.0f / HV) + EPS);
                    const v4u rw = *(const GAS v4u*)(Zb + (size_t)m * ZP + ZC_R + h * HV + lane * 8);
                    o0 = o0 * rstd * g0; o1 = o1 * rstd * g1;
                    v4u w; w.x = pk2(o0.x * bfl(rw.x), o0.y * bfh(rw.x)); w.y = pk2(o0.z * bfl(rw.y), o0.w * bfh(rw.y)); w.z = pk2(o1.x * bfl(rw.z), o1.y * bfh(rw.z)); w.w = pk2(o1.z * bfl(rw.w), o1.w * bfh(rw.w));
                    *(GAS v4u*)(Acat + (size_t)m * KCAT + h * HV + lane * 8) = w;
                }
                const int t = m & (SEQ - 1), win = 2 << (lane >> 4), nw = (t + 1 < win) ? (t + 1) : win;
                float sm[16], p0[16];
#pragma unroll
                for (int i = 0; i < 16; ++i) { sm[i] = 0.f; p0[i] = 0.f; }
#pragma unroll
                for (int bt = 0; bt < 2; ++bt) {
                    v4u pa[8], pc[8];
#pragma unroll
                    for (int s = 0; s < 8; ++s) { const int sft = 8 * bt + s; pa[s] = (v4u){0u, 0u, 0u, 0u}; pc[s] = (v4u){0u, 0u, 0u, 0u};
                        if (sft < nw) { const GAS v4u* pp = (const GAS v4u*)(Zb + (size_t)(m - sft) * ZP + ZC_P + lane * 16); pa[s] = pp[0]; pc[s] = pp[1]; } }
#pragma unroll
                    for (int s = 0; s < 8; ++s) { const v4u a = pa[s], c = pc[s];
                        const float pv[16] = {bfl(a.x), bfh(a.x), bfl(a.y), bfh(a.y), bfl(a.z), bfh(a.z), bfl(a.w), bfh(a.w), bfl(c.x), bfh(c.x), bfl(c.y), bfh(c.y), bfl(c.z), bfh(c.z), bfl(c.w), bfh(c.w)};
#pragma unroll
                        for (int i = 0; i < 16; ++i) { sm[i] += pv[i]; if (bt == 0 && s == 0) p0[i] = pv[i]; } }
                }
                const float inv = 1.0f / (float)nw;
                v4u w0, w1;
                w0.x = pk2(sm[0] * inv - p0[0], sm[1] * inv - p0[1]); w0.y = pk2(sm[2] * inv - p0[2], sm[3] * inv - p0[3]); w0.z = pk2(sm[4] * inv - p0[4], sm[5] * inv - p0[5]); w0.w = pk2(sm[6] * inv - p0[6], sm[7] * inv - p0[7]);
                w1.x = pk2(sm[8] * inv - p0[8], sm[9] * inv - p0[9]); w1.y = pk2(sm[10] * inv - p0[10], sm[11] * inv - p0[11]); w1.z = pk2(sm[12] * inv - p0[12], sm[13] * inv - p0[13]); w1.w = pk2(sm[14] * inv - p0[14], sm[15] * inv - p0[15]);
                GAS v4u* mp = (GAS v4u*)(Acat + (size_t)m * KCAT + 2048 + lane * 16); mp[0] = w0; mp[1] = w1;
            }
        }
        SEAM(pb + 5);
        if (IN(pb + 6)) {
            pg8::Gemm g{Acat, BcatT + (size_t)l * D * KCAT, M, D, D, 0, KCAT, KCAT}; pg8::StaticOrder S; S.init(M, D, G, bx);
            pg8::EpiGate<false> E{Ub, D, Zb + ZC_GA, ZP};
            pg8::gemm_phase<pg8::EpiGate<false>, pg8::StaticOrder, true, true>(lds + RING_OFF, g, S, E);
        }
        if (IN(pb + 6)) {
            VM_WAIT(); __syncthreads();
            pg8::Gemm g{Acat + 2048, BcatT + (size_t)l * D * KCAT + 2048, M, D, 1024, 0, KCAT, KCAT}; pg8::StaticOrder S; S.init(M, D, G, bx);
            pg8::EpiGate<true> E{Ub, D, Zb + ZC_GB, ZP};
            pg8::gemm_phase<pg8::EpiGate<true>, pg8::StaticOrder, true, true>(lds + RING_OFF, g, S, E);
        }
        SEAM(pb + 6);
        if (IN(pb + 7)) {
            pg8::Gemm g{Ub, WoutT + (size_t)l * D * D, M, D, D, 0, D, D}; pg8::StaticOrder S; S.init(M, D, G, bx);
            pg8::EpiRes E{l == 0 ? x_in : (const float*)xo, xo, D};
            pg8::gemm_phase<pg8::EpiRes, pg8::StaticOrder, true, true>(lds + RING_OFF, g, S, E);
        }
        SEAM(pb + 7);
        if (IN(pb + 8)) {
            if (l == 0) norm_rows<false, DENSE_FP8>(xo, ln_ffn, Hb, gw, NGW, lane, nullptr, nullptr, nullptr, nullptr);
            else {
                LAS float* rw = (LAS float*)(lds + RING_OFF); LAS unsigned* hist = (LAS unsigned*)(lds + RING_OFF + 65536);
                for (int i = tid; i < D * NE / 4; i += 512) ((LAS f32x4*)rw)[i] = ((const GAS f32x4*)router_w)[i];
                if (tid < 8) hist[tid] = 0u;
                __syncthreads();
                norm_rows<true>(xo, ln_ffn + D, Hb, gw, NGW, lane, rw, tok_e, tok_w, hist);
                __syncthreads();
                if (tid < 8) __hip_atomic_fetch_add(cnt + tid, hist[tid], RLX_AGENT);
            }
        }
        SEAM(pb + 8);
        if (l == 0) {
            if (IN(pb + 9)) {
                pg8::StaticOrder S; S.init(M, FFN, G, bx);
                if constexpr (DENSE_FP8) { pg8::Gemm g{Hb, FF1T, M, FFN, D / 2, 0, D / 2, D / 2}; pg8::EpiSwiGLU8 E{Hmid8, DFF};
                    pg8::gemm_phase<pg8::EpiSwiGLU8, pg8::StaticOrder, true, true, true>(lds + RING_OFF, g, S, E); }
                else { pg8::Gemm g{Hb, FF1T, M, FFN, D, 0, D, D}; pg8::EpiSwiGLU E{Hmid, DFF};
                    pg8::gemm_phase<pg8::EpiSwiGLU, pg8::StaticOrder, true, true>(lds + RING_OFF, g, S, E); }
            }
            SEAM(pb + 9);
            if (IN(pb + 10)) {
                pg8::StaticOrder S; S.init(M, D, G, bx); pg8::EpiRes E{xo, xo, D};
                if constexpr (DENSE_FP8) { pg8::Gemm g{Hmid, FF2T, M, D, DFF / 2, 0, DFF / 2, DFF / 2}; pg8::gemm_phase<pg8::EpiRes, pg8::StaticOrder, true, true, true>(lds + RING_OFF, g, S, E); }
                else { pg8::Gemm g{Hmid, FF2T, M, D, DFF, 0, DFF, DFF}; pg8::gemm_phase<pg8::EpiRes, pg8::StaticOrder, true, true>(lds + RING_OFF, g, S, E); }
            }
            SEAM(pb + 10);
            if (IN(pb + 11)) norm_rows<false>(xo, ln_mix + D, Hb, gw, NGW, lane, nullptr, nullptr, nullptr, nullptr);
            SEAM(pb + 11);
        } else {
            if (IN(pb + 9)) {
                LAS unsigned* lcnt = (LAS unsigned*)(lds + RING_OFF); LAS unsigned* lbase = lcnt + 8; LAS int* lslot = (LAS int*)(lcnt + 16);
                int brow[8]; { int p = 0;
#pragma unroll
                    for (int e = 0; e < 8; ++e) { brow[e] = 256 * p; p += (int)((__hip_atomic_load(cnt + e, RLX_AGENT) + 255u) >> 8); } }
                for (int ch = bx; ch < M / 64; ch += G) {
                    __syncthreads();
                    if (tid < 8) lcnt[tid] = 0u;
                    __syncthreads();
                    int e = 0, tok = 0; unsigned rank = 0;
                    if (tid < 128) { tok = ch * 64 + (tid >> 1); e = tok_e[2 * tok + (tid & 1)]; rank = __hip_atomic_fetch_add(lcnt + e, 1u, __ATOMIC_RELAXED, __HIP_MEMORY_SCOPE_WORKGROUP); }
                    __syncthreads();
                    if (tid < 8) lbase[tid] = __hip_atomic_fetch_add(fill + tid, lcnt[tid], RLX_AGENT);
                    __syncthreads();
                    if (tid < 128) { int br = 0;
#pragma unroll
                        for (int q = 0; q < 8; ++q) br = (e == q) ? brow[q] : br;
                        const int slot = br + (int)lbase[e] + (int)rank; lslot[tid] = slot; slot_of_tok[2 * tok + (tid & 1)] = slot; }
                    __syncthreads();
                    for (int en = wave; en < 128; en += NWAVES) { const int tk = ch * 64 + (en >> 1), slot = lslot[en];
                        const GAS v4u* src = (const GAS v4u*)(Hb + (size_t)tk * D) + 4 * lane; GAS v4u* dst = (GAS v4u*)(Hperm8 + (size_t)slot * D) + 2 * lane;
#pragma unroll
                        for (int j = 0; j < 2; ++j) { const v4u a = src[2 * j], c = src[2 * j + 1]; v4u o;
                            o.x = pg8::pk4_fp8(bfl(a.x), bfh(a.x), bfl(a.y), bfh(a.y)); o.y = pg8::pk4_fp8(bfl(a.z), bfh(a.z), bfl(a.w), bfh(a.w));
                            o.z = pg8::pk4_fp8(bfl(c.x), bfh(c.x), bfl(c.y), bfh(c.y)); o.w = pg8::pk4_fp8(bfl(c.z), bfh(c.z), bfl(c.w), bfh(c.w)); dst[j] = o; } }
                }
            }
            SEAM(pb + 9);
            if (IN(pb + 10)) {
                pg8::Gemm g{(const bf16*)Hperm8, (const bf16*)EF1T, MAXSLOT, FFN, D / 2, (size_t)FFN * D, D / 2, D / 2}; pg8::MoeOrder S; S.init(cnt, FFN / 256, G, bx);
                pg8::EpiSwiGLU8 E{Hmid8, DFF};
                pg8::gemm_phase<pg8::EpiSwiGLU8, pg8::MoeOrder, true, true, true>(lds + RING_OFF, g, S, E);
            }
            SEAM(pb + 10);
            if (IN(pb + 11)) {
                pg8::Gemm g{(const bf16*)Hmid8, (const bf16*)EF2T, MAXSLOT, D, DFF / 2, (size_t)D * DFF, DFF / 2, DFF / 2}; pg8::MoeOrder S; S.init(cnt, D / 256, G, bx);
                pg8::EpiBf16 E{YS, D};
                pg8::gemm_phase<pg8::EpiBf16, pg8::MoeOrder, true, true, true>(lds + RING_OFF, g, S, E);
            }
            SEAM(pb + 11);
        }
}

__global__ void __launch_bounds__(NWAVES * 64, 2) fwd(Args args) {
    extern __shared__ __attribute__((aligned(16))) unsigned char lds_raw[];
    LAS unsigned char* lds = (LAS unsigned char*)lds_raw;
    volatile LAS unsigned* MISC = (volatile LAS unsigned*)(lds + MISC_OFF);
    const int tid = threadIdx.x, lane = tid & 63, wave = __builtin_amdgcn_readfirstlane(tid >> 6);
    const int G = gridDim.x, bx = blockIdx.x;
    const int vcu = (G % 8 == 0) ? (bx % 8) * (G / 8) + bx / 8 : bx;
    const int gw = vcu * NWAVES + wave, NGW = G * NWAVES;
    unsigned char* ws = args.ws;
    gu32* ctl = (gu32*)(ws + WS_CTL);
    const float* x_in = args.in[0]; const float* ln_mix = args.in[1]; const float* w_in = args.in[2]; const float* w_alpha = args.in[3]; const float* b_alpha = args.in[4];
    const float* gla_norm = args.in[5]; const float* w_pool = args.in[6]; const float* pool_scale = args.in[7]; const float* w_bg = args.in[8]; const float* w_bp = args.in[9];
    const float* w_out = args.in[10]; const float* ln_ffn = args.in[11]; const float* ffn_g = args.in[12]; const float* ffn_u = args.in[13]; const float* ffn_d = args.in[14];
    const float* router_w = args.in[15]; const float* exp_g = args.in[16]; const float* exp_u = args.in[17]; const float* exp_d = args.in[18]; const float* ln_final = args.in[19];
    float* xo = args.out;
    bf16* WinT = (bf16*)(ws + WS_WIN); bf16* BcatT = (bf16*)(ws + WS_BCAT); bf16* WoutT = (bf16*)(ws + WS_WOUT); bf16* FF1T = (bf16*)(ws + WS_FF1); bf16* FF2T = (bf16*)(ws + WS_FF2);
    unsigned char* EF1T = ws + WS_EF1; unsigned char* EF2T = ws + WS_EF2;
    bf16* Hb = (bf16*)(ws + WS_HB); bf16* Zb = (bf16*)(ws + WS_ZB); float* LA = (float*)(ws + WS_LA); float* OF = (float*)(ws + WS_OF);
    bf16* Acat = (bf16*)(ws + WS_ACAT); bf16* Ub = (bf16*)(ws + WS_U); bf16* Hmid = (bf16*)(ws + WS_HMID); unsigned char* Hmid8 = ws + WS_HMID; unsigned char* Hperm8 = ws + WS_HPERM;
    bf16* WA1T = (bf16*)(ws + WS_CTL + 3 * MiB); bf16* WbpT = (bf16*)(ws + WS_OF); bf16* WpS = (bf16*)(ws + WS_OF + 8 * MiB);
    int* slot_of_tok = (int*)(ws + WS_TOKSLOT); int* tok_e = (int*)(ws + WS_TOKE); float* tok_w = (float*)(ws + WS_TOKW); bf16* YS = (bf16*)(ws + WS_LA);
    unsigned* cnt = (unsigned*)(ctl + CW_CNT); unsigned* fill = (unsigned*)(ctl + CW_FILL);

    for (int u = tid; u < (LDS_BYTES - LDSCTL_OFF) / 4; u += NWAVES * 64) ((LAS unsigned*)(lds + LDSCTL_OFF))[u] = 0u;
    __syncthreads();
    const int lo = args.ph_lo, hi = args.ph_hi;
    XcdBarrier bar; bar.bar = (unsigned*)(ctl + CW_BAR); bar.x = 0; bar.st = nullptr;
    if (hi - lo > 1) bar = xcd_barrier_post((unsigned*)(ctl + CW_BAR), MISC + 8);

    if (IN(0)) {
        LAS unsigned* Tl = (LAS unsigned*)(lds + RING_OFF + wave * 16384);
#ifdef PROBE_NOW
        const int PNW = (args.li == 7);
#else
        constexpr int PNW = 0;
#endif
        for (int i = vcu * 512 + tid; i < 2 * 16 * D; i += G * 512) { const int l = i >> 15, r = (i >> 11) & 15, k = i & 2047; WA1T[i] = (bf16)f2bf(w_in[(size_t)l * D * DIN + (size_t)k * DIN + 6144 + r]); }
        for (int i = vcu * 512 + tid; i < 2 * 4 * 256 * 256 / 4; i += G * 512) { const int d4 = i & 63, lg = i >> 14;
            const f32x4 w = ((const GAS f32x4*)w_pool)[i], s = ((const GAS f32x4*)pool_scale)[lg * 64 + d4];
            v2u o; o.x = pkbf(w.x * s.x, w.y * s.y); o.y = pkbf(w.z * s.z, w.w * s.w); ((GAS v2u*)WpS)[i] = o; }
#ifdef PROBE_NOSTORE
        const int PNS = (args.li == 7);
#else
        constexpr int PNS = 0;
#endif
        constexpr int T_LAYER = 8192, T_DENSE = 8448, T_ALL = 2 * T_LAYER + T_DENSE + 8 * T_DENSE;
        auto decode = [&](int it, TrJob& J) {
            J.mode = 0; J.row_off = 0; J.kind = 0; int kt, nt;
            if (it < 2 * T_LAYER) { const int l = it / T_LAYER, r = it % T_LAYER; const float* wi = w_in + (size_t)l * D * DIN; unsigned char* wt = (unsigned char*)(WinT + (size_t)l * ZN * D);
                if (r < 3072) { J.src = wi; J.ldw = DIN; J.dst = wt; J.ldt = 2 * D; kt = r / 96; nt = r % 96; }
                else if (r < 5632) { const int q = r - 3072; J.src = wi + 6160; J.ldw = DIN; J.dst = wt; J.ldt = 2 * D; J.row_off = 6144; kt = q / 80; nt = q % 80; }
                else if (r < 6656) { const int q = r - 5632; J.src = w_bg + (size_t)l * D * D; J.ldw = D; J.dst = (unsigned char*)(BcatT + (size_t)l * D * KCAT); J.ldt = 2 * KCAT; kt = q >> 5; nt = q & 31; }
                else if (r < 7680) { const int q = r - 6656; J.src = w_out + (size_t)l * D * D; J.ldw = D; J.dst = (unsigned char*)(WoutT + (size_t)l * D * D); J.ldt = 2 * D; kt = q >> 5; nt = q & 31; }
                else { const int q = r - 7680; kt = q >> 5; nt = q & 31;
                    J.src = w_bp + (size_t)l * 1024 * D + (size_t)(64 * kt) * D + 64 * nt; J.ldw = D; J.dst = (unsigned char*)(WbpT + ((size_t)(l * 4 + (kt >> 2)) * 2048) * 256); J.ldt = 512; J.k0 = 64 * (kt & 3); J.n0 = 64 * nt; return; }
                J.k0 = 64 * kt; J.n0 = 64 * nt;
            } else if (it < 2 * T_LAYER + T_DENSE) { const int r = it - 2 * T_LAYER, j = r / 2816, q = r % 2816;
                if (DENSE_FP8) { J.kind = 1;
                    if (j == 0) { J.src = ffn_g; J.ldw = DFF; J.dst = (unsigned char*)FF1T; J.ldt = D; J.mode = 1; kt = q / 176; nt = q % 176; }
                    else if (j == 1) { J.src = ffn_u; J.ldw = DFF; J.dst = (unsigned char*)FF1T; J.ldt = D; J.mode = 1; J.row_off = 128; kt = q / 176; nt = q % 176; }
                    else { J.src = ffn_d; J.ldw = D; J.dst = (unsigned char*)FF2T; J.ldt = DFF; kt = q >> 6; nt = q & 63; }
                    J.k0 = 128 * kt; J.n0 = 32 * nt;
                } else {
                if (j == 0) { J.src = ffn_g; J.ldw = DFF; J.dst = (unsigned char*)FF1T; J.ldt = 2 * D; J.mode = 1; kt = q / 88; nt = q % 88; }
                else if (j == 1) { J.src = ffn_u; J.ldw = DFF; J.dst = (unsigned char*)FF1T; J.ldt = 2 * D; J.mode = 1; J.row_off = 128; kt = q / 88; nt = q % 88; }
                else { J.src = ffn_d; J.ldw = D; J.dst = (unsigned char*)FF2T; J.ldt = 2 * DFF; kt = q >> 5; nt = q & 31; }
                J.k0 = 64 * kt; J.n0 = 64 * nt; }
            } else { const int r = it - 2 * T_LAYER - T_DENSE, e = r / T_DENSE, r2 = r % T_DENSE, j = r2 / 2816, q = r2 % 2816; J.kind = 1;
                if (j == 0) { J.src = exp_g + (size_t)e * D * DFF; J.ldw = DFF; J.dst = EF1T + (size_t)e * FFN * D; J.ldt = D; J.mode = 1; kt = q / 176; nt = q % 176; }
                else if (j == 1) { J.src = exp_u + (size_t)e * D * DFF; J.ldw = DFF; J.dst = EF1T + (size_t)e * FFN * D; J.ldt = D; J.mode = 1; J.row_off = 128; kt = q / 176; nt = q % 176; }
                else { J.src = exp_d + (size_t)e * DFF * D; J.ldw = D; J.dst = EF2T + (size_t)e * D * DFF; J.ldt = DFF; kt = q >> 6; nt = q & 63; }
                J.k0 = 128 * kt; J.n0 = 32 * nt;
            }
            J.src += (size_t)J.k0 * J.ldw + J.n0;
        };
        if (gw < T_ALL) {
            TrJob J, Jn; f32x4 R[16], Rn[16];
            decode(gw, J); tr_load(J, R, lane);
            for (int it = gw; it < T_ALL; it += NGW) {
                const bool more = it + NGW < T_ALL;
                if (more) { decode(it + NGW, Jn); tr_load(Jn, Rn, lane); }
                tr_finish(J, R, Tl, lane, PNS && J.kind == 1);
                if (more) { J = Jn;
#pragma unroll
                    for (int i = 0; i < 16; ++i) R[i] = Rn[i]; }
            }
        }
        norm_rows<false>(x_in, ln_mix, Hb, gw, NGW, lane, nullptr, nullptr, nullptr, nullptr);
    }
    SEAM(0);
#ifdef PROBE_XBAR
    if (hi - lo > 1) for (int i = 0; i < PROBE_XBAR; ++i) xcd_barrier(bar);
#endif

    layer_phases<0>(args, lds, bar, lo, hi, tid, lane, wave, G, bx, vcu, gw, NGW);
    layer_phases<1>(args, lds, bar, lo, hi, tid, lane, wave, G, bx, vcu, gw, NGW);
    if (IN(N_PHASES - 1)) {
        f32x4 nx[8]; v2u na[8], nc[8]; float nw1 = 0.f, nw2 = 0.f;
#define FINAL_FETCH(mm) do { const int m_ = (mm); const GAS f32x4* xr_ = (const GAS f32x4*)(xo + (size_t)m_ * D) + lane; \
            const int s1_ = slot_of_tok[2 * m_], s2_ = slot_of_tok[2 * m_ + 1]; nw1 = tok_w[2 * m_]; nw2 = tok_w[2 * m_ + 1]; \
            const GAS v2u* y1_ = (const GAS v2u*)(YS + (size_t)s1_ * D) + lane; const GAS v2u* y2_ = (const GAS v2u*)(YS + (size_t)s2_ * D) + lane; \
            _Pragma("unroll") for (int j = 0; j < 8; ++j) { nx[j] = xr_[64 * j]; na[j] = y1_[64 * j]; nc[j] = y2_[64 * j]; } } while (0)
        if (gw < M) FINAL_FETCH(gw);
        for (int m = gw; m < M; m += NGW) {
            GAS f32x4* xr = (GAS f32x4*)(xo + (size_t)m * D) + lane;
            const float w1 = nw1, w2 = nw2;
            f32x4 v[8]; float s = 0.f;
#pragma unroll
            for (int j = 0; j < 8; ++j) { const v2u a = na[j], c = nc[j]; f32x4 t = nx[j];
                t.x += w1 * bfl(a.x) + w2 * bfl(c.x); t.y += w1 * bfh(a.x) + w2 * bfh(c.x); t.z += w1 * bfl(a.y) + w2 * bfl(c.y); t.w += w1 * bfh(a.y) + w2 * bfh(c.y);
                v[j] = t; s += (t.x * t.x + t.y * t.y) + (t.z * t.z + t.w * t.w); }
            if (m + NGW < M) FINAL_FETCH(m + NGW);
            const float rstd = 1.0f / sqrtf(wave_sum(s) * (1.0f / D) + EPS);
#pragma unroll
            for (int j = 0; j < 8; ++j) { const f32x4 g4 = ((const GAS f32x4*)ln_final)[lane + 64 * j]; xr[64 * j] = v[j] * rstd * g4; }
        }
    }
#undef IN
#undef SEAM
}

#ifndef MK_ONE_LAUNCH
#define MK_ONE_LAUNCH 1
#endif
#ifndef PROBE_DUP
#define PROBE_DUP -1
#endif
#ifndef PROBE_REP
#define PROBE_REP 1
#endif
extern "C" void kernel_launch(void* const* d_in, const int* in_sizes, int n_in, void* d_out, int out_size, void* d_ws, size_t ws_size, hipStream_t stream) {
    static int grid = 0;
    if (grid == 0) {
        if (n_in != 20 || in_sizes[0] != M * D || out_size != M * D || ws_size < WS_END) { fprintf(stderr, "kernel_launch: unexpected shapes / workspace (n_in %d, in0 %d, out %d, ws %zu < %zu); nothing launched\n", n_in, n_in > 0 ? in_sizes[0] : -1, out_size, ws_size, (size_t)WS_END); grid = -1; return; }
        int dev = 0, cus = 0, per_cu = 0;
        if (hipGetDevice(&dev) != hipSuccess || hipDeviceGetAttribute(&cus, hipDeviceAttributeMultiprocessorCount, dev) != hipSuccess) { grid = -1; return; }
        if (hipFuncSetAttribute((const void*)fwd, hipFuncAttributeMaxDynamicSharedMemorySize, LDS_BYTES) != hipSuccess) { fprintf(stderr, "kernel_launch: hipFuncSetAttribute failed\n"); grid = -1; return; }
        if (hipOccupancyMaxActiveBlocksPerMultiprocessor(&per_cu, (const void*)fwd, NWAVES * 64, LDS_BYTES) != hipSuccess || per_cu < 1) { fprintf(stderr, "kernel_launch: occupancy query reports %d workgroups per CU\n", per_cu); }
        (void)hipGetLastError();
        grid = cus;
    }
    if (grid < 0) return;
    if (hipMemsetAsync((char*)d_ws + WS_CTL, 0, CTL_ZERO_BYTES, stream) != hipSuccess) return;
    Args a{};
    for (int i = 0; i < 20; ++i) a.in[i] = (const float*)d_in[i];
    a.out = (float*)d_out; a.ws = (unsigned char*)d_ws;
#if MK_ONE_LAUNCH
    a.ph_lo = 0; a.ph_hi = N_PHASES; a.li = 0;
    hipLaunchKernelGGL(fwd, dim3(grid), dim3(NWAVES * 64), LDS_BYTES, stream, a);
#else
    for (int p = 0; p < N_PHASES; ++p) { a.ph_lo = p; a.ph_hi = p + 1;
        if (p == PROBE_DUP) { a.li = 7; for (int r = 0; r < PROBE_REP; ++r) hipLaunchKernelGGL(fwd, dim3(grid), dim3(NWAVES * 64), LDS_BYTES, stream, a); }
        a.li = 0; hipLaunchKernelGGL(fwd, dim3(grid), dim3(NWAVES * 64), LDS_BYTES, stream, a); }
#endif
}
```

```cpp
#include <hip/hip_runtime.h>
#include <cstdio>
#include <cstdint>

namespace pg8 {
#define PG8_LAS __attribute__((address_space(3)))
typedef unsigned short bf16_t;
typedef short bf16x8 __attribute__((ext_vector_type(8)));
typedef float f32x4 __attribute__((ext_vector_type(4)));
typedef unsigned u32x4 __attribute__((ext_vector_type(4)));
typedef unsigned u32x2 __attribute__((ext_vector_type(2)));
constexpr int BM = 256, BK = 64, HALF = 128, HTB = HALF * BK * 2  , STAGE_BYTES = 8 * HTB, NXCD = 8, WGM = 8;

__host__ __device__ __forceinline__ int lds_byte(int r, int c) { const int st = (r >> 4) * 2 + (c >> 5), rr = r & 15, cc = c & 31, ob = rr * 64 + cc * 2; return st * 1024 + (ob ^ (((ob >> 9) & 1) << 5)); }
__host__ __device__ __forceinline__ void stage_rc(int b, int& R, int& C) { const int st = b / 1024, sb = b % 1024, swz = sb ^ (((sb >> 9) & 1) << 5); R = (st >> 1) * 16 + swz / 64; C = (st & 1) * 32 + (swz % 64) / 2; }
__host__ __device__ __forceinline__ int perm32(int rho) { const int n = rho >> 4, i = rho & 15; return 8 * (i >> 2) + 4 * n + (i & 3); }

struct Unit { int pm, pn, be; };
struct Gemm { const bf16_t* A; const bf16_t* Bt; int M, N, K; size_t bstride; int lda, ldb; };

struct StaticOrder {
    int nM, nN, nwg, G, c;
    __host__ __device__ void init(int M, int N, int G_, int c_) { nM = M / BM; nN = N / BM; nwg = nM * nN; G = G_; c = c_; }
    __host__ __device__ bool next(int i, Unit& u) const {
        const long L = (long)i * G + c; if (L >= nwg) return false;
        int wgid = (int)L; { const int q = nwg / NXCD, r = nwg % NXCD, xcd = wgid % NXCD, off = wgid / NXCD; wgid = (xcd < r ? xcd * (q + 1) : r * (q + 1) + (xcd - r) * q) + off; }
        const int nig = WGM * nN, gid = wgid / nig, fm = gid * WGM, gsz = (nM - fm) < WGM ? (nM - fm) : WGM;
        u.pm = fm + ((wgid % nig) % gsz); u.pn = (wgid % nig) / gsz; u.be = 0; return true;
    }
    __device__ __forceinline__ void a_ready(const Unit&) const {}
    __device__ __forceinline__ void done(const Unit&) const {}
};
struct PoolOrder {
    int G, c;
    __device__ __forceinline__ bool next(int i, Unit& u) const { const int L = i * G + c; if (L >= 64) return false; u.pm = L; u.pn = 0; u.be = L >> 3; return true; }
    __device__ __forceinline__ void a_ready(const Unit&) const {}
    __device__ __forceinline__ void done(const Unit&) const {}
};
struct MoeOrder {
    int nM, nN, nwg, G, c; int pe[8];
    __device__ __forceinline__ void init(const unsigned* cnt, int nN_, int G_, int c_) {
        int p = 0;
#pragma unroll
        for (int e = 0; e < 8; ++e) { p += (int)((__hip_atomic_load(cnt + e, __ATOMIC_RELAXED, __HIP_MEMORY_SCOPE_AGENT) + 255u) >> 8); pe[e] = p; }
        nM = p; nN = nN_; nwg = nM * nN; G = G_; c = c_;
    }
    __device__ __forceinline__ bool next(int i, Unit& u) const {
        const long L = (long)i * G + c; if (L >= nwg) return false;
        int wgid = (int)L; { const int q = nwg / NXCD, r = nwg % NXCD, xcd = wgid % NXCD, off = wgid / NXCD; wgid = (xcd < r ? xcd * (q + 1) : r * (q + 1) + (xcd - r) * q) + off; }
        const int nig = WGM * nN, gid = wgid / nig, fm = gid * WGM, gsz = (nM - fm) < WGM ? (nM - fm) : WGM;
        u.pm = fm + ((wgid % nig) % gsz); u.pn = (wgid % nig) / gsz;
        int be = 0;
#pragma unroll
        for (int e = 0; e < 7; ++e) be += (u.pm >= pe[e]) ? 1 : 0;
        u.be = be; return true;
    }
    __device__ __forceinline__ void a_ready(const Unit&) const {}
    __device__ __forceinline__ void done(const Unit&) const {}
};

__device__ __forceinline__ unsigned cvt_pk_bf16(float lo, float hi) { unsigned r; asm volatile("v_cvt_pk_bf16_f32 %0, %1, %2" : "=v"(r) : "v"(lo), "v"(hi)); return r; }
__device__ __forceinline__ float bf_lo(unsigned w) { return __uint_as_float(w << 16); }
__device__ __forceinline__ float bf_hi(unsigned w) { return __uint_as_float(w & 0xffff0000u); }
__device__ __forceinline__ float fsigmoid(float x) { return __builtin_amdgcn_rcpf(1.0f + __expf(-x)); }
__device__ __forceinline__ float fsilu(float x) { return x * __builtin_amdgcn_rcpf(1.0f + __expf(-x)); }
__device__ __forceinline__ float flogsig(float x) { return fminf(x, 0.0f) - __logf(1.0f + __expf(-fabsf(x))); }

constexpr int ZP_ = 11264;
struct EpiZ {
    static constexpr bool PERM = true, AFTER_DRAIN = false;
    bf16_t* Zb;
    __device__ __forceinline__ void operator()(const f32x4 (&acc)[2][2][4][2], const Unit& u, int wr, int wc, int fr, int fq) const {
        const int row0 = u.pm * BM + wr * 64 + fr; const int pn = u.pn;
        const int mode = (pn >= 16 && pn < 24) ? 1 : (pn >= 28 ? 2 : 0);
        const int col0 = pn * BM + wc * 32 + 8 * fq;
#pragma unroll
        for (int ai = 0; ai < 2; ++ai)
#pragma unroll
            for (int m = 0; m < 4; ++m) { bf16_t* rowp = Zb + (size_t)(row0 + ai * HALF + m * 16) * ZP_ + col0;
#pragma unroll
                for (int bj = 0; bj < 2; ++bj) { f32x4 v0 = acc[ai][bj][m][0], v1 = acc[ai][bj][m][1];
                    if (mode == 1) {
#pragma unroll
                        for (int j = 0; j < 4; ++j) { v0[j] = fsilu(v0[j]); v1[j] = fsilu(v1[j]); } }
                    else if (mode == 2) {
#pragma unroll
                        for (int j = 0; j < 4; ++j) { v0[j] = fsigmoid(v0[j]); v1[j] = fsigmoid(v1[j]); } }
                    u32x4 w; w.x = cvt_pk_bf16(v0[0], v0[1]); w.y = cvt_pk_bf16(v0[2], v0[3]); w.z = cvt_pk_bf16(v1[0], v1[1]); w.w = cvt_pk_bf16(v1[2], v1[3]);
                    *(u32x4*)(rowp + bj * HALF) = w; } }
    }
};
template <bool ACCUM> struct EpiGate {
    static constexpr bool PERM = true, AFTER_DRAIN = false;
    bf16_t* U; int ldu; const bf16_t* G; int ldg;
    __device__ __forceinline__ void operator()(const f32x4 (&acc)[2][2][4][2], const Unit& u, int wr, int wc, int fr, int fq) const {
        const int row0 = u.pm * BM + wr * 64 + fr, col0 = u.pn * BM + wc * 32 + 8 * fq;
#pragma unroll
        for (int ai = 0; ai < 2; ++ai) {
            u32x4 gw[4][2], ow[4][2];
#pragma unroll
            for (int m = 0; m < 4; ++m) { const size_t r = (size_t)(row0 + ai * HALF + m * 16);
#pragma unroll
                for (int bj = 0; bj < 2; ++bj) { gw[m][bj] = *(const u32x4*)(G + r * ldg + col0 + bj * HALF); if (ACCUM) ow[m][bj] = *(const u32x4*)(U + r * ldu + col0 + bj * HALF); } }
            __builtin_amdgcn_sched_barrier(0);
#pragma unroll
            for (int m = 0; m < 4; ++m) { bf16_t* up = U + (size_t)(row0 + ai * HALF + m * 16) * ldu + col0;
#pragma unroll
                for (int bj = 0; bj < 2; ++bj) { const u32x4 g4 = gw[m][bj]; f32x4 v0 = acc[ai][bj][m][0], v1 = acc[ai][bj][m][1];
                    v0[0] *= bf_lo(g4.x); v0[1] *= bf_hi(g4.x); v0[2] *= bf_lo(g4.y); v0[3] *= bf_hi(g4.y); v1[0] *= bf_lo(g4.z); v1[1] *= bf_hi(g4.z); v1[2] *= bf_lo(g4.w); v1[3] *= bf_hi(g4.w);
                    if (ACCUM) { const u32x4 o4 = ow[m][bj];
                        v0[0] += bf_lo(o4.x); v0[1] += bf_hi(o4.x); v0[2] += bf_lo(o4.y); v0[3] += bf_hi(o4.y); v1[0] += bf_lo(o4.z); v1[1] += bf_hi(o4.z); v1[2] += bf_lo(o4.w); v1[3] += bf_hi(o4.w); }
                    u32x4 w; w.x = cvt_pk_bf16(v0[0], v0[1]); w.y = cvt_pk_bf16(v0[2], v0[3]); w.z = cvt_pk_bf16(v1[0], v1[1]); w.w = cvt_pk_bf16(v1[2], v1[3]);
                    *(u32x4*)(up + bj * HALF) = w; } }
            __builtin_amdgcn_sched_barrier(0);
        }
    }
};
struct EpiRes {
    static constexpr bool PERM = false, AFTER_DRAIN = false;
    const float* base; float* out; int ldc;
    __device__ __forceinline__ void operator()(const f32x4 (&acc)[2][2][4][2], const Unit& u, int wr, int wc, int fr, int fq) const {
        const int row0 = u.pm * BM + wr * 64 + fr, col0 = u.pn * BM + wc * 32 + 4 * fq;
#pragma unroll
        for (int ai = 0; ai < 2; ++ai) {
            f32x4 bs[4][2][2];
#pragma unroll
            for (int m = 0; m < 4; ++m) { const size_t off = (size_t)(row0 + ai * HALF + m * 16) * ldc + col0;
#pragma unroll
                for (int bj = 0; bj < 2; ++bj)
#pragma unroll
                    for (int n = 0; n < 2; ++n) bs[m][bj][n] = *(const f32x4*)(base + off + bj * HALF + n * 16); }
            __builtin_amdgcn_sched_barrier(0);
#pragma unroll
            for (int m = 0; m < 4; ++m) { const size_t off = (size_t)(row0 + ai * HALF + m * 16) * ldc + col0;
#pragma unroll
                for (int bj = 0; bj < 2; ++bj)
#pragma unroll
                    for (int n = 0; n < 2; ++n) *(f32x4*)(out + off + bj * HALF + n * 16) = bs[m][bj][n] + acc[ai][bj][m][n]; }
            __builtin_amdgcn_sched_barrier(0);
        }
    }
};
struct EpiSwiGLU {
    static constexpr bool PERM = true, AFTER_DRAIN = false;
    bf16_t* Hm; int ldh;
    __device__ __forceinline__ void operator()(const f32x4 (&acc)[2][2][4][2], const Unit& u, int wr, int wc, int fr, int fq) const {
        const int row0 = u.pm * BM + wr * 64 + fr, colh = u.pn * HALF + wc * 32 + 8 * fq;
#pragma unroll
        for (int ai = 0; ai < 2; ++ai)
#pragma unroll
            for (int m = 0; m < 4; ++m) { bf16_t* rowp = Hm + (size_t)(row0 + ai * HALF + m * 16) * ldh + colh;
                const f32x4 g0 = acc[ai][0][m][0], g1 = acc[ai][0][m][1], u0 = acc[ai][1][m][0], u1 = acc[ai][1][m][1];
                u32x4 w; w.x = cvt_pk_bf16(fsilu(g0[0]) * u0[0], fsilu(g0[1]) * u0[1]); w.y = cvt_pk_bf16(fsilu(g0[2]) * u0[2], fsilu(g0[3]) * u0[3]);
                w.z = cvt_pk_bf16(fsilu(g1[0]) * u1[0], fsilu(g1[1]) * u1[1]); w.w = cvt_pk_bf16(fsilu(g1[2]) * u1[2], fsilu(g1[3]) * u1[3]);
                *(u32x4*)rowp = w; }
    }
};
struct EpiBf16 {
    static constexpr bool PERM = true, AFTER_DRAIN = false;
    bf16_t* O; int ldc;
    __device__ __forceinline__ void operator()(const f32x4 (&acc)[2][2][4][2], const Unit& u, int wr, int wc, int fr, int fq) const {
        const int row0 = u.pm * BM + wr * 64 + fr, col0 = u.pn * BM + wc * 32 + 8 * fq;
#pragma unroll
        for (int ai = 0; ai < 2; ++ai)
#pragma unroll
            for (int m = 0; m < 4; ++m) { bf16_t* rowp = O + (size_t)(row0 + ai * HALF + m * 16) * ldc + col0;
#pragma unroll
                for (int bj = 0; bj < 2; ++bj) { const f32x4 v0 = acc[ai][bj][m][0], v1 = acc[ai][bj][m][1];
                    u32x4 w; w.x = cvt_pk_bf16(v0[0], v0[1]); w.y = cvt_pk_bf16(v0[2], v0[3]); w.z = cvt_pk_bf16(v1[0], v1[1]); w.w = cvt_pk_bf16(v1[2], v1[3]);
                    *(u32x4*)(rowp + bj * HALF) = w; } }
    }
};

typedef int i32x8 __attribute__((ext_vector_type(8)));
typedef int i32x4 __attribute__((ext_vector_type(4)));
constexpr int FP8_WSCALE = 127 - 6;
__device__ __forceinline__ i32x8 pg8_cat(const bf16x8& a, const bf16x8& b) { return __builtin_shufflevector(__builtin_bit_cast(i32x4, a), __builtin_bit_cast(i32x4, b), 0, 1, 2, 3, 4, 5, 6, 7); }
__device__ __forceinline__ unsigned pk4_fp8(float a, float b, float c, float d) { int w = __builtin_amdgcn_cvt_pk_fp8_f32(a, b, 0, false); w = __builtin_amdgcn_cvt_pk_fp8_f32(c, d, w, true); return (unsigned)w; }
struct EpiSwiGLU8 {
    static constexpr bool PERM = true, AFTER_DRAIN = false;
    unsigned char* Hm; int ldh;
    __device__ __forceinline__ void operator()(const f32x4 (&acc)[2][2][4][2], const Unit& u, int wr, int wc, int fr, int fq) const {
        const int row0 = u.pm * BM + wr * 64 + fr, colh = u.pn * HALF + wc * 32 + 8 * fq;
#pragma unroll
        for (int ai = 0; ai < 2; ++ai)
#pragma unroll
            for (int m = 0; m < 4; ++m) { unsigned char* rowp = Hm + (size_t)(row0 + ai * HALF + m * 16) * ldh + colh;
                const f32x4 g0 = acc[ai][0][m][0], g1 = acc[ai][0][m][1], u0 = acc[ai][1][m][0], u1 = acc[ai][1][m][1];
                u32x2 w; w.x = pk4_fp8(fsilu(g0[0]) * u0[0], fsilu(g0[1]) * u0[1], fsilu(g0[2]) * u0[2], fsilu(g0[3]) * u0[3]);
                w.y = pk4_fp8(fsilu(g1[0]) * u1[0], fsilu(g1[1]) * u1[1], fsilu(g1[2]) * u1[2], fsilu(g1[3]) * u1[3]);
                *(u32x2*)rowp = w; }
    }
};

struct EpiPoolW {
    static constexpr bool PERM = true, AFTER_DRAIN = false;
    bf16_t* O;
    __device__ __forceinline__ void operator()(const f32x4 (&acc)[2][2][4][2], const Unit& u, int wr, int wc, int fr, int fq) const {
        const int l = u.pm >> 5, g = (u.pm >> 3) & 3, np = u.pm & 7;
        const int row0 = np * BM + wr * 64 + fr, col0 = 2048 + 256 * g + wc * 32 + 8 * fq;
        bf16_t* base = O + (size_t)l * 2048 * 3072;
#pragma unroll
        for (int ai = 0; ai < 2; ++ai)
#pragma unroll
            for (int m = 0; m < 4; ++m) { bf16_t* rowp = base + (size_t)(row0 + ai * HALF + m * 16) * 3072 + col0;
#pragma unroll
                for (int bj = 0; bj < 2; ++bj) { const f32x4 v0 = acc[ai][bj][m][0], v1 = acc[ai][bj][m][1];
                    u32x4 w; w.x = cvt_pk_bf16(v0[0], v0[1]); w.y = cvt_pk_bf16(v0[2], v0[3]); w.z = cvt_pk_bf16(v1[0], v1[1]); w.w = cvt_pk_bf16(v1[2], v1[3]);
                    *(u32x4*)(rowp + bj * HALF) = w; } }
    }
};

template <class Epi, class Sched, bool ALIGN_EPI = false, bool SP2 = false, bool FP8 = false>
__device__ __forceinline__ void gemm_phase(PG8_LAS unsigned char* lds, const Gemm g, const Sched& S, const Epi& E) {
    int tid_ = threadIdx.x; asm volatile("" : "+v"(tid_));
    const int tid = tid_, wid = __builtin_amdgcn_readfirstlane(tid >> 6), lane = tid & 63, wr = wid >> 2, wc = wid & 3, fr = lane & 15, fq = lane >> 4;
    const int K = g.K, nt = K / BK;
    unsigned voffA[2], voffB[2];
#pragma unroll
    for (int i = 0; i < 2; ++i) { int R, C; stage_rc(tid * 16 + i * 8192, R, C); const int Rb = Epi::PERM ? ((R & ~31) + perm32(R & 31)) : R;
        voffA[i] = (unsigned)(R * g.lda + C) * 2u; voffB[i] = (unsigned)(Rb * g.ldb + C) * 2u; }
    const size_t kstep = (size_t)(BK * 2);
    const size_t hstepA = (size_t)HALF * g.lda * 2, hstepB = (size_t)HALF * g.ldb * 2;
    const size_t tstepA = 2 * hstepA, tstepB = 2 * hstepB;
    const unsigned ldsw = (unsigned)wid * 1024u;
    const int aoff = lds_byte(wr * 64 + fr, fq * 8), boff = lds_byte(wc * 32 + fr, fq * 8);
#define PG8_SA(b, h) (((b) * 2 + (h)) * HTB)
#define PG8_SB(b, h) ((4 + (b) * 2 + (h)) * HTB)
#define PG8_STAGE(bufoff, gbase, voff) do { _Pragma("unroll") for (int _i = 0; _i < 2; ++_i) \
        __builtin_amdgcn_global_load_lds((const unsigned*)((const char*)(gbase) + (voff)[_i]), (PG8_LAS unsigned*)(lds + (bufoff) + ldsw + _i * 8192), 16, 0, 0); } while (0)
#define PG8_LDA(dst, b, h) do { if constexpr (FP8) { _Pragma("unroll") for (int m = 0; m < 4; ++m) { dst##8[m].lo = *(const PG8_LAS i32x4*)(lds + PG8_SA(b, h) + aoff + m * 2048); dst##8[m].hi = *(const PG8_LAS i32x4*)(lds + PG8_SA(b, h) + aoff + m * 2048 + 1024); } } \
        else { _Pragma("unroll") for (int m = 0; m < 4; ++m) _Pragma("unroll") for (int k = 0; k < 2; ++k) dst[m][k] = *(const PG8_LAS bf16x8*)(lds + PG8_SA(b, h) + aoff + m * 2048 + k * 1024); } } while (0)
#define PG8_LDB(dst, b, h) do { if constexpr (FP8) { _Pragma("unroll") for (int n = 0; n < 2; ++n) { dst##8[n].lo = *(const PG8_LAS i32x4*)(lds + PG8_SB(b, h) + boff + n * 2048); dst##8[n].hi = *(const PG8_LAS i32x4*)(lds + PG8_SB(b, h) + boff + n * 2048 + 1024); } } \
        else { _Pragma("unroll") for (int n = 0; n < 2; ++n) _Pragma("unroll") for (int k = 0; k < 2; ++k) dst[n][k] = *(const PG8_LAS bf16x8*)(lds + PG8_SB(b, h) + boff + n * 2048 + k * 1024); } } while (0)
#define PG8_MMA(ai, bj, At, Bt) do { __builtin_amdgcn_s_setprio(1); \
        if constexpr (FP8) { _Pragma("unroll") for (int m = 0; m < 4; ++m) _Pragma("unroll") for (int n = 0; n < 2; ++n) \
            asm volatile("v_mfma_scale_f32_16x16x128_f8f6f4 %0, %1, %2, %0, %3, %4 op_sel_hi:[0,0,0]" : "+v"(acc[ai][bj][m][n]) : "v"(Bt##8[n]), "v"(At##8[m]), "v"(fp8_sw), "v"(fp8_sa)); } \
        else { _Pragma("unroll") for (int m = 0; m < 4; ++m) _Pragma("unroll") for (int n = 0; n < 2; ++n) _Pragma("unroll") for (int k = 0; k < 2; ++k) \
            acc[ai][bj][m][n] = __builtin_amdgcn_mfma_f32_16x16x32_bf16(Bt[n][k], At[m][k], acc[ai][bj][m][n], 0, 0, 0); } \
        __builtin_amdgcn_s_setprio(0); } while (0)
#define PG8_WAIT_V(n) asm volatile("s_waitcnt vmcnt(" #n ")" ::: "memory")
#define PG8_WAIT_L(n) asm volatile("s_waitcnt lgkmcnt(" #n ")" ::: "memory")
#define PG8_BAR __builtin_amdgcn_s_barrier()
#define PG8_SCHED __builtin_amdgcn_sched_barrier(0)
    Unit cur, nxt; int ui = 0;
    if (!S.next(0, cur)) return;
    f32x4 acc[2][2][4][2];
#pragma unroll
    for (int a = 0; a < 2; ++a)
#pragma unroll
        for (int b = 0; b < 2; ++b)
#pragma unroll
            for (int m = 0; m < 4; ++m)
#pragma unroll
                for (int n = 0; n < 2; ++n) acc[a][b][m][n] = (f32x4){0.f, 0.f, 0.f, 0.f};
    bf16x8 At[4][2], B0[2][2], B1[2][2]; i32x8 At8[4], B08[2], B18[2]; const int fp8_sw = FP8_WSCALE, fp8_sa = 127;
    const char* cA = (const char*)g.A + (size_t)cur.pm * tstepA; const char* cB = (const char*)g.Bt + (size_t)cur.be * g.bstride + (size_t)cur.pn * tstepB;
    S.a_ready(cur);
    if constexpr (SP2) {
        PG8_STAGE(PG8_SB(0, 0), cB, voffB); PG8_STAGE(PG8_SB(0, 1), cB + hstepB, voffB); PG8_STAGE(PG8_SA(0, 0), cA, voffA); PG8_STAGE(PG8_SA(0, 1), cA + hstepA, voffA);
        if (wr == 1) PG8_BAR;
        PG8_WAIT_V(2); PG8_BAR;
        PG8_STAGE(PG8_SB(1, 0), cB + kstep, voffB); PG8_STAGE(PG8_SA(1, 0), cA + kstep, voffA); PG8_STAGE(PG8_SB(1, 1), cB + hstepB + kstep, voffB);
        PG8_WAIT_V(6); PG8_BAR;
    } else {
        PG8_STAGE(PG8_SB(0, 0), cB, voffB); PG8_STAGE(PG8_SA(0, 0), cA, voffA); PG8_STAGE(PG8_SB(0, 1), cB + hstepB, voffB); PG8_STAGE(PG8_SA(0, 1), cA + hstepA, voffA);
        if (wr == 1) PG8_BAR;
        PG8_WAIT_V(4); PG8_BAR;
        PG8_STAGE(PG8_SB(1, 0), cB + kstep, voffB); PG8_STAGE(PG8_SA(1, 0), cA + kstep, voffA); PG8_STAGE(PG8_SB(1, 1), cB + hstepB + kstep, voffB);
        PG8_WAIT_V(6); PG8_BAR;
    }
    for (;;) {
        const bool has_next = S.next(ui + 1, nxt);
        const char* nA = has_next ? (const char*)g.A + (size_t)nxt.pm * tstepA : cA; const char* nB = has_next ? (const char*)g.Bt + (size_t)nxt.be * g.bstride + (size_t)nxt.pn * tstepB : cB;
        for (int t = 0; t < nt; t += 2) {
            const bool last = (t == nt - 2);
            const char* a1 = cA + (size_t)(t + 1) * kstep;
            const char* a2 = last ? nA : cA + (size_t)(t + 2) * kstep; const char* b2 = last ? nB : cB + (size_t)(t + 2) * kstep;
            const char* a3 = a2 + kstep; const char* b3 = b2 + kstep;
            if (last && has_next) S.a_ready(nxt);
            if constexpr (SP2) {
            PG8_LDB(B0, 0, 0); PG8_LDB(B1, 0, 1); PG8_SCHED; PG8_LDA(At, 0, 0); PG8_STAGE(PG8_SA(1, 1), a1 + hstepA, voffA);
            PG8_WAIT_V(8); PG8_WAIT_L(0); PG8_BAR; PG8_MMA(0, 0, At, B0); PG8_MMA(0, 1, At, B1); PG8_BAR; PG8_SCHED;
            PG8_LDA(At, 0, 1); PG8_STAGE(PG8_SB(0, 0), b2, voffB); PG8_STAGE(PG8_SB(0, 1), b2 + hstepB, voffB); PG8_STAGE(PG8_SA(0, 0), a2, voffA);
            PG8_WAIT_V(8); PG8_WAIT_L(0); PG8_BAR; PG8_MMA(1, 0, At, B0); PG8_MMA(1, 1, At, B1); PG8_BAR; PG8_SCHED;
            PG8_LDB(B0, 1, 0); PG8_LDB(B1, 1, 1); PG8_SCHED; PG8_LDA(At, 1, 0); PG8_STAGE(PG8_SA(0, 1), a2 + hstepA, voffA);
            PG8_WAIT_V(8); PG8_WAIT_L(0); PG8_BAR; PG8_MMA(0, 0, At, B0); PG8_MMA(0, 1, At, B1); PG8_BAR; PG8_SCHED;
            PG8_LDA(At, 1, 1); PG8_STAGE(PG8_SB(1, 0), b3, voffB); PG8_STAGE(PG8_SB(1, 1), b3 + hstepB, voffB); PG8_STAGE(PG8_SA(1, 0), a3, voffA);
            PG8_WAIT_V(8); PG8_WAIT_L(0); PG8_BAR; PG8_MMA(1, 0, At, B0); PG8_MMA(1, 1, At, B1); PG8_BAR; PG8_SCHED;
            } else {
            PG8_LDB(B0, 0, 0); PG8_SCHED; PG8_LDA(At, 0, 0); PG8_STAGE(PG8_SA(1, 1), a1 + hstepA, voffA);
            PG8_WAIT_L(8); PG8_BAR; PG8_WAIT_L(0); PG8_MMA(0, 0, At, B0); PG8_BAR; PG8_SCHED;
            PG8_LDB(B1, 0, 1); PG8_STAGE(PG8_SB(0, 0), b2, voffB);
            PG8_BAR; PG8_WAIT_L(0); PG8_MMA(0, 1, At, B1); PG8_BAR;
            PG8_LDA(At, 0, 1); PG8_STAGE(PG8_SA(0, 0), a2, voffA);
            PG8_BAR; PG8_WAIT_L(0); PG8_MMA(1, 0, At, B0); PG8_BAR; PG8_SCHED;
            PG8_STAGE(PG8_SB(0, 1), b2 + hstepB, voffB);
            PG8_WAIT_V(6); PG8_BAR; PG8_MMA(1, 1, At, B1); PG8_BAR;
            PG8_LDB(B0, 1, 0); PG8_SCHED; PG8_LDA(At, 1, 0); PG8_STAGE(PG8_SA(0, 1), a2 + hstepA, voffA);
            PG8_WAIT_L(8); PG8_BAR; PG8_WAIT_L(0); PG8_MMA(0, 0, At, B0); PG8_BAR; PG8_SCHED;
            PG8_LDB(B1, 1, 1); PG8_STAGE(PG8_SB(1, 0), b3, voffB);
            PG8_BAR; PG8_WAIT_L(0); PG8_MMA(0, 1, At, B1); PG8_BAR;
            PG8_LDA(At, 1, 1); PG8_STAGE(PG8_SA(1, 0), a3, voffA);
            PG8_BAR; PG8_WAIT_L(0); PG8_MMA(1, 0, At, B0); PG8_BAR; PG8_SCHED;
            PG8_STAGE(PG8_SB(1, 1), b3 + hstepB, voffB);
            PG8_WAIT_V(6); PG8_BAR; PG8_MMA(1, 1, At, B1); PG8_BAR;
            }
        }
        if constexpr (FP8) asm volatile("s_nop 15\n\ts_nop 15" ::: "memory");
        if constexpr (ALIGN_EPI) { if (wr == 0) PG8_BAR; }
        if constexpr (!Epi::AFTER_DRAIN) { E(acc, cur, wr, wc, fr, fq); S.done(cur); }
        if (!has_next) break;
#pragma unroll
        for (int a = 0; a < 2; ++a)
#pragma unroll
            for (int b = 0; b < 2; ++b)
#pragma unroll
                for (int m = 0; m < 4; ++m)
#pragma unroll
                    for (int n = 0; n < 2; ++n) acc[a][b][m][n] = (f32x4){0.f, 0.f, 0.f, 0.f};
        cur = nxt; cA = nA; cB = nB; ++ui;
        if constexpr (ALIGN_EPI) { if (wr == 1) PG8_BAR; }
    }
    PG8_WAIT_V(0);
    if constexpr (!ALIGN_EPI) { if (wr == 0) PG8_BAR; }
    PG8_BAR;
    if constexpr (Epi::AFTER_DRAIN) { E.fused(acc, cur, wr, wc, fr, fq, lds, wid, lane); S.done(cur); }
#undef PG8_SA
#undef PG8_SB
#undef PG8_STAGE
#undef PG8_LDA
#undef PG8_LDB
#undef PG8_MMA
#undef PG8_WAIT_V
#undef PG8_WAIT_L
#undef PG8_BAR
#undef PG8_SCHED
}
}

#ifndef DENSE_FP8
#define DENSE_FP8 0
#endif
constexpr int NWAVES = 8;
constexpr int BATCH = 2, SEQ = 8192, M = BATCH * SEQ, D = 2048, NH = 4, HK = 256, HV = 512, PW = 1024, DFF = 5632, NE = 8, DIN = 11280;
constexpr int ZN = 12288;
constexpr int ZP = 11264;
constexpr int ZC_Q = 0, ZC_K = 1024, ZC_V = 2048, ZC_R = 4096, ZC_P = 6144, ZC_GA = 7168, ZC_GB = 9216;
constexpr int KCAT = 3072;
constexpr int FFN = 2 * DFF;
constexpr int MAXSLOT = 2 * M + NE * 256;
constexpr float EPS = 1e-6f;
static_assert(pg8::ZP_ == ZP, "pitch");

constexpr size_t MiB = 1u << 20;
constexpr size_t WS_CTL = 0, CTL_ZERO_BYTES = 65536;
constexpr size_t WS_TOKSLOT = 1 * MiB, WS_WSLOT = 1 * MiB + 256 * 1024, WS_TOKE = 2 * MiB, WS_TOKW = 2 * MiB + 256 * 1024;
constexpr size_t WS_WIN = 4 * MiB, WS_BCAT = 100 * MiB, WS_WOUT = 124 * MiB, WS_FF1 = 140 * MiB, WS_FF2 = 184 * MiB, WS_EF1 = 206 * MiB, WS_EF2 = 558 * MiB;
constexpr size_t WS_HB = 734 * MiB, WS_ZB = 798 * MiB, WS_LA = 1172 * MiB, WS_OF = 1236 * MiB, WS_ACAT = 1364 * MiB, WS_U = 1460 * MiB, WS_END = 1524 * MiB;
constexpr size_t WS_HMID = WS_ZB, WS_HPERM = WS_ACAT;
static_assert(WS_WIN + 2 * (size_t)ZN * D * 2 <= WS_BCAT && WS_BCAT + 2 * (size_t)D * KCAT * 2 <= WS_WOUT && WS_WOUT + 2 * (size_t)D * D * 2 <= WS_FF1, "ws map 1");
static_assert(WS_FF1 + (size_t)FFN * D * 2 <= WS_FF2 && WS_FF2 + (size_t)D * DFF * 2 <= WS_EF1 && WS_EF1 + 8 * (size_t)FFN * D * 2 <= WS_EF2 && WS_EF2 + 8 * (size_t)D * DFF * 2 <= WS_HB, "ws map 2");
static_assert(WS_HB + (size_t)M * D * 2 <= WS_ZB && WS_ZB + (size_t)M * ZP * 2 <= WS_LA && WS_HMID + (size_t)MAXSLOT * DFF * 2 <= WS_LA && WS_LA + (size_t)M * 1024 * 4 <= WS_OF, "ws map 3");
static_assert(WS_OF + (size_t)M * D * 4 <= WS_ACAT && WS_ACAT + (size_t)M * KCAT * 2 <= WS_U && WS_U + (size_t)M * D * 2 <= WS_END && WS_HPERM + (size_t)MAXSLOT * D * 2 <= WS_END, "ws map 4");
static_assert((size_t)MAXSLOT * 4 <= 256 * 1024 && (size_t)M * 2 * 4 <= 256 * 1024, "ctl tables");
constexpr int CW_TMO = 0, CW_CODE = 1, CW_BAR = 4096, CW_CNT = 8192, CW_FILL = 8256;

constexpr int RING_OFF = 0, RING_BYTES = 131072;
constexpr int LDSCTL_OFF = RING_BYTES, MISC_OFF = LDSCTL_OFF + 320;
constexpr int LDS_BYTES = 147456;

#define GAS __attribute__((address_space(1)))
#define LAS __attribute__((address_space(3)))
typedef unsigned short bf16;
typedef unsigned v4u __attribute__((ext_vector_type(4)));
typedef unsigned v2u __attribute__((ext_vector_type(2)));
typedef float f32x4 __attribute__((ext_vector_type(4)));
typedef GAS unsigned gu32;
#define RLX_AGENT __ATOMIC_RELAXED, __HIP_MEMORY_SCOPE_AGENT
#define LDS_WAIT() asm volatile("s_waitcnt lgkmcnt(0)" ::: "memory")
#define VM_WAIT() asm volatile("s_waitcnt vmcnt(0)" ::: "memory")
__device__ __forceinline__ unsigned f2bf(float f) { unsigned u = __builtin_bit_cast(unsigned, f); return (u + 0x7fffu + ((u >> 16) & 1u)) >> 16; }
__device__ __forceinline__ unsigned pk2(float lo, float hi) { return f2bf(lo) | (f2bf(hi) << 16); }
__device__ __forceinline__ float bfl(unsigned w) { return __uint_as_float(w << 16); }
__device__ __forceinline__ float bfh(unsigned w) { return __uint_as_float(w & 0xffff0000u); }
__device__ __forceinline__ float wave_sum(float v) {
#pragma unroll
    for (int o = 1; o < 64; o <<= 1) v += __shfl_xor(v, o);
    return v;
}
typedef __bf16 gl_bf2 __attribute__((ext_vector_type(2)));
typedef float gl_f2 __attribute__((ext_vector_type(2)));
__device__ __forceinline__ unsigned pkbf(float lo, float hi) { gl_f2 v = {lo, hi}; return __builtin_bit_cast(unsigned, __builtin_convertvector(v, gl_bf2)); }
__device__ __forceinline__ int opq(int x) { asm volatile("" : "+v"(x)); return x; }
#define XB_TMO      128
#define XB_XCNT(j)  (256  + 64 * (j))
#define XB_XSUB(j)  (1280 + 64 * (j))
#define XB_XGEN(j)  (2304 + 64 * (j))
#define XB_TOP      3328
#define XB_TOPGEN   3392
#define XCD_BAR_WORDS 3456
#define XB_SPIN_CAP (1u << 18)

__device__ __forceinline__ unsigned xb_ld(unsigned* p)              { return __hip_atomic_load(p, __ATOMIC_RELAXED, __HIP_MEMORY_SCOPE_AGENT); }
__device__ __forceinline__ unsigned xb_add(unsigned* p, unsigned v) { return __hip_atomic_fetch_add(p, v, __ATOMIC_RELAXED, __HIP_MEMORY_SCOPE_AGENT); }
__device__ __forceinline__ unsigned xb_xcc_id() { return (unsigned)__builtin_amdgcn_s_getreg((3 << 11) | 20) & 0xFu; }
#define XB_SPIN(cond, bar) do { unsigned _sp = 0; while (cond) { __builtin_amdgcn_s_sleep(1); \
    if ((++_sp & 255u) == 0u) { if (xb_ld(&(bar)[XB_TMO])) break; if (_sp > XB_SPIN_CAP) { atomicAdd(&(bar)[XB_TMO], 1u); break; } } } } while (0)

struct XcdBarrier {
    unsigned* bar; unsigned x;
    volatile LAS unsigned* st;
};

__device__ __forceinline__ XcdBarrier xcd_barrier_post(unsigned* bar, volatile LAS unsigned* st) {
    XcdBarrier b; b.bar = bar; b.x = xb_xcc_id(); b.st = st;
    if (threadIdx.x == 0) (void)xb_add(&bar[XB_XCNT(b.x)], 1u);
    return b;
}
__device__ __forceinline__ void xcd_barrier_complete(unsigned* bar, unsigned x, unsigned& nloc, unsigned& nx) {
    const unsigned G = gridDim.x * gridDim.y * gridDim.z;
    unsigned sum, cnt, mine, sp = 0u;
    for (;;) {
        sum = 0u; cnt = 0u; mine = 0u;
#pragma unroll
        for (unsigned j = 0; j < 16; ++j) { const unsigned c = xb_ld(&bar[XB_XCNT(j)]); sum += c; cnt += (c > 0u) ? 1u : 0u; mine = (j == x) ? c : mine; }
        if (sum == G) break;
        __builtin_amdgcn_s_sleep(1);
        if ((++sp & 255u) == 0u) { if (xb_ld(&bar[XB_TMO])) break; if (sp > XB_SPIN_CAP) { atomicAdd(&bar[XB_TMO], 1u); break; } }
    }
    nloc = mine > 0u ? mine : 1u; nx = cnt > 0u ? cnt : 1u;
}

__device__ __forceinline__ void xcd_barrier(const XcdBarrier& b) {
    asm volatile("s_waitcnt vmcnt(0)" ::: "memory");
    __syncthreads();
    if (threadIdx.x == 0) {
        unsigned* bar = b.bar;
        __builtin_amdgcn_s_waitcnt(0);
        unsigned nloc = b.st[0], nx = b.st[1];
        if (nloc == 0u) { xcd_barrier_complete(bar, b.x, nloc, nx); b.st[0] = nloc; b.st[1] = nx; }
        const unsigned old = xb_add(&bar[XB_XSUB(b.x)], 1u);
        const unsigned gen = old / nloc;
        if (old + 1u == (gen + 1u) * nloc) {
            __builtin_amdgcn_fence(__ATOMIC_RELEASE, "agent");
            asm volatile("s_waitcnt vmcnt(0)" ::: "memory");
            const unsigned og = xb_add(&bar[XB_TOP], 1u);
            const unsigned tg = og / nx;
            if (og + 1u == (tg + 1u) * nx) xb_add(&bar[XB_TOPGEN], 1u);
            else XB_SPIN(xb_ld(&bar[XB_TOPGEN]) == tg, bar);
            __builtin_amdgcn_fence(__ATOMIC_ACQUIRE, "agent");
            xb_add(&bar[XB_XGEN(b.x)], 1u);
            asm volatile("s_waitcnt vmcnt(0)" ::: "memory");
        } else {
            XB_SPIN(xb_ld(&bar[XB_XGEN(b.x)]) == gen, bar);
            __builtin_amdgcn_fence(__ATOMIC_ACQUIRE, "agent");
            asm volatile("s_waitcnt vmcnt(0)" ::: "memory");
        }
    }
    __syncthreads();
}

struct TrJob { const float* src; unsigned char* dst; int ldw, ldt, k0, n0, mode, row_off, kind; };
__device__ __forceinline__ int tr_drow(int nn, int mode, int row_off) { return mode ? (256 * (nn >> 7) + (nn & 127) + row_off) : (row_off + nn); }
__device__ __forceinline__ void tr_load(const TrJob& J, f32x4 (&R)[16], int lane) {
    if (J.kind == 0) { const int nq = lane & 15, kr = lane >> 4; const float* b = J.src + (size_t)(4 * kr) * J.ldw + 4 * nq;
#pragma unroll
        for (int jq = 0; jq < 4; ++jq)
#pragma unroll
            for (int x = 0; x < 4; ++x) R[4 * jq + x] = __builtin_nontemporal_load((const GAS f32x4*)(b + (size_t)(16 * jq + x) * J.ldw));
    } else { const int nq = lane & 7, kr = lane >> 3; const float* b = J.src + (size_t)(4 * kr) * J.ldw + 4 * nq;
#pragma unroll
        for (int jq = 0; jq < 4; ++jq)
#pragma unroll
            for (int x = 0; x < 4; ++x) R[4 * jq + x] = __builtin_nontemporal_load((const GAS f32x4*)(b + (size_t)(32 * jq + x) * J.ldw)); }
}
__device__ __forceinline__ void tr_finish(const TrJob& J, const f32x4 (&R)[16], LAS unsigned* T, int lane, int nostore) {
    if (J.kind == 0) { const int nq = lane & 15, kr = lane >> 4;
#pragma unroll
        for (int jq = 0; jq < 4; ++jq)
#pragma unroll
            for (int i = 0; i < 4; ++i) { T[(4 * nq + i) * 33 + 8 * jq + 2 * kr] = pkbf(R[4 * jq][i], R[4 * jq + 1][i]); T[(4 * nq + i) * 33 + 8 * jq + 2 * kr + 1] = pkbf(R[4 * jq + 2][i], R[4 * jq + 3][i]); }
        LDS_WAIT(); asm volatile("" ::: "memory");
#pragma unroll
        for (int r = 0; r < 8; ++r) { const int t = lane + 64 * r, n = t >> 3, c = t & 7; const LAS unsigned* s = T + n * 33 + 4 * c;
            v4u o; o.x = s[0]; o.y = s[1]; o.z = s[2]; o.w = s[3];
            if (!nostore || o.x == 0x12345678u) *(GAS v4u*)(J.dst + (size_t)tr_drow(J.n0 + n, J.mode, J.row_off) * J.ldt + 2 * J.k0 + 16 * c) = o; }
    } else { const int nq = lane & 7, kr = lane >> 3;
#pragma unroll
        for (int jq = 0; jq < 4; ++jq)
#pragma unroll
            for (int i = 0; i < 4; ++i) T[(4 * nq + i) * 33 + 8 * jq + kr] = pg8::pk4_fp8(R[4 * jq][i] * 64.0f, R[4 * jq + 1][i] * 64.0f, R[4 * jq + 2][i] * 64.0f, R[4 * jq + 3][i] * 64.0f);
        LDS_WAIT(); asm volatile("" ::: "memory");
#pragma unroll
        for (int r = 0; r < 4; ++r) { const int t = lane + 64 * r, n = t >> 3, c = t & 7; const LAS unsigned* s = T + n * 33 + 4 * c;
            v4u o; o.x = s[0]; o.y = s[1]; o.z = s[2]; o.w = s[3];
            if (!nostore || o.x == 0x12345678u) *(GAS v4u*)(J.dst + (size_t)tr_drow(J.n0 + n, J.mode, J.row_off) * J.ldt + J.k0 + 16 * c) = o; } }
    LDS_WAIT(); asm volatile("" ::: "memory");
}

template <bool ROUTE, bool OUT8 = false>
__device__ __forceinline__ void norm_rows(const float* X, const float* gain, bf16* out, int gw, int NGW, int lane0,
                                          const LAS float* rw, int* tok_e, float* tok_w, LAS unsigned* hist) {
    const int lane = opq(lane0);
    f32x4 nx[8], gv[8];
#pragma unroll
    for (int j = 0; j < 8; ++j) gv[j] = ((const GAS f32x4*)gain)[lane + 64 * j];
    if (gw < M) { const GAS f32x4* xr = (const GAS f32x4*)(X + (size_t)gw * D) + lane;
#pragma unroll
        for (int j = 0; j < 8; ++j) nx[j] = xr[64 * j]; }
    for (int m = gw; m < M; m += NGW) {
        f32x4 v[8]; float s = 0.f;
#pragma unroll
        for (int j = 0; j < 8; ++j) { v[j] = nx[j]; s += (v[j].x * v[j].x + v[j].y * v[j].y) + (v[j].z * v[j].z + v[j].w * v[j].w); }
        if (m + NGW < M) { const GAS f32x4* xr = (const GAS f32x4*)(X + (size_t)(m + NGW) * D) + lane;
#pragma unroll
            for (int j = 0; j < 8; ++j) nx[j] = xr[64 * j]; }
        const float rstd = 1.0f / sqrtf(wave_sum(s) * (1.0f / D) + EPS);
        GAS unsigned long long* o8 = (GAS unsigned long long*)(out + (size_t)m * D) + lane;
#pragma unroll
        for (int j = 0; j < 8; ++j) { const f32x4 g4 = gv[j]; v[j] = v[j] * rstd * g4;
            if (OUT8) ((GAS unsigned*)((unsigned char*)out + (size_t)m * D))[lane + 64 * j] = pg8::pk4_fp8(v[j].x, v[j].y, v[j].z, v[j].w);
            else o8[64 * j] = (unsigned long long)pk2(v[j].x, v[j].y) | ((unsigned long long)pk2(v[j].z, v[j].w) << 32); }
        if (ROUTE) {
            float lg[8];
#pragma unroll
            for (int e = 0; e < 8; ++e) lg[e] = 0.f;
#pragma unroll
            for (int j = 0; j < 8; ++j) {
                f32x4 r0[4], r1[4];
#pragma unroll
                for (int i = 0; i < 4; ++i) { const int k = 4 * (lane + 64 * j) + i; r0[i] = *(const LAS f32x4*)(rw + k * 8); r1[i] = *(const LAS f32x4*)(rw + k * 8 + 4); }
                __builtin_amdgcn_sched_barrier(0);
#pragma unroll
                for (int i = 0; i < 4; ++i) { const float hv = v[j][i];
                    lg[0] += hv * r0[i].x; lg[1] += hv * r0[i].y; lg[2] += hv * r0[i].z; lg[3] += hv * r0[i].w; lg[4] += hv * r1[i].x; lg[5] += hv * r1[i].y; lg[6] += hv * r1[i].z; lg[7] += hv * r1[i].w; }
                __builtin_amdgcn_sched_barrier(0);
            }
#pragma unroll
            for (int e = 0; e < 8; ++e) lg[e] = wave_sum(lg[e]);
            float v1 = lg[0]; int i1 = 0;
#pragma unroll
            for (int e = 1; e < 8; ++e) if (lg[e] > v1) { v1 = lg[e]; i1 = e; }
            float v2 = -3.0e38f; int i2 = 0;
#pragma unroll
            for (int e = 0; e < 8; ++e) if (e != i1 && lg[e] > v2) { v2 = lg[e]; i2 = e; }
            const float ex = __expf(v2 - v1), w1 = 1.0f / (1.0f + ex), w2 = ex * w1;
            if (lane == 0) { tok_e[2 * m] = i1; tok_e[2 * m + 1] = i2; tok_w[2 * m] = w1; tok_w[2 * m + 1] = w2;
                __hip_atomic_fetch_add(hist + i1, 1u, __ATOMIC_RELAXED, __HIP_MEMORY_SCOPE_WORKGROUP); __hip_atomic_fetch_add(hist + i2, 1u, __ATOMIC_RELAXED, __HIP_MEMORY_SCOPE_WORKGROUP); }
        }
    }
}


typedef short gl_bf16x8 __attribute__((ext_vector_type(8)));
typedef short gl_s16x4 __attribute__((ext_vector_type(4)));
__device__ __forceinline__ unsigned off_q(unsigned row, unsigned ch) { return 512u * row + 16u * (ch ^ (row & 15u)); }
__device__ __forceinline__ unsigned off_a(unsigned row, unsigned ch) { return 128u * row + 16u * (ch ^ (row & 7u)); }
__device__ __forceinline__ unsigned off_b(unsigned row, unsigned ch) { return 256u * row + 16u * (ch ^ (((row & 3u) << 2) | ((row >> 2) & 3u))); }
__device__ __forceinline__ gl_bf16x8 tr_frag(unsigned base, unsigned lane, unsigned c) {
    const unsigned g = lane >> 4, q = (lane & 15u) >> 2, p = lane & 3u;
    const unsigned a0 = base + off_b(8u * g + q, 2u * c + (p >> 1)) + 8u * (p & 1u), a1 = base + off_b(8u * g + 4u + q, 2u * c + (p >> 1)) + 8u * (p & 1u);
    const gl_s16x4 lo = __builtin_amdgcn_ds_read_tr16_b64_v4i16((LAS gl_s16x4*)a0), hi = __builtin_amdgcn_ds_read_tr16_b64_v4i16((LAS gl_s16x4*)a1);
    return __builtin_shufflevector(lo, hi, 0, 1, 2, 3, 4, 5, 6, 7);
}
#define GLA_MFMA(a, b, c) __builtin_amdgcn_mfma_f32_16x16x32_bf16((a), (b), (c), 0, 0, 0)
constexpr int GLA_NSEG = 8, GLA_CPS = 16;
constexpr int GL_QT = 0, GL_KE = 32768, GL_V = 65536, GL_ATT = 81920, GL_DEC = 90112;

__device__ __forceinline__ void gla_g0(LAS unsigned char* lds, bf16* Zb, const bf16* Hb, const bf16* WA1T, const float* w_alpha, const float* b_alpha, bf16* ATT, float* DEC, int bx, int G, int tid0, int lane0, int wave) {
    const int tid = opq(tid0), lane = tid & 63; (void)lane0;
    LAS float* sB = (LAS float*)lds; LAS unsigned char* sQ = lds + 65536; LAS unsigned char* sK = lds + 98304;
    LAS float* sP = (LAS float*)(lds + 65536);
    LAS float* sA1 = (LAS float*)(lds + 131072 + 1024);
    const unsigned li = lane & 15, g = lane >> 4;
    for (int uc = bx; uc < 256; uc += G) {
        const int b = uc >> 7, c = uc & 127; const size_t row0 = (size_t)b * SEQ + (size_t)c * 64;
        __syncthreads();
        { f32x4 pa[4];
#pragma unroll
            for (int mt = 0; mt < 4; ++mt) pa[mt] = (f32x4){0.f, 0.f, 0.f, 0.f};
#pragma unroll
            for (int s2 = 0; s2 < 4; ++s2) { gl_bf16x8 bf[2], af[2][4];
#pragma unroll
                for (int ss = 0; ss < 2; ++ss) { const int s = 8 * wave + 2 * s2 + ss; bf[ss] = *(const GAS gl_bf16x8*)(WA1T + (size_t)li * D + 32 * s + 8 * g);
#pragma unroll
                    for (int mt = 0; mt < 4; ++mt) af[ss][mt] = *(const GAS gl_bf16x8*)(Hb + (row0 + 16 * mt + li) * D + 32 * s + 8 * g); }
#pragma unroll
                for (int ss = 0; ss < 2; ++ss)
#pragma unroll
                    for (int mt = 0; mt < 4; ++mt) pa[mt] = GLA_MFMA(af[ss][mt], bf[ss], pa[mt]); }
#pragma unroll
            for (int mt = 0; mt < 4; ++mt)
#pragma unroll
                for (int j = 0; j < 4; ++j) sP[(wave * 64 + 16 * mt + 4 * g + j) * 16 + li] = pa[mt][j]; }
        __syncthreads();
#pragma unroll
        for (int e2 = 0; e2 < 2; ++e2) { const int e = tid + 512 * e2; float s = 0.f;
#pragma unroll
            for (int w = 0; w < 8; ++w) s += sP[w * 1024 + e];
            sA1[e] = s; }
        for (int h = 0; h < 4; ++h) {
        const int u = (b << 9) | (c << 2) | h;
        __syncthreads();
        v4u q8r[4], k8r[4];
#pragma unroll
        for (int i = 0; i < 4; ++i) { const int n = tid + 512 * i, r = n >> 5, ch = n & 31;
            q8r[i] = *(const GAS v4u*)(Zb + (row0 + r) * ZP + ZC_Q + h * 256 + 8 * ch); k8r[i] = *(const GAS v4u*)(Zb + (row0 + r) * ZP + ZC_K + h * 256 + 8 * ch); }
        {
            const int d = tid & 255, hf = tid >> 8; float wa[16];
#pragma unroll
            for (int r = 0; r < 16; ++r) wa[r] = w_alpha[r * 1024 + h * 256 + d];
            const float ba = b_alpha[h * 256 + d];
            float vv[32];
#pragma unroll
            for (int t4 = 0; t4 < 32; t4 += 4) {
                f32x4 av[4][4];
#pragma unroll
                for (int tt = 0; tt < 4; ++tt) { const LAS f32x4* ap = (const LAS f32x4*)(sA1 + (32 * hf + t4 + tt) * 16); av[tt][0] = ap[0]; av[tt][1] = ap[1]; av[tt][2] = ap[2]; av[tt][3] = ap[3]; }
                __builtin_amdgcn_sched_barrier(0);
#pragma unroll
                for (int tt = 0; tt < 4; ++tt) { const f32x4 a0 = av[tt][0], a1 = av[tt][1], a2 = av[tt][2], a3 = av[tt][3];
                    float s = ba + (a0.x * wa[0] + a0.y * wa[1]) + (a0.z * wa[2] + a0.w * wa[3]) + (a1.x * wa[4] + a1.y * wa[5]) + (a1.z * wa[6] + a1.w * wa[7])
                                 + (a2.x * wa[8] + a2.y * wa[9]) + (a2.z * wa[10] + a2.w * wa[11]) + (a3.x * wa[12] + a3.y * wa[13]) + (a3.z * wa[14] + a3.w * wa[15]);
                    vv[t4 + tt] = pg8::flogsig(s) * 0.0625f; }
                __builtin_amdgcn_sched_barrier(0);
            }
#pragma unroll
            for (int t = 1; t < 32; ++t) vv[t] += vv[t - 1];
            LAS float* tot = (LAS float*)(lds + 65536);
            if (hf == 0) tot[d] = vv[31];
            __syncthreads();
            const float add = hf ? tot[d] : 0.f;
#pragma unroll
            for (int t = 0; t < 32; ++t) sB[(32 * hf + t) * 256 + d] = vv[t] + add;
        }
        __syncthreads();
#pragma unroll
        for (int i = 0; i < 4; ++i) { const int n = tid + 512 * i, r = n >> 5, ch = n & 31;
            bf16* qp = Zb + (row0 + r) * ZP + ZC_Q + h * 256; bf16* kp = Zb + (row0 + r) * ZP + ZC_K + h * 256;
            const v4u q8 = q8r[i], k8 = k8r[i];
            const f32x4 b0 = *(const LAS f32x4*)(sB + r * 256 + 8 * ch), b1 = *(const LAS f32x4*)(sB + r * 256 + 8 * ch + 4);
            const f32x4 l0 = *(const LAS f32x4*)(sB + 63 * 256 + 8 * ch), l1 = *(const LAS f32x4*)(sB + 63 * 256 + 8 * ch + 4);
            const float qv[8] = {bfl(q8.x), bfh(q8.x), bfl(q8.y), bfh(q8.y), bfl(q8.z), bfh(q8.z), bfl(q8.w), bfh(q8.w)};
            const float kv[8] = {bfl(k8.x), bfh(k8.x), bfl(k8.y), bfh(k8.y), bfl(k8.z), bfh(k8.z), bfl(k8.w), bfh(k8.w)};
            const float bb[8] = {b0.x, b0.y, b0.z, b0.w, b1.x, b1.y, b1.z, b1.w}; const float bl[8] = {l0.x, l0.y, l0.z, l0.w, l1.x, l1.y, l1.z, l1.w};
            float qt[8], kt[8], ke[8];
#pragma unroll
            for (int e = 0; e < 8; ++e) { qt[e] = qv[e] * __expf(bb[e]) * 0.0625f; kt[e] = kv[e] * __expf(-bb[e]); ke[e] = kv[e] * __expf(bl[e] - bb[e]); }
            v4u qw, kw, ew; qw.x = pkbf(qt[0], qt[1]); qw.y = pkbf(qt[2], qt[3]); qw.z = pkbf(qt[4], qt[5]); qw.w = pkbf(qt[6], qt[7]);
            kw.x = pkbf(kt[0], kt[1]); kw.y = pkbf(kt[2], kt[3]); kw.z = pkbf(kt[4], kt[5]); kw.w = pkbf(kt[6], kt[7]);
            ew.x = pkbf(ke[0], ke[1]); ew.y = pkbf(ke[2], ke[3]); ew.z = pkbf(ke[4], ke[5]); ew.w = pkbf(ke[6], ke[7]);
            *(LAS v4u*)(sQ + off_q(r, ch)) = qw; *(LAS v4u*)(sK + off_q(r, ch)) = kw;
            *(GAS v4u*)(kp + 8 * ch) = ew;
            const int p0 = 32 * (ch >> 2) + 16 * (ch & 1) + 4 * ((ch >> 1) & 1);
            v2u w0, w1; w0.x = qw.x; w0.y = qw.y; w1.x = qw.z; w1.y = qw.w;
            *(GAS v2u*)(qp + p0) = w0; *(GAS v2u*)(qp + p0 + 8) = w1; }
        if (tid < 256) DEC[((size_t)b * 128 + c) * 1024 + h * 256 + tid] = __expf(sB[63 * 256 + tid]);
        __syncthreads();
#pragma unroll
        for (int tt = 0; tt < 2; ++tt) { const int T = 2 * wave + tt, jt = T >> 2, it = T & 3;
            f32x4 acc = {0.f, 0.f, 0.f, 0.f};
            if (jt <= it) {
#pragma unroll
                for (int s = 0; s < 8; ++s) { const gl_bf16x8 a = *(const LAS gl_bf16x8*)(sK + off_q(16 * jt + li, 4 * s + g)), bq = *(const LAS gl_bf16x8*)(sQ + off_q(16 * it + li, 4 * s + g));
                    acc = GLA_MFMA(a, bq, acc); } }
            const int i = 16 * it + (int)li, j0 = 16 * jt + 4 * (int)g;
            v2u w; w.x = pkbf(j0 + 0 <= i ? acc[0] : 0.f, j0 + 1 <= i ? acc[1] : 0.f); w.y = pkbf(j0 + 2 <= i ? acc[2] : 0.f, j0 + 3 <= i ? acc[3] : 0.f);
            *(GAS v2u*)(ATT + (size_t)u * 4096 + i * 64 + j0) = w; }
        }
    }
}

struct GlaRegs { v4u k[4], q[4], v[2], a; f32x4 d; };
template <bool WITH_Q>
__device__ __forceinline__ void gla_issue(GlaRegs& R, const bf16* Zb, const bf16* ATT, const float* DEC, int b, int c, int h, int sl, int tid) {
    const size_t row0 = (size_t)b * SEQ + (size_t)c * 64;
#pragma unroll
    for (int i = 0; i < 4; ++i) { const int n = tid + 512 * i, r = n >> 5, ch = n & 31;
        R.k[i] = *(const GAS v4u*)(Zb + (row0 + r) * ZP + ZC_K + h * 256 + 8 * ch);
        if (WITH_Q) R.q[i] = *(const GAS v4u*)(Zb + (row0 + r) * ZP + ZC_Q + h * 256 + 8 * ch); }
#pragma unroll
    for (int i = 0; i < 2; ++i) { const int n = tid + 512 * i, r = n >> 4, ch = n & 15; R.v[i] = *(const GAS v4u*)(Zb + (row0 + r) * ZP + ZC_V + h * 512 + sl * 128 + 8 * ch); }
    if (WITH_Q) { const int r = tid >> 3, ch = tid & 7; const unsigned u = ((unsigned)b << 9) | ((unsigned)c << 2) | (unsigned)h; R.a = *(const GAS v4u*)(ATT + (size_t)u * 4096 + r * 64 + 8 * ch); }
    if (tid < 64) R.d = *(const GAS f32x4*)(DEC + ((size_t)b * 128 + c) * 1024 + h * 256 + 4 * tid);
}
template <bool WITH_Q>
__device__ __forceinline__ void gla_commit(const GlaRegs& R, LAS unsigned char* lds, int tid) {
#pragma unroll
    for (int i = 0; i < 4; ++i) { const int n = tid + 512 * i, r = n >> 5, ch = n & 31;
        *(LAS v4u*)(lds + GL_KE + ((r >> 5) * 2 + (ch >> 4)) * 8192 + off_b(r & 31, ch & 15)) = R.k[i];
        if (WITH_Q) *(LAS v4u*)(lds + GL_QT + off_q(r, ch)) = R.q[i]; }
#pragma unroll
    for (int i = 0; i < 2; ++i) { const int n = tid + 512 * i, r = n >> 4, ch = n & 15; *(LAS v4u*)(lds + GL_V + (r >> 5) * 8192 + off_b(r & 31, ch)) = R.v[i]; }
    if (WITH_Q) { const int r = tid >> 3, ch = tid & 7; *(LAS v4u*)(lds + GL_ATT + off_a(r, ch)) = R.a; }
    if (tid < 64) ((LAS f32x4*)(lds + GL_DEC))[tid] = R.d;
}
__device__ __forceinline__ void gla_update(LAS unsigned char* lds, f32x4 (&S)[16], const gl_bf16x8 (&vf)[2], unsigned lane, unsigned g) {
    const unsigned lbase = (unsigned)(size_t)lds;
#pragma unroll
    for (int i2 = 0; i2 < 8; ++i2) {
        f32x4 d4[2]; gl_bf16x8 kf[2][2];
#pragma unroll
        for (int ii = 0; ii < 2; ++ii) { const int i = 2 * i2 + ii; d4[ii] = *(const LAS f32x4*)(lds + GL_DEC + 4 * (16 * i + 4 * g));
            kf[ii][0] = tr_frag(lbase + GL_KE + (0 * 2 + (i >> 3)) * 8192, lane, i & 7); kf[ii][1] = tr_frag(lbase + GL_KE + (1 * 2 + (i >> 3)) * 8192, lane, i & 7); }
        __builtin_amdgcn_sched_barrier(0);
#pragma unroll
        for (int ii = 0; ii < 2; ++ii) { const int i = 2 * i2 + ii; S[i] = S[i] * d4[ii]; S[i] = GLA_MFMA(kf[ii][0], vf[0], S[i]); S[i] = GLA_MFMA(kf[ii][1], vf[1], S[i]); }
        __builtin_amdgcn_sched_barrier(0);
    }
}

__device__ __forceinline__ void gla_g1(LAS unsigned char* lds, const bf16* Zb, const float* DEC, float* SL, float* DSEG, int bx, int G, int tid0, int lane0, int wave) {
    const int tid = opq(tid0), lane = tid & 63; (void)lane0;
    const unsigned li = lane & 15, g = lane >> 4; const unsigned lbase = (unsigned)(size_t)lds;
    for (int un = bx; un < 256; un += G) {
        const int seg = un & 7, bh = un >> 5, sl = (un >> 3) & 3, b = bh >> 2, h = bh & 3;
        if (seg == 7) continue;
        f32x4 S[16];
#pragma unroll
        for (int i = 0; i < 16; ++i) S[i] = (f32x4){0.f, 0.f, 0.f, 0.f};
        float dprod = 1.0f;
        GlaRegs R; gla_issue<false>(R, Zb, nullptr, DEC, b, seg * GLA_CPS, h, sl, tid);
        for (int cc = 0; cc < GLA_CPS; ++cc) {
            __syncthreads();
            gla_commit<false>(R, lds, tid);
            __syncthreads();
            if (cc + 1 < GLA_CPS) gla_issue<false>(R, Zb, nullptr, DEC, b, seg * GLA_CPS + cc + 1, h, sl, tid);
            if (tid < 256) dprod *= ((LAS float*)(lds + GL_DEC))[tid];
            unsigned lv = (unsigned)lane; asm volatile("" : "+v"(lv));
            gl_bf16x8 vf[2]; vf[0] = tr_frag(lbase + GL_V, lv, wave); vf[1] = tr_frag(lbase + GL_V + 8192, lv, wave);
            gla_update(lds, S, vf, lv, lv >> 4);
        }
        float* pp = SL + ((size_t)(bh * 7 + seg) * 256 + 4 * g) * 512 + sl * 128 + 16 * wave + li;
#pragma unroll
        for (int i = 0; i < 16; ++i) { asm volatile("" : "+v"(pp));
#pragma unroll
            for (int r = 0; r < 4; ++r) pp[r * 512] = S[i][r];
            pp += 16 * 512; }
        if (sl == 0 && tid < 256) DSEG[(bh * 7 + seg) * 256 + tid] = dprod;
    }
}
__device__ __forceinline__ void gla_g2(float* SL, const float* DSEG, int gtid, int NT) {
    for (int it = gtid; it < 8 * 256 * 128; it += NT) { const int bh = it >> 15, dk = (it >> 7) & 255, d4 = it & 127;
        f32x4 s = {0.f, 0.f, 0.f, 0.f}, lv[7]; float dv[7];
#pragma unroll
        for (int seg = 0; seg < 7; ++seg) { lv[seg] = *((const GAS f32x4*)(SL + ((size_t)(bh * 7 + seg) * 256 + dk) * 512) + d4); dv[seg] = DSEG[(bh * 7 + seg) * 256 + dk]; }
#pragma unroll
        for (int seg = 0; seg < 7; ++seg) { s = s * dv[seg] + lv[seg]; *((GAS f32x4*)(SL + ((size_t)(bh * 7 + seg) * 256 + dk) * 512) + d4) = s; } }
}
__device__ __forceinline__ void gla_g3_chunk(LAS unsigned char* lds, f32x4 (&S)[16], GlaRegs& R, const bf16* Zb, const bf16* ATT, const float* DEC, float* OF,
                                             int b, int c, int h, int sl, int c_next, bool refill, bool do_update, int tid, int lane, int wave) {
    const unsigned lbase = (unsigned)(size_t)lds;
    __syncthreads();
    gla_commit<true>(R, lds, tid);
    __syncthreads();
    if (refill) gla_issue<true>(R, Zb, ATT, DEC, b, c_next, h, sl, tid);
    unsigned lv = (unsigned)lane; asm volatile("" : "+v"(lv));
    const unsigned li = lv & 15, g = lv >> 4;
    gl_bf16x8 vf[2]; vf[0] = tr_frag(lbase + GL_V, lv, wave); vf[1] = tr_frag(lbase + GL_V + 8192, lv, wave);
    f32x4 o[4];
#pragma unroll
    for (int nt = 0; nt < 4; ++nt) o[nt] = (f32x4){0.f, 0.f, 0.f, 0.f};
#pragma unroll
    for (int s = 0; s < 8; ++s) {
        gl_bf16x8 qf[4];
#pragma unroll
        for (int nt = 0; nt < 4; ++nt) qf[nt] = *(const LAS gl_bf16x8*)(lds + GL_QT + off_q(16 * nt + li, 4 * s + g));
        v4u aw; aw.x = pkbf(S[2 * s][0], S[2 * s][1]); aw.y = pkbf(S[2 * s][2], S[2 * s][3]); aw.z = pkbf(S[2 * s + 1][0], S[2 * s + 1][1]); aw.w = pkbf(S[2 * s + 1][2], S[2 * s + 1][3]);
        const gl_bf16x8 af = __builtin_bit_cast(gl_bf16x8, aw);
        __builtin_amdgcn_sched_barrier(0);
#pragma unroll
        for (int nt = 0; nt < 4; ++nt) o[nt] = GLA_MFMA(af, qf[nt], o[nt]);
        __builtin_amdgcn_sched_barrier(0);
    }
    { gl_bf16x8 tf[6];
#pragma unroll
        for (int nt = 0; nt < 4; ++nt) tf[nt] = *(const LAS gl_bf16x8*)(lds + GL_ATT + off_a(16 * nt + li, g));
#pragma unroll
        for (int nt = 2; nt < 4; ++nt) tf[2 + nt] = *(const LAS gl_bf16x8*)(lds + GL_ATT + off_a(16 * nt + li, 4 + g));
        __builtin_amdgcn_sched_barrier(0);
#pragma unroll
        for (int nt = 0; nt < 4; ++nt) o[nt] = GLA_MFMA(vf[0], tf[nt], o[nt]);
#pragma unroll
        for (int nt = 2; nt < 4; ++nt) o[nt] = GLA_MFMA(vf[1], tf[2 + nt], o[nt]);
        __builtin_amdgcn_sched_barrier(0); }
    bf16* op = (bf16*)OF + ((size_t)b * SEQ + (size_t)c * 64 + li) * D + h * 512 + sl * 128 + 16 * wave + 4 * g;
#pragma unroll
    for (int nt = 0; nt < 4; ++nt) { v2u w; w.x = pkbf(o[nt][0], o[nt][1]); w.y = pkbf(o[nt][2], o[nt][3]); *(GAS v2u*)(op + (size_t)(16 * nt) * D) = w; }
    if (do_update) gla_update(lds, S, vf, lv, g);
}
__device__ __forceinline__ void gla_g3(LAS unsigned char* lds, const bf16* Zb, const bf16* ATT, const float* DEC, const float* SL, float* OF, int bx, int G, int tid0, int lane0, int wave) {
    const int tid = opq(tid0), lane = tid & 63; (void)lane0;
    const unsigned li = lane & 15, g = lane >> 4;
    for (int un = bx; un < 256; un += G) {
        const int seg = un & 7, bh = un >> 5, sl = (un >> 3) & 3, b = bh >> 2, h = bh & 3;
        f32x4 S[16];
        if (seg == 0) {
#pragma unroll
            for (int i = 0; i < 16; ++i) S[i] = (f32x4){0.f, 0.f, 0.f, 0.f};
        } else { const float* pp = SL + ((size_t)(bh * 7 + seg - 1) * 256 + 4 * g) * 512 + sl * 128 + 16 * wave + li;
#pragma unroll
            for (int i = 0; i < 16; ++i) { asm volatile("" : "+v"(pp));
#pragma unroll
                for (int r = 0; r < 4; ++r) S[i][r] = pp[r * 512];
                pp += 16 * 512; } }
        const int c0 = seg * GLA_CPS;
        GlaRegs RA; gla_issue<true>(RA, Zb, ATT, DEC, b, c0, h, sl, tid);
        for (int cc = 0; cc < GLA_CPS; ++cc)
            gla_g3_chunk(lds, S, RA, Zb, ATT, DEC, OF, b, c0 + cc, h, sl, c0 + cc + 1, cc + 1 < GLA_CPS, cc + 1 < GLA_CPS, tid, lane, wave);
    }
}

struct Args { const float* in[20]; float* out; unsigned char* ws; int ph_lo, ph_hi, li, pad; };
constexpr int PH_PER_LAYER = 12, N_PHASES = 2 + 2 * PH_PER_LAYER;

#define IN(k) (lo <= (k) && (k) < hi)
#define SEAM(k) do { if (IN(k) && IN((k) + 1)) xcd_barrier(bar); } while (0)
template <int l> __device__ __forceinline__ void layer_phases(const Args& args, LAS unsigned char* lds, const XcdBarrier& bar, const int lo, const int hi,
                                                             const int tid, const int lane, const int wave, const int G, const int bx, const int vcu, const int gw, const int NGW) {
    unsigned char* ws = args.ws;
    gu32* ctl = (gu32*)(ws + WS_CTL);
    const float* x_in = args.in[0]; const float* ln_mix = args.in[1]; const float* w_in = args.in[2]; const float* w_alpha = args.in[3]; const float* b_alpha = args.in[4];
    const float* gla_norm = args.in[5]; const float* w_pool = args.in[6]; const float* pool_scale = args.in[7]; const float* w_bg = args.in[8]; const float* w_bp = args.in[9];
    const float* w_out = args.in[10]; const float* ln_ffn = args.in[11]; const float* ffn_g = args.in[12]; const float* ffn_u = args.in[13]; const float* ffn_d = args.in[14];
    const float* router_w = args.in[15]; const float* exp_g = args.in[16]; const float* exp_u = args.in[17]; const float* exp_d = args.in[18]; const float* ln_final = args.in[19];
    float* xo = args.out;
    bf16* WinT = (bf16*)(ws + WS_WIN); bf16* BcatT = (bf16*)(ws + WS_BCAT); bf16* WoutT = (bf16*)(ws + WS_WOUT); bf16* FF1T = (bf16*)(ws + WS_FF1); bf16* FF2T = (bf16*)(ws + WS_FF2);
    unsigned char* EF1T = ws + WS_EF1; unsigned char* EF2T = ws + WS_EF2;
    bf16* Hb = (bf16*)(ws + WS_HB); bf16* Zb = (bf16*)(ws + WS_ZB); float* LA = (float*)(ws + WS_LA); float* OF = (float*)(ws + WS_OF);
    bf16* Acat = (bf16*)(ws + WS_ACAT); bf16* Ub = (bf16*)(ws + WS_U); bf16* Hmid = (bf16*)(ws + WS_HMID); unsigned char* Hmid8 = ws + WS_HMID; unsigned char* Hperm8 = ws + WS_HPERM;
    bf16* WA1T = (bf16*)(ws + WS_CTL + 3 * MiB); bf16* WbpT = (bf16*)(ws + WS_OF); bf16* WpS = (bf16*)(ws + WS_OF + 8 * MiB);
    int* slot_of_tok = (int*)(ws + WS_TOKSLOT); int* tok_e = (int*)(ws + WS_TOKE); float* tok_w = (float*)(ws + WS_TOKW); bf16* YS = (bf16*)(ws + WS_LA);
    unsigned* cnt = (unsigned*)(ctl + CW_CNT); unsigned* fill = (unsigned*)(ctl + CW_FILL);

    constexpr int pb = 1 + PH_PER_LAYER * l;
        if (IN(pb + 0)) {
            pg8::Gemm g{Hb, WinT + (size_t)l * ZN * D, M, ZP, D, 0, D, D}; pg8::StaticOrder S; S.init(M, ZP, G, bx);
            pg8::EpiZ E{Zb};
            pg8::gemm_phase<pg8::EpiZ, pg8::StaticOrder, true, true>(lds + RING_OFF, g, S, E);
        }
        SEAM(pb + 0);
        bf16* ATT = (bf16*)(ws + WS_LA); float* DEC = (float*)(ws + WS_LA + 8 * MiB); float* DSEG = (float*)(ws + WS_LA + 10 * MiB); float* SL = (float*)(ws + WS_U);
        if (IN(pb + 1)) gla_g0(lds + RING_OFF, Zb, Hb, WA1T + (size_t)l * 16 * D, w_alpha + (size_t)l * 16 * 1024, b_alpha + l * 1024, ATT, DEC, bx, G, tid, lane, wave);
        SEAM(pb + 1);
        if (IN(pb + 2)) gla_g1(lds + RING_OFF, Zb, DEC, SL, DSEG, bx, G, tid, lane, wave);
        SEAM(pb + 2);
        if (IN(pb + 3)) {
            if (l == 0) {
                pg8::Gemm g{WbpT, WpS, 2 * 4 * 2048, 256, 256, (size_t)256 * 256 * 2, 256, 256}; pg8::PoolOrder S; S.G = G; S.c = bx;
                pg8::EpiPoolW E{BcatT};
                pg8::gemm_phase<pg8::EpiPoolW, pg8::PoolOrder, false, false>(lds + RING_OFF, g, S, E);
            }
            gla_g2(SL, DSEG, vcu * 512 + tid, G * 512);
        }
        SEAM(pb + 3);
        if (IN(pb + 4)) gla_g3(lds + RING_OFF, Zb, ATT, DEC, SL, OF, bx, G, tid, lane, wave);
        SEAM(pb + 4);
        if (IN(pb + 5)) {
            const float* gn = gla_norm + l * HV;
            const f32x4 g0 = *(const GAS f32x4*)(gn + lane * 8), g1 = *(const GAS f32x4*)(gn + lane * 8 + 4);
            v4u no[4], nr[4];
#define G4_FETCH(mm) do { const int m_ = (mm); _Pragma("unroll") for (int h_ = 0; h_ < NH; ++h_) { no[h_] = *(const GAS v4u*)((const bf16*)OF + (size_t)m_ * D + h_ * HV + lane * 8); \
                nr[h_] = *(const GAS v4u*)(Zb + (size_t)m_ * ZP + ZC_R + h_ * HV + lane * 8); } } while (0)
            if (gw < M) G4_FETCH(gw);
            for (int m = gw; m < M; m += NGW) {
                v4u co[4], cr[4];
#pragma unroll
                for (int h = 0; h < NH; ++h) { co[h] = no[h]; cr[h] = nr[h]; }
                if (m + NGW < M) G4_FETCH(m + NGW);
#pragma unroll
                for (int h = 0; h < NH; ++h) {
                    const v4u ow = co[h]; f32x4 o0 = {bfl(ow.x), bfh(ow.x), bfl(ow.y), bfh(ow.y)}, o1 = {bfl(ow.z), bfh(ow.z), bfl(ow.w), bfh(ow.w)};
                    float s = (o0.x * o0.x + o0.y * o0.y) + (o0.z * o0.z + o0.w * o0.w) + (o1.x * o1.x + o1.y * o1.y) + (o1.z * o1.z + o1.w * o1.w);
                    const float rstd = 1.0f / sqrtf(wave_sum(s) * (1.0f / HV) + EPS);
                    const v4u rw = cr[h];
                    o0 = o0 * rstd * g0; o1 = o1 * rstd * g1;
                    v4u w; w.x = pk2(o0.x * bfl(rw.x), o0.y * bfh(rw.x)); w.y = pk2(o0.z * bfl(rw.y), o0.w * bfh(rw.y)); w.z = pk2(o1.x * bfl(rw.z), o1.y * bfh(rw.z)); w.w = pk2(o1.z * bfl(rw.w), o1.w * bfh(rw.w));
                    *(GAS v4u*)(Acat + (size_t)m * KCAT + h * HV + lane * 8) = w;
                }
                const int t = m & (SEQ - 1), win = 2 << (lane >> 4), nw = (t + 1 < win) ? (t + 1) : win;
                float sm[16], p0[16];
#pragma unroll
                for (int i = 0; i < 16; ++i) { sm[i] = 0.f; p0[i] = 0.f; }
#pragma unroll
                for (int bt = 0; bt < 2; ++bt) {
                    v4u pa[8], pc[8];
#pragma unroll
                    for (int s = 0; s < 8; ++s) { const int sft = 8 * bt + s; pa[s] = (v4u){0u, 0u, 0u, 0u}; pc[s] = (v4u){0u, 0u, 0u, 0u};
                        if (sft < nw) { const GAS v4u* pp = (const GAS v4u*)(Zb + (size_t)(m - sft) * ZP + ZC_P + lane * 16); pa[s] = pp[0]; pc[s] = pp[1]; } }
#pragma unroll
                    for (int s = 0; s < 8; ++s) { const v4u a = pa[s], c = pc[s];
                        const float pv[16] = {bfl(a.x), bfh(a.x), bfl(a.y), bfh(a.y), bfl(a.z), bfh(a.z), bfl(a.w), bfh(a.w), bfl(c.x), bfh(c.x), bfl(c.y), bfh(c.y), bfl(c.z), bfh(c.z), bfl(c.w), bfh(c.w)};
#pragma unroll
                        for (int i = 0; i < 16; ++i) { sm[i] += pv[i]; if (bt == 0 && s == 0) p0[i] = pv[i]; } }
                }
                const float inv = 1.0f / (float)nw;
                v4u w0, w1;
                w0.x = pk2(sm[0] * inv - p0[0], sm[1] * inv - p0[1]); w0.y = pk2(sm[2] * inv - p0[2], sm[3] * inv - p0[3]); w0.z = pk2(sm[4] * inv - p0[4], sm[5] * inv - p0[5]); w0.w = pk2(sm[6] * inv - p0[6], sm[7] * inv - p0[7]);
                w1.x = pk2(sm[8] * inv - p0[8], sm[9] * inv - p0[9]); w1.y = pk2(sm[10] * inv - p0[10], sm[11] * inv - p0[11]); w1.z = pk2(sm[12] * inv - p0[12], sm[13] * inv - p0[13]); w1.w = pk2(sm[14] * inv - p0[14], sm[15] * inv - p0[15]);
                GAS v4u* mp = (GAS v4u*)(Acat + (size_t)m * KCAT + 2048 + lane * 16); mp[0] = w0; mp[1] = w1;
            }
        }
        SEAM(pb + 5);
        if (IN(pb + 6)) {
            pg8::Gemm g{Acat, BcatT + (size_t)l * D * KCAT, M, D, D, 0, KCAT, KCAT}; pg8::StaticOrder S; S.init(M, D, G, bx);
            pg8::EpiGate<false> E{Ub, D, Zb + ZC_GA, ZP};
            pg8::gemm_phase<pg8::EpiGate<false>, pg8::StaticOrder, true, true>(lds + RING_OFF, g, S, E);
        }
        if (IN(pb + 6)) {
            VM_WAIT(); __syncthreads();
            pg8::Gemm g{Acat + 2048, BcatT + (size_t)l * D * KCAT + 2048, M, D, 1024, 0, KCAT, KCAT}; pg8::StaticOrder S; S.init(M, D, G, bx);
            pg8::EpiGate<true> E{Ub, D, Zb + ZC_GB, ZP};
            pg8::gemm_phase<pg8::EpiGate<true>, pg8::StaticOrder, true, true>(lds + RING_OFF, g, S, E);
        }
        SEAM(pb + 6);
        if (IN(pb + 7)) {
            pg8::Gemm g{Ub, WoutT + (size_t)l * D * D, M, D, D, 0, D, D}; pg8::StaticOrder S; S.init(M, D, G, bx);
            pg8::EpiRes E{l == 0 ? x_in : (const float*)xo, xo, D};
            pg8::gemm_phase<pg8::EpiRes, pg8::StaticOrder, true, true>(lds + RING_OFF, g, S, E);
        }
        SEAM(pb + 7);
        if (IN(pb + 8)) {
            if (l == 0) norm_rows<false, DENSE_FP8>(xo, ln_ffn, Hb, gw, NGW, lane, nullptr, nullptr, nullptr, nullptr);
            else {
                LAS float* rw = (LAS float*)(lds + RING_OFF); LAS unsigned* hist = (LAS unsigned*)(lds + RING_OFF + 65536);
                for (int i = tid; i < D * NE / 4; i += 512) ((LAS f32x4*)rw)[i] = ((const GAS f32x4*)router_w)[i];
                if (tid < 8) hist[tid] = 0u;
                __syncthreads();
                norm_rows<true>(xo, ln_ffn + D, Hb, gw, NGW, lane, rw, tok_e, tok_w, hist);
                __syncthreads();
                if (tid < 8) __hip_atomic_fetch_add(cnt + tid, hist[tid], RLX_AGENT);
            }
        }
        SEAM(pb + 8);
        if (l == 0) {
            if (IN(pb + 9)) {
                pg8::StaticOrder S; S.init(M, FFN, G, bx);
                if constexpr (DENSE_FP8) { pg8::Gemm g{Hb, FF1T, M, FFN, D / 2, 0, D / 2, D / 2}; pg8::EpiSwiGLU8 E{Hmid8, DFF};
                    pg8::gemm_phase<pg8::EpiSwiGLU8, pg8::StaticOrder, true, true, true>(lds + RING_OFF, g, S, E); }
                else { pg8::Gemm g{Hb, FF1T, M, FFN, D, 0, D, D}; pg8::EpiSwiGLU E{Hmid, DFF};
                    pg8::gemm_phase<pg8::EpiSwiGLU, pg8::StaticOrder, true, true>(lds + RING_OFF, g, S, E); }
            }
            SEAM(pb + 9);
            if (IN(pb + 10)) {
                pg8::StaticOrder S; S.init(M, D, G, bx); pg8::EpiRes E{xo, xo, D};
                if constexpr (DENSE_FP8) { pg8::Gemm g{Hmid, FF2T, M, D, DFF / 2, 0, DFF / 2, DFF / 2}; pg8::gemm_phase<pg8::EpiRes, pg8::StaticOrder, true, true, true>(lds + RING_OFF, g, S, E); }
                else { pg8::Gemm g{Hmid, FF2T, M, D, DFF, 0, DFF, DFF}; pg8::gemm_phase<pg8::EpiRes, pg8::StaticOrder, true, true>(lds + RING_OFF, g, S, E); }
            }
            SEAM(pb + 10);
            if (IN(pb + 11)) norm_rows<false>(xo, ln_mix + D, Hb, gw, NGW, lane, nullptr, nullptr, nullptr, nullptr);
            SEAM(pb + 11);
        } else {
            if (IN(pb + 9)) {
                LAS unsigned* lcnt = (LAS unsigned*)(lds + RING_OFF); LAS unsigned* lbase = lcnt + 8; LAS int* lslot = (LAS int*)(lcnt + 16);
                int brow[8]; { int p = 0;
#pragma unroll
                    for (int e = 0; e < 8; ++e) { brow[e] = 256 * p; p += (int)((__hip_atomic_load(cnt + e, RLX_AGENT) + 255u) >> 8); } }
                for (int ch = bx; ch < M / 64; ch += G) {
                    __syncthreads();
                    if (tid < 8) lcnt[tid] = 0u;
                    __syncthreads();
                    int e = 0, tok = 0; unsigned rank = 0;
                    if (tid < 128) { tok = ch * 64 + (tid >> 1); e = tok_e[2 * tok + (tid & 1)]; rank = __hip_atomic_fetch_add(lcnt + e, 1u, __ATOMIC_RELAXED, __HIP_MEMORY_SCOPE_WORKGROUP); }
                    __syncthreads();
                    if (tid < 8) lbase[tid] = __hip_atomic_fetch_add(fill + tid, lcnt[tid], RLX_AGENT);
                    __syncthreads();
                    if (tid < 128) { int br = 0;
#pragma unroll
                        for (int q = 0; q < 8; ++q) br = (e == q) ? brow[q] : br;
                        const int slot = br + (int)lbase[e] + (int)rank; lslot[tid] = slot; slot_of_tok[2 * tok + (tid & 1)] = slot; }
                    __syncthreads();
                    for (int en = wave; en < 128; en += NWAVES) { const int tk = ch * 64 + (en >> 1), slot = lslot[en];
                        const GAS v4u* src = (const GAS v4u*)(Hb + (size_t)tk * D) + 4 * lane; GAS v4u* dst = (GAS v4u*)(Hperm8 + (size_t)slot * D) + 2 * lane;
#pragma unroll
                        for (int j = 0; j < 2; ++j) { const v4u a = src[2 * j], c = src[2 * j + 1]; v4u o;
                            o.x = pg8::pk4_fp8(bfl(a.x), bfh(a.x), bfl(a.y), bfh(a.y)); o.y = pg8::pk4_fp8(bfl(a.z), bfh(a.z), bfl(a.w), bfh(a.w));
                            o.z = pg8::pk4_fp8(bfl(c.x), bfh(c.x), bfl(c.y), bfh(c.y)); o.w = pg8::pk4_fp8(bfl(c.z), bfh(c.z), bfl(c.w), bfh(c.w)); dst[j] = o; } }
                }
            }
            SEAM(pb + 9);
            if (IN(pb + 10)) {
                pg8::Gemm g{(const bf16*)Hperm8, (const bf16*)EF1T, MAXSLOT, FFN, D / 2, (size_t)FFN * D, D / 2, D / 2}; pg8::MoeOrder S; S.init(cnt, FFN / 256, G, bx);
                pg8::EpiSwiGLU8 E{Hmid8, DFF};
                pg8::gemm_phase<pg8::EpiSwiGLU8, pg8::MoeOrder, true, true, true>(lds + RING_OFF, g, S, E);
            }
            SEAM(pb + 10);
            if (IN(pb + 11)) {
                pg8::Gemm g{(const bf16*)Hmid8, (const bf16*)EF2T, MAXSLOT, D, DFF / 2, (size_t)D * DFF, DFF / 2, DFF / 2}; pg8::MoeOrder S; S.init(cnt, D / 256, G, bx);
                pg8::EpiBf16 E{YS, D};
                pg8::gemm_phase<pg8::EpiBf16, pg8::MoeOrder, true, true, true>(lds + RING_OFF, g, S, E);
            }
            SEAM(pb + 11);
        }
}

__global__ void __launch_bounds__(NWAVES * 64, 2) fwd(Args args) {
    extern __shared__ __attribute__((aligned(16))) unsigned char lds_raw[];
    LAS unsigned char* lds = (LAS unsigned char*)lds_raw;
    volatile LAS unsigned* MISC = (volatile LAS unsigned*)(lds + MISC_OFF);
    const int tid = threadIdx.x, lane = tid & 63, wave = __builtin_amdgcn_readfirstlane(tid >> 6);
    const int G = gridDim.x, bx = blockIdx.x;
    const int vcu = (G % 8 == 0) ? (bx % 8) * (G / 8) + bx / 8 : bx;
    const int gw = vcu * NWAVES + wave, NGW = G * NWAVES;
    unsigned char* ws = args.ws;
    gu32* ctl = (gu32*)(ws + WS_CTL);
    const float* x_in = args.in[0]; const float* ln_mix = args.in[1]; const float* w_in = args.in[2]; const float* w_alpha = args.in[3]; const float* b_alpha = args.in[4];
    const float* gla_norm = args.in[5]; const float* w_pool = args.in[6]; const float* pool_scale = args.in[7]; const float* w_bg = args.in[8]; const float* w_bp = args.in[9];
    const float* w_out = args.in[10]; const float* ln_ffn = args.in[11]; const float* ffn_g = args.in[12]; const float* ffn_u = args.in[13]; const float* ffn_d = args.in[14];
    const float* router_w = args.in[15]; const float* exp_g = args.in[16]; const float* exp_u = args.in[17]; const float* exp_d = args.in[18]; const float* ln_final = args.in[19];
    float* xo = args.out;
    bf16* WinT = (bf16*)(ws + WS_WIN); bf16* BcatT = (bf16*)(ws + WS_BCAT); bf16* WoutT = (bf16*)(ws + WS_WOUT); bf16* FF1T = (bf16*)(ws + WS_FF1); bf16* FF2T = (bf16*)(ws + WS_FF2);
    unsigned char* EF1T = ws + WS_EF1; unsigned char* EF2T = ws + WS_EF2;
    bf16* Hb = (bf16*)(ws + WS_HB); bf16* Zb = (bf16*)(ws + WS_ZB); float* LA = (float*)(ws + WS_LA); float* OF = (float*)(ws + WS_OF);
    bf16* Acat = (bf16*)(ws + WS_ACAT); bf16* Ub = (bf16*)(ws + WS_U); bf16* Hmid = (bf16*)(ws + WS_HMID); unsigned char* Hmid8 = ws + WS_HMID; unsigned char* Hperm8 = ws + WS_HPERM;
    bf16* WA1T = (bf16*)(ws + WS_CTL + 3 * MiB); bf16* WbpT = (bf16*)(ws + WS_OF); bf16* WpS = (bf16*)(ws + WS_OF + 8 * MiB);
    int* slot_of_tok = (int*)(ws + WS_TOKSLOT); int* tok_e = (int*)(ws + WS_TOKE); float* tok_w = (float*)(ws + WS_TOKW); bf16* YS = (bf16*)(ws + WS_LA);
    unsigned* cnt = (unsigned*)(ctl + CW_CNT); unsigned* fill = (unsigned*)(ctl + CW_FILL);

    for (int u = tid; u < (LDS_BYTES - LDSCTL_OFF) / 4; u += NWAVES * 64) ((LAS unsigned*)(lds + LDSCTL_OFF))[u] = 0u;
    __syncthreads();
    const int lo = args.ph_lo, hi = args.ph_hi;
    XcdBarrier bar; bar.bar = (unsigned*)(ctl + CW_BAR); bar.x = 0; bar.st = nullptr;
    if (hi - lo > 1) bar = xcd_barrier_post((unsigned*)(ctl + CW_BAR), MISC + 8);

    if (IN(0)) {
        LAS unsigned* Tl = (LAS unsigned*)(lds + RING_OFF + wave * 16384);
#ifdef PROBE_NOW
        const int PNW = (args.li == 7);
#else
        constexpr int PNW = 0;
#endif
        for (int i = vcu * 512 + tid; i < 2 * 16 * D; i += G * 512) { const int l = i >> 15, r = (i >> 11) & 15, k = i & 2047; WA1T[i] = (bf16)f2bf(w_in[(size_t)l * D * DIN + (size_t)k * DIN + 6144 + r]); }
        for (int i = vcu * 512 + tid; i < 2 * 4 * 256 * 256 / 4; i += G * 512) { const int d4 = i & 63, lg = i >> 14;
            const f32x4 w = ((const GAS f32x4*)w_pool)[i], s = ((const GAS f32x4*)pool_scale)[lg * 64 + d4];
            v2u o; o.x = pkbf(w.x * s.x, w.y * s.y); o.y = pkbf(w.z * s.z, w.w * s.w); ((GAS v2u*)WpS)[i] = o; }
#ifdef PROBE_NOSTORE
        const int PNS = (args.li == 7);
#else
        constexpr int PNS = 0;
#endif
        constexpr int T_LAYER = 8192, T_DENSE = 8448, T_ALL = 2 * T_LAYER + T_DENSE + 8 * T_DENSE;
        auto decode = [&](int it, TrJob& J) {
            J.mode = 0; J.row_off = 0; J.kind = 0; int kt, nt;
            if (it < 2 * T_LAYER) { const int l = it / T_LAYER, r = it % T_LAYER; const float* wi = w_in + (size_t)l * D * DIN; unsigned char* wt = (unsigned char*)(WinT + (size_t)l * ZN * D);
                if (r < 3072) { J.src = wi; J.ldw = DIN; J.dst = wt; J.ldt = 2 * D; kt = r / 96; nt = r % 96; }
                else if (r < 5632) { const int q = r - 3072; J.src = wi + 6160; J.ldw = DIN; J.dst = wt; J.ldt = 2 * D; J.row_off = 6144; kt = q / 80; nt = q % 80; }
                else if (r < 6656) { const int q = r - 5632; J.src = w_bg + (size_t)l * D * D; J.ldw = D; J.dst = (unsigned char*)(BcatT + (size_t)l * D * KCAT); J.ldt = 2 * KCAT; kt = q >> 5; nt = q & 31; }
                else if (r < 7680) { const int q = r - 6656; J.src = w_out + (size_t)l * D * D; J.ldw = D; J.dst = (unsigned char*)(WoutT + (size_t)l * D * D); J.ldt = 2 * D; kt = q >> 5; nt = q & 31; }
                else { const int q = r - 7680; kt = q >> 5; nt = q & 31;
                    J.src = w_bp + (size_t)l * 1024 * D + (size_t)(64 * kt) * D + 64 * nt; J.ldw = D; J.dst = (unsigned char*)(WbpT + ((size_t)(l * 4 + (kt >> 2)) * 2048) * 256); J.ldt = 512; J.k0 = 64 * (kt & 3); J.n0 = 64 * nt; return; }
                J.k0 = 64 * kt; J.n0 = 64 * nt;
            } else if (it < 2 * T_LAYER + T_DENSE) { const int r = it - 2 * T_LAYER, j = r / 2816, q = r % 2816;
                if (DENSE_FP8) { J.kind = 1;
                    if (j == 0) { J.src = ffn_g; J.ldw = DFF; J.dst = (unsigned char*)FF1T; J.ldt = D; J.mode = 1; kt = q / 176; nt = q % 176; }
                    else if (j == 1) { J.src = ffn_u; J.ldw = DFF; J.dst = (unsigned char*)FF1T; J.ldt = D; J.mode = 1; J.row_off = 128; kt = q / 176; nt = q % 176; }
                    else { J.src = ffn_d; J.ldw = D; J.dst = (unsigned char*)FF2T; J.ldt = DFF; kt = q >> 6; nt = q & 63; }
                    J.k0 = 128 * kt; J.n0 = 32 * nt;
                } else {
                if (j == 0) { J.src = ffn_g; J.ldw = DFF; J.dst = (unsigned char*)FF1T; J.ldt = 2 * D; J.mode = 1; kt = q / 88; nt = q % 88; }
                else if (j == 1) { J.src = ffn_u; J.ldw = DFF; J.dst = (unsigned char*)FF1T; J.ldt = 2 * D; J.mode = 1; J.row_off = 128; kt = q / 88; nt = q % 88; }
                else { J.src = ffn_d; J.ldw = D; J.dst = (unsigned char*)FF2T; J.ldt = 2 * DFF; kt = q >> 5; nt = q & 31; }
                J.k0 = 64 * kt; J.n0 = 64 * nt; }
            } else { const int r = it - 2 * T_LAYER - T_DENSE, e = r / T_DENSE, r2 = r % T_DENSE, j = r2 / 2816, q = r2 % 2816; J.kind = 1;
                if (j == 0) { J.src = exp_g + (size_t)e * D * DFF; J.ldw = DFF; J.dst = EF1T + (size_t)e * FFN * D; J.ldt = D; J.mode = 1; kt = q / 176; nt = q % 176; }
                else if (j == 1) { J.src = exp_u + (size_t)e * D * DFF; J.ldw = DFF; J.dst = EF1T + (size_t)e * FFN * D; J.ldt = D; J.mode = 1; J.row_off = 128; kt = q / 176; nt = q % 176; }
                else { J.src = exp_d + (size_t)e * DFF * D; J.ldw = D; J.dst = EF2T + (size_t)e * D * DFF; J.ldt = DFF; kt = q >> 6; nt = q & 63; }
                J.k0 = 128 * kt; J.n0 = 32 * nt;
            }
            J.src += (size_t)J.k0 * J.ldw + J.n0;
        };
        if (gw < T_ALL) {
            TrJob J, Jn; f32x4 R[16], Rn[16];
            decode(gw, J); tr_load(J, R, lane);
            for (int it = gw; it < T_ALL; it += NGW) {
                const bool more = it + NGW < T_ALL;
                if (more) { decode(it + NGW, Jn); tr_load(Jn, Rn, lane); }
                tr_finish(J, R, Tl, lane, PNS && J.kind == 1);
                if (more) { J = Jn;
#pragma unroll
                    for (int i = 0; i < 16; ++i) R[i] = Rn[i]; }
            }
        }
        norm_rows<false>(x_in, ln_mix, Hb, gw, NGW, lane, nullptr, nullptr, nullptr, nullptr);
    }
    SEAM(0);
#ifdef PROBE_XBAR
    if (hi - lo > 1) for (int i = 0; i < PROBE_XBAR; ++i) xcd_barrier(bar);
#endif

    layer_phases<0>(args, lds, bar, lo, hi, tid, lane, wave, G, bx, vcu, gw, NGW);
    layer_phases<1>(args, lds, bar, lo, hi, tid, lane, wave, G, bx, vcu, gw, NGW);
    if (IN(N_PHASES - 1)) {
        f32x4 nx[8], gv[8]; v2u na[8], nc[8]; float nw1 = 0.f, nw2 = 0.f;
#pragma unroll
        for (int j = 0; j < 8; ++j) gv[j] = ((const GAS f32x4*)ln_final)[lane + 64 * j];
#define FINAL_FETCH(mm) do { const int m_ = (mm); const GAS f32x4* xr_ = (const GAS f32x4*)(xo + (size_t)m_ * D) + lane; \
            const int s1_ = slot_of_tok[2 * m_], s2_ = slot_of_tok[2 * m_ + 1]; nw1 = tok_w[2 * m_]; nw2 = tok_w[2 * m_ + 1]; \
            const GAS v2u* y1_ = (const GAS v2u*)(YS + (size_t)s1_ * D) + lane; const GAS v2u* y2_ = (const GAS v2u*)(YS + (size_t)s2_ * D) + lane; \
            _Pragma("unroll") for (int j = 0; j < 8; ++j) { nx[j] = xr_[64 * j]; na[j] = y1_[64 * j]; nc[j] = y2_[64 * j]; } } while (0)
        if (gw < M) FINAL_FETCH(gw);
        for (int m = gw; m < M; m += NGW) {
            GAS f32x4* xr = (GAS f32x4*)(xo + (size_t)m * D) + lane;
            const float w1 = nw1, w2 = nw2;
            f32x4 v[8]; float s = 0.f;
#pragma unroll
            for (int j = 0; j < 8; ++j) { const v2u a = na[j], c = nc[j]; f32x4 t = nx[j];
                t.x += w1 * bfl(a.x) + w2 * bfl(c.x); t.y += w1 * bfh(a.x) + w2 * bfh(c.x); t.z += w1 * bfl(a.y) + w2 * bfl(c.y); t.w += w1 * bfh(a.y) + w2 * bfh(c.y);
                v[j] = t; s += (t.x * t.x + t.y * t.y) + (t.z * t.z + t.w * t.w); }
            if (m + NGW < M) FINAL_FETCH(m + NGW);
            const float rstd = 1.0f / sqrtf(wave_sum(s) * (1.0f / D) + EPS);
#pragma unroll
            for (int j = 0; j < 8; ++j) xr[64 * j] = v[j] * rstd * gv[j];
        }
    }
#undef IN
#undef SEAM
}

#ifndef MK_ONE_LAUNCH
#define MK_ONE_LAUNCH 1
#endif
#ifndef PROBE_DUP
#define PROBE_DUP -1
#endif
#ifndef PROBE_REP
#define PROBE_REP 1
#endif
extern "C" void kernel_launch(void* const* d_in, const int* in_sizes, int n_in, void* d_out, int out_size, void* d_ws, size_t ws_size, hipStream_t stream) {
    static int grid = 0;
    if (grid == 0) {
        if (n_in != 20 || in_sizes[0] != M * D || out_size != M * D || ws_size < WS_END) { fprintf(stderr, "kernel_launch: unexpected shapes / workspace (n_in %d, in0 %d, out %d, ws %zu < %zu); nothing launched\n", n_in, n_in > 0 ? in_sizes[0] : -1, out_size, ws_size, (size_t)WS_END); grid = -1; return; }
        int dev = 0, cus = 0, per_cu = 0;
        if (hipGetDevice(&dev) != hipSuccess || hipDeviceGetAttribute(&cus, hipDeviceAttributeMultiprocessorCount, dev) != hipSuccess) { grid = -1; return; }
        if (hipFuncSetAttribute((const void*)fwd, hipFuncAttributeMaxDynamicSharedMemorySize, LDS_BYTES) != hipSuccess) { fprintf(stderr, "kernel_launch: hipFuncSetAttribute failed\n"); grid = -1; return; }
        if (hipOccupancyMaxActiveBlocksPerMultiprocessor(&per_cu, (const void*)fwd, NWAVES * 64, LDS_BYTES) != hipSuccess || per_cu < 1) { fprintf(stderr, "kernel_launch: occupancy query reports %d workgroups per CU\n", per_cu); }
        (void)hipGetLastError();
        grid = cus;
    }
    if (grid < 0) return;
    if (hipMemsetAsync((char*)d_ws + WS_CTL, 0, CTL_ZERO_BYTES, stream) != hipSuccess) return;
    Args a{};
    for (int i = 0; i < 20; ++i) a.in[i] = (const float*)d_in[i];
    a.out = (float*)d_out; a.ws = (unsigned char*)d_ws;
#if MK_ONE_LAUNCH
    a.ph_lo = 0; a.ph_hi = N_PHASES; a.li = 0;
    hipLaunchKernelGGL(fwd, dim3(grid), dim3(NWAVES * 64), LDS_BYTES, stream, a);
#else
    for (int p = 0; p < N_PHASES; ++p) { a.ph_lo = p; a.ph_hi = p + 1;
        if (p == PROBE_DUP) { a.li = 7; for (int r = 0; r < PROBE_REP; ++r) hipLaunchKernelGGL(fwd, dim3(grid), dim3(NWAVES * 64), LDS_BYTES, stream, a); }
        a.li = 0; hipLaunchKernelGGL(fwd, dim3(grid), dim3(NWAVES * 64), LDS_BYTES, stream, a); }
#endif
}
```

```cpp
#include <hip/hip_runtime.h>
#include <cstdio>
#include <cstdint>

namespace pg8 {
#define PG8_LAS __attribute__((address_space(3)))
typedef unsigned short bf16_t;
typedef short bf16x8 __attribute__((ext_vector_type(8)));
typedef float f32x4 __attribute__((ext_vector_type(4)));
typedef unsigned u32x4 __attribute__((ext_vector_type(4)));
typedef unsigned u32x2 __attribute__((ext_vector_type(2)));
constexpr int BM = 256, BK = 64, HALF = 128, HTB = HALF * BK * 2  , STAGE_BYTES = 8 * HTB, NXCD = 8, WGM = 8;

__host__ __device__ __forceinline__ int lds_byte(int r, int c) { const int st = (r >> 4) * 2 + (c >> 5), rr = r & 15, cc = c & 31, ob = rr * 64 + cc * 2; return st * 1024 + (ob ^ (((ob >> 9) & 1) << 5)); }
__host__ __device__ __forceinline__ void stage_rc(int b, int& R, int& C) { const int st = b / 1024, sb = b % 1024, swz = sb ^ (((sb >> 9) & 1) << 5); R = (st >> 1) * 16 + swz / 64; C = (st & 1) * 32 + (swz % 64) / 2; }
__host__ __device__ __forceinline__ int perm32(int rho) { const int n = rho >> 4, i = rho & 15; return 8 * (i >> 2) + 4 * n + (i & 3); }

struct Unit { int pm, pn, be; };
struct Gemm { const bf16_t* A; const bf16_t* Bt; int M, N, K; size_t bstride; int lda, ldb; };

struct StaticOrder {
    int nM, nN, nwg, G, c;
    __host__ __device__ void init(int M, int N, int G_, int c_) { nM = M / BM; nN = N / BM; nwg = nM * nN; G = G_; c = c_; }
    __host__ __device__ bool next(int i, Unit& u) const {
        const long L = (long)i * G + c; if (L >= nwg) return false;
        int wgid = (int)L; { const int q = nwg / NXCD, r = nwg % NXCD, xcd = wgid % NXCD, off = wgid / NXCD; wgid = (xcd < r ? xcd * (q + 1) : r * (q + 1) + (xcd - r) * q) + off; }
        const int nig = WGM * nN, gid = wgid / nig, fm = gid * WGM, gsz = (nM - fm) < WGM ? (nM - fm) : WGM;
        u.pm = fm + ((wgid % nig) % gsz); u.pn = (wgid % nig) / gsz; u.be = 0; return true;
    }
    __device__ __forceinline__ void a_ready(const Unit&) const {}
    __device__ __forceinline__ void done(const Unit&) const {}
};
struct PoolOrder {
    int G, c;
    __device__ __forceinline__ bool next(int i, Unit& u) const { const int L = i * G + c; if (L >= 64) return false; u.pm = L; u.pn = 0; u.be = L >> 3; return true; }
    __device__ __forceinline__ void a_ready(const Unit&) const {}
    __device__ __forceinline__ void done(const Unit&) const {}
};
struct MoeOrder {
    int nM, nN, nwg, G, c; int pe[8];
    __device__ __forceinline__ void init(const unsigned* cnt, int nN_, int G_, int c_) {
        int p = 0;
#pragma unroll
        for (int e = 0; e < 8; ++e) { p += (int)((__hip_atomic_load(cnt + e, __ATOMIC_RELAXED, __HIP_MEMORY_SCOPE_AGENT) + 255u) >> 8); pe[e] = p; }
        nM = p; nN = nN_; nwg = nM * nN; G = G_; c = c_;
    }
    __device__ __forceinline__ bool next(int i, Unit& u) const {
        const long L = (long)i * G + c; if (L >= nwg) return false;
        int wgid = (int)L; { const int q = nwg / NXCD, r = nwg % NXCD, xcd = wgid % NXCD, off = wgid / NXCD; wgid = (xcd < r ? xcd * (q + 1) : r * (q + 1) + (xcd - r) * q) + off; }
        const int nig = WGM * nN, gid = wgid / nig, fm = gid * WGM, gsz = (nM - fm) < WGM ? (nM - fm) : WGM;
        u.pm = fm + ((wgid % nig) % gsz); u.pn = (wgid % nig) / gsz;
        int be = 0;
#pragma unroll
        for (int e = 0; e < 7; ++e) be += (u.pm >= pe[e]) ? 1 : 0;
        u.be = be; return true;
    }
    __device__ __forceinline__ void a_ready(const Unit&) const {}
    __device__ __forceinline__ void done(const Unit&) const {}
};

__device__ __forceinline__ unsigned cvt_pk_bf16(float lo, float hi) { unsigned r; asm volatile("v_cvt_pk_bf16_f32 %0, %1, %2" : "=v"(r) : "v"(lo), "v"(hi)); return r; }
__device__ __forceinline__ float bf_lo(unsigned w) { return __uint_as_float(w << 16); }
__device__ __forceinline__ float bf_hi(unsigned w) { return __uint_as_float(w & 0xffff0000u); }
__device__ __forceinline__ float fsigmoid(float x) { return __builtin_amdgcn_rcpf(1.0f + __expf(-x)); }
__device__ __forceinline__ float fsilu(float x) { return x * __builtin_amdgcn_rcpf(1.0f + __expf(-x)); }
__device__ __forceinline__ float flogsig(float x) { return fminf(x, 0.0f) - __logf(1.0f + __expf(-fabsf(x))); }

constexpr int ZP_ = 11264;
struct EpiZ {
    static constexpr bool PERM = true, AFTER_DRAIN = false, HOOK = false;
    bf16_t* Zb;
    __device__ __forceinline__ void operator()(const f32x4 (&acc)[2][2][4][2], const Unit& u, int wr, int wc, int fr, int fq) const {
        const int row0 = u.pm * BM + wr * 64 + fr; const int pn = u.pn;
        if (pn >= 28) {
            const int c0 = (pn - 28) * HALF + wc * 32 + 8 * fq;
#pragma unroll
            for (int ai = 0; ai < 2; ++ai)
#pragma unroll
                for (int m = 0; m < 4; ++m) { bf16_t* rowp = Zb + (size_t)(row0 + ai * HALF + m * 16) * ZP_ + c0; float rr[8], sb[8];
#pragma unroll
                    for (int n = 0; n < 2; ++n)
#pragma unroll
                        for (int j = 0; j < 4; ++j) { const float ea = __expf(-acc[ai][0][m][n][j]), eb = __expf(-acc[ai][1][m][n][j]); sb[4 * n + j] = __builtin_amdgcn_rcpf(1.0f + eb); rr[4 * n + j] = (1.0f + eb) * __builtin_amdgcn_rcpf(1.0f + ea); }
                    u32x4 w; w.x = cvt_pk_bf16(rr[0], rr[1]); w.y = cvt_pk_bf16(rr[2], rr[3]); w.z = cvt_pk_bf16(rr[4], rr[5]); w.w = cvt_pk_bf16(rr[6], rr[7]);
                    *(u32x4*)(rowp + 7168) = w;
                    w.x = cvt_pk_bf16(sb[0], sb[1]); w.y = cvt_pk_bf16(sb[2], sb[3]); w.z = cvt_pk_bf16(sb[4], sb[5]); w.w = cvt_pk_bf16(sb[6], sb[7]);
                    *(u32x4*)(rowp + 9216) = w; }
            return; }
        const int mode = (pn >= 16 && pn < 24) ? 1 : 0;
        const int col0 = pn * BM + wc * 32 + 8 * fq;
#pragma unroll
        for (int ai = 0; ai < 2; ++ai)
#pragma unroll
            for (int m = 0; m < 4; ++m) { bf16_t* rowp = Zb + (size_t)(row0 + ai * HALF + m * 16) * ZP_ + col0;
#pragma unroll
                for (int bj = 0; bj < 2; ++bj) { f32x4 v0 = acc[ai][bj][m][0], v1 = acc[ai][bj][m][1];
                    if (mode == 1) {
#pragma unroll
                        for (int j = 0; j < 4; ++j) { v0[j] = fsilu(v0[j]); v1[j] = fsilu(v1[j]); } }
                    u32x4 w; w.x = cvt_pk_bf16(v0[0], v0[1]); w.y = cvt_pk_bf16(v0[2], v0[3]); w.z = cvt_pk_bf16(v1[0], v1[1]); w.w = cvt_pk_bf16(v1[2], v1[3]);
                    *(u32x4*)(rowp + bj * HALF) = w; } }
    }
};
template <bool ACCUM> struct EpiGate {
    static constexpr bool PERM = true, AFTER_DRAIN = false, HOOK = false;
    bf16_t* U; int ldu; const bf16_t* G; int ldg;
    __device__ __forceinline__ void operator()(const f32x4 (&acc)[2][2][4][2], const Unit& u, int wr, int wc, int fr, int fq) const {
        const int row0 = u.pm * BM + wr * 64 + fr, col0 = u.pn * BM + wc * 32 + 8 * fq;
#pragma unroll
        for (int ai = 0; ai < 2; ++ai) {
            u32x4 gw[4][2], ow[4][2];
#pragma unroll
            for (int m = 0; m < 4; ++m) { const size_t r = (size_t)(row0 + ai * HALF + m * 16);
#pragma unroll
                for (int bj = 0; bj < 2; ++bj) { gw[m][bj] = *(const u32x4*)(G + r * ldg + col0 + bj * HALF); if (ACCUM) ow[m][bj] = *(const u32x4*)(U + r * ldu + col0 + bj * HALF); } }
            __builtin_amdgcn_sched_barrier(0);
#pragma unroll
            for (int m = 0; m < 4; ++m) { bf16_t* up = U + (size_t)(row0 + ai * HALF + m * 16) * ldu + col0;
#pragma unroll
                for (int bj = 0; bj < 2; ++bj) { const u32x4 g4 = gw[m][bj]; f32x4 v0 = acc[ai][bj][m][0], v1 = acc[ai][bj][m][1];
                    v0[0] *= bf_lo(g4.x); v0[1] *= bf_hi(g4.x); v0[2] *= bf_lo(g4.y); v0[3] *= bf_hi(g4.y); v1[0] *= bf_lo(g4.z); v1[1] *= bf_hi(g4.z); v1[2] *= bf_lo(g4.w); v1[3] *= bf_hi(g4.w);
                    if (ACCUM) { const u32x4 o4 = ow[m][bj];
                        v0[0] += bf_lo(o4.x); v0[1] += bf_hi(o4.x); v0[2] += bf_lo(o4.y); v0[3] += bf_hi(o4.y); v1[0] += bf_lo(o4.z); v1[1] += bf_hi(o4.z); v1[2] += bf_lo(o4.w); v1[3] += bf_hi(o4.w); }
                    u32x4 w; w.x = cvt_pk_bf16(v0[0], v0[1]); w.y = cvt_pk_bf16(v0[2], v0[3]); w.z = cvt_pk_bf16(v1[0], v1[1]); w.w = cvt_pk_bf16(v1[2], v1[3]);
                    *(u32x4*)(up + bj * HALF) = w; } }
            __builtin_amdgcn_sched_barrier(0);
        }
    }
};
struct EpiY {
    static constexpr bool PERM = true, AFTER_DRAIN = false, HOOK = true; static constexpr int HOOK_T = 32;
    bf16_t* U; int ldu; const bf16_t* Zb; int ldz;
    __device__ __forceinline__ void hook(f32x4 (&acc)[2][2][4][2], const Unit& u, int, int, int, int) const {
        int t2 = threadIdx.x; asm volatile("" : "+v"(t2));
        const int wid2 = t2 >> 6, wr = wid2 >> 2, wc = wid2 & 3, fr = t2 & 15, fq = (t2 >> 4) & 3;
        const bf16_t* rp = Zb + (size_t)(u.pm * BM + wr * 64 + fr) * ZP_ + 7168 + u.pn * BM + wc * 32 + 8 * fq;
#pragma unroll
        for (int ai = 0; ai < 2; ++ai)
#pragma unroll
            for (int m2 = 0; m2 < 2; ++m2) {
                u32x4 rw[2][2];
#pragma unroll
                for (int mm = 0; mm < 2; ++mm)
#pragma unroll
                    for (int bj = 0; bj < 2; ++bj) rw[mm][bj] = *(const u32x4*)(rp + (size_t)(ai * HALF + (2 * m2 + mm) * 16) * ZP_ + bj * HALF);
                __builtin_amdgcn_sched_barrier(0);
#pragma unroll
                for (int mm = 0; mm < 2; ++mm)
#pragma unroll
                    for (int bj = 0; bj < 2; ++bj) { const u32x4 g4 = rw[mm][bj]; f32x4& v0 = acc[ai][bj][2 * m2 + mm][0]; f32x4& v1 = acc[ai][bj][2 * m2 + mm][1];
                        v0[0] *= bf_lo(g4.x); v0[1] *= bf_hi(g4.x); v0[2] *= bf_lo(g4.y); v0[3] *= bf_hi(g4.y); v1[0] *= bf_lo(g4.z); v1[1] *= bf_hi(g4.z); v1[2] *= bf_lo(g4.w); v1[3] *= bf_hi(g4.w); }
                __builtin_amdgcn_sched_barrier(0);
            }
    }
    __device__ __forceinline__ void operator()(const f32x4 (&acc)[2][2][4][2], const Unit& u, int wr, int wc, int fr, int fq) const {
        const int row0 = u.pm * BM + wr * 64 + fr, col0 = u.pn * BM + wc * 32 + 8 * fq;
#pragma unroll
        for (int ai = 0; ai < 2; ++ai) {
            u32x4 gw[4][2];
#pragma unroll
            for (int m = 0; m < 4; ++m)
#pragma unroll
                for (int bj = 0; bj < 2; ++bj) gw[m][bj] = *(const u32x4*)(Zb + (size_t)(row0 + ai * HALF + m * 16) * ldz + 9216 + col0 + bj * HALF);
            __builtin_amdgcn_sched_barrier(0);
#pragma unroll
            for (int m = 0; m < 4; ++m) { bf16_t* up = U + (size_t)(row0 + ai * HALF + m * 16) * ldu + col0;
#pragma unroll
                for (int bj = 0; bj < 2; ++bj) { const u32x4 g4 = gw[m][bj]; f32x4 v0 = acc[ai][bj][m][0], v1 = acc[ai][bj][m][1];
                    v0[0] *= bf_lo(g4.x); v0[1] *= bf_hi(g4.x); v0[2] *= bf_lo(g4.y); v0[3] *= bf_hi(g4.y); v1[0] *= bf_lo(g4.z); v1[1] *= bf_hi(g4.z); v1[2] *= bf_lo(g4.w); v1[3] *= bf_hi(g4.w);
                    u32x4 w; w.x = cvt_pk_bf16(v0[0], v0[1]); w.y = cvt_pk_bf16(v0[2], v0[3]); w.z = cvt_pk_bf16(v1[0], v1[1]); w.w = cvt_pk_bf16(v1[2], v1[3]);
                    *(u32x4*)(up + bj * HALF) = w; } }
            __builtin_amdgcn_sched_barrier(0);
        }
    }
};
struct EpiRes {
    static constexpr bool PERM = false, AFTER_DRAIN = false, HOOK = false;
    const float* base; float* out; int ldc;
    __device__ __forceinline__ void operator()(const f32x4 (&acc)[2][2][4][2], const Unit& u, int wr, int wc, int fr, int fq) const {
        const int row0 = u.pm * BM + wr * 64 + fr, col0 = u.pn * BM + wc * 32 + 4 * fq;
#pragma unroll
        for (int ai = 0; ai < 2; ++ai) {
            f32x4 bs[4][2][2];
#pragma unroll
            for (int m = 0; m < 4; ++m) { const size_t off = (size_t)(row0 + ai * HALF + m * 16) * ldc + col0;
#pragma unroll
                for (int bj = 0; bj < 2; ++bj)
#pragma unroll
                    for (int n = 0; n < 2; ++n) bs[m][bj][n] = *(const f32x4*)(base + off + bj * HALF + n * 16); }
            __builtin_amdgcn_sched_barrier(0);
#pragma unroll
            for (int m = 0; m < 4; ++m) { const size_t off = (size_t)(row0 + ai * HALF + m * 16) * ldc + col0;
#pragma unroll
                for (int bj = 0; bj < 2; ++bj)
#pragma unroll
                    for (int n = 0; n < 2; ++n) *(f32x4*)(out + off + bj * HALF + n * 16) = bs[m][bj][n] + acc[ai][bj][m][n]; }
            __builtin_amdgcn_sched_barrier(0);
        }
    }
};
struct EpiSwiGLU {
    static constexpr bool PERM = true, AFTER_DRAIN = false, HOOK = false;
    bf16_t* Hm; int ldh;
    __device__ __forceinline__ void operator()(const f32x4 (&acc)[2][2][4][2], const Unit& u, int wr, int wc, int fr, int fq) const {
        const int row0 = u.pm * BM + wr * 64 + fr, colh = u.pn * HALF + wc * 32 + 8 * fq;
#pragma unroll
        for (int ai = 0; ai < 2; ++ai)
#pragma unroll
            for (int m = 0; m < 4; ++m) { bf16_t* rowp = Hm + (size_t)(row0 + ai * HALF + m * 16) * ldh + colh;
                const f32x4 g0 = acc[ai][0][m][0], g1 = acc[ai][0][m][1], u0 = acc[ai][1][m][0], u1 = acc[ai][1][m][1];
                u32x4 w; w.x = cvt_pk_bf16(fsilu(g0[0]) * u0[0], fsilu(g0[1]) * u0[1]); w.y = cvt_pk_bf16(fsilu(g0[2]) * u0[2], fsilu(g0[3]) * u0[3]);
                w.z = cvt_pk_bf16(fsilu(g1[0]) * u1[0], fsilu(g1[1]) * u1[1]); w.w = cvt_pk_bf16(fsilu(g1[2]) * u1[2], fsilu(g1[3]) * u1[3]);
                *(u32x4*)rowp = w; }
    }
};
struct EpiBf16 {
    static constexpr bool PERM = true, AFTER_DRAIN = false, HOOK = false;
    bf16_t* O; int ldc;
    __device__ __forceinline__ void operator()(const f32x4 (&acc)[2][2][4][2], const Unit& u, int wr, int wc, int fr, int fq) const {
        const int row0 = u.pm * BM + wr * 64 + fr, col0 = u.pn * BM + wc * 32 + 8 * fq;
#pragma unroll
        for (int ai = 0; ai < 2; ++ai)
#pragma unroll
            for (int m = 0; m < 4; ++m) { bf16_t* rowp = O + (size_t)(row0 + ai * HALF + m * 16) * ldc + col0;
#pragma unroll
                for (int bj = 0; bj < 2; ++bj) { const f32x4 v0 = acc[ai][bj][m][0], v1 = acc[ai][bj][m][1];
                    u32x4 w; w.x = cvt_pk_bf16(v0[0], v0[1]); w.y = cvt_pk_bf16(v0[2], v0[3]); w.z = cvt_pk_bf16(v1[0], v1[1]); w.w = cvt_pk_bf16(v1[2], v1[3]);
                    *(u32x4*)(rowp + bj * HALF) = w; } }
    }
};

typedef int i32x8 __attribute__((ext_vector_type(8)));
typedef int i32x4 __attribute__((ext_vector_type(4)));
constexpr int FP8_WSCALE = 127 - 6;
__device__ __forceinline__ i32x8 pg8_cat(const bf16x8& a, const bf16x8& b) { return __builtin_shufflevector(__builtin_bit_cast(i32x4, a), __builtin_bit_cast(i32x4, b), 0, 1, 2, 3, 4, 5, 6, 7); }
__device__ __forceinline__ unsigned pk4_fp8(float a, float b, float c, float d) { int w = __builtin_amdgcn_cvt_pk_fp8_f32(a, b, 0, false); w = __builtin_amdgcn_cvt_pk_fp8_f32(c, d, w, true); return (unsigned)w; }
struct EpiSwiGLU8 {
    static constexpr bool PERM = true, AFTER_DRAIN = false, HOOK = false;
    unsigned char* Hm; int ldh;
    __device__ __forceinline__ void operator()(const f32x4 (&acc)[2][2][4][2], const Unit& u, int wr, int wc, int fr, int fq) const {
        const int row0 = u.pm * BM + wr * 64 + fr, colh = u.pn * HALF + wc * 32 + 8 * fq;
#pragma unroll
        for (int ai = 0; ai < 2; ++ai)
#pragma unroll
            for (int m = 0; m < 4; ++m) { unsigned char* rowp = Hm + (size_t)(row0 + ai * HALF + m * 16) * ldh + colh;
                const f32x4 g0 = acc[ai][0][m][0], g1 = acc[ai][0][m][1], u0 = acc[ai][1][m][0], u1 = acc[ai][1][m][1];
                u32x2 w; w.x = pk4_fp8(fsilu(g0[0]) * u0[0], fsilu(g0[1]) * u0[1], fsilu(g0[2]) * u0[2], fsilu(g0[3]) * u0[3]);
                w.y = pk4_fp8(fsilu(g1[0]) * u1[0], fsilu(g1[1]) * u1[1], fsilu(g1[2]) * u1[2], fsilu(g1[3]) * u1[3]);
                *(u32x2*)rowp = w; }
    }
};

struct EpiPoolW {
    static constexpr bool PERM = true, AFTER_DRAIN = false, HOOK = false;
    bf16_t* O;
    __device__ __forceinline__ void operator()(const f32x4 (&acc)[2][2][4][2], const Unit& u, int wr, int wc, int fr, int fq) const {
        const int l = u.pm >> 5, g = (u.pm >> 3) & 3, np = u.pm & 7;
        const int row0 = np * BM + wr * 64 + fr, col0 = 2048 + 256 * g + wc * 32 + 8 * fq;
        bf16_t* base = O + (size_t)l * 2048 * 3072;
#pragma unroll
        for (int ai = 0; ai < 2; ++ai)
#pragma unroll
            for (int m = 0; m < 4; ++m) { bf16_t* rowp = base + (size_t)(row0 + ai * HALF + m * 16) * 3072 + col0;
#pragma unroll
                for (int bj = 0; bj < 2; ++bj) { const f32x4 v0 = acc[ai][bj][m][0], v1 = acc[ai][bj][m][1];
                    u32x4 w; w.x = cvt_pk_bf16(v0[0], v0[1]); w.y = cvt_pk_bf16(v0[2], v0[3]); w.z = cvt_pk_bf16(v1[0], v1[1]); w.w = cvt_pk_bf16(v1[2], v1[3]);
                    *(u32x4*)(rowp + bj * HALF) = w; } }
    }
};

template <class Epi, class Sched, bool ALIGN_EPI = false, bool SP2 = false, bool FP8 = false>
__device__ __forceinline__ void gemm_phase(PG8_LAS unsigned char* lds, const Gemm g, const Sched& S, const Epi& E) {
    int tid_ = threadIdx.x; asm volatile("" : "+v"(tid_));
    const int tid = tid_, wid = __builtin_amdgcn_readfirstlane(tid >> 6), lane = tid & 63, wr = wid >> 2, wc = wid & 3, fr = lane & 15, fq = lane >> 4;
    const int K = g.K, nt = K / BK;
    unsigned voffA[2], voffB[2];
#pragma unroll
    for (int i = 0; i < 2; ++i) { int R, C; stage_rc(tid * 16 + i * 8192, R, C); const int Rb = Epi::PERM ? ((R & ~31) + perm32(R & 31)) : R;
        voffA[i] = (unsigned)(R * g.lda + C) * 2u; voffB[i] = (unsigned)(Rb * g.ldb + C) * 2u; }
    const size_t kstep = (size_t)(BK * 2);
    const size_t hstepA = (size_t)HALF * g.lda * 2, hstepB = (size_t)HALF * g.ldb * 2;
    const size_t tstepA = 2 * hstepA, tstepB = 2 * hstepB;
    const unsigned ldsw = (unsigned)wid * 1024u;
    const int aoff = lds_byte(wr * 64 + fr, fq * 8), boff = lds_byte(wc * 32 + fr, fq * 8);
#define PG8_SA(b, h) (((b) * 2 + (h)) * HTB)
#define PG8_SB(b, h) ((4 + (b) * 2 + (h)) * HTB)
#define PG8_STAGE(bufoff, gbase, voff) do { _Pragma("unroll") for (int _i = 0; _i < 2; ++_i) \
        __builtin_amdgcn_global_load_lds((const unsigned*)((const char*)(gbase) + (voff)[_i]), (PG8_LAS unsigned*)(lds + (bufoff) + ldsw + _i * 8192), 16, 0, 0); } while (0)
#define PG8_LDA(dst, b, h) do { if constexpr (FP8) { _Pragma("unroll") for (int m = 0; m < 4; ++m) { dst##8[m].lo = *(const PG8_LAS i32x4*)(lds + PG8_SA(b, h) + aoff + m * 2048); dst##8[m].hi = *(const PG8_LAS i32x4*)(lds + PG8_SA(b, h) + aoff + m * 2048 + 1024); } } \
        else { _Pragma("unroll") for (int m = 0; m < 4; ++m) _Pragma("unroll") for (int k = 0; k < 2; ++k) dst[m][k] = *(const PG8_LAS bf16x8*)(lds + PG8_SA(b, h) + aoff + m * 2048 + k * 1024); } } while (0)
#define PG8_LDB(dst, b, h) do { if constexpr (FP8) { _Pragma("unroll") for (int n = 0; n < 2; ++n) { dst##8[n].lo = *(const PG8_LAS i32x4*)(lds + PG8_SB(b, h) + boff + n * 2048); dst##8[n].hi = *(const PG8_LAS i32x4*)(lds + PG8_SB(b, h) + boff + n * 2048 + 1024); } } \
        else { _Pragma("unroll") for (int n = 0; n < 2; ++n) _Pragma("unroll") for (int k = 0; k < 2; ++k) dst[n][k] = *(const PG8_LAS bf16x8*)(lds + PG8_SB(b, h) + boff + n * 2048 + k * 1024); } } while (0)
#define PG8_MMA(ai, bj, At, Bt) do { __builtin_amdgcn_s_setprio(1); \
        if constexpr (FP8) { _Pragma("unroll") for (int m = 0; m < 4; ++m) _Pragma("unroll") for (int n = 0; n < 2; ++n) \
            asm volatile("v_mfma_scale_f32_16x16x128_f8f6f4 %0, %1, %2, %0, %3, %4 op_sel_hi:[0,0,0]" : "+v"(acc[ai][bj][m][n]) : "v"(Bt##8[n]), "v"(At##8[m]), "v"(fp8_sw), "v"(fp8_sa)); } \
        else { _Pragma("unroll") for (int m = 0; m < 4; ++m) _Pragma("unroll") for (int n = 0; n < 2; ++n) _Pragma("unroll") for (int k = 0; k < 2; ++k) \
            acc[ai][bj][m][n] = __builtin_amdgcn_mfma_f32_16x16x32_bf16(Bt[n][k], At[m][k], acc[ai][bj][m][n], 0, 0, 0); } \
        __builtin_amdgcn_s_setprio(0); } while (0)
#define PG8_WAIT_V(n) asm volatile("s_waitcnt vmcnt(" #n ")" ::: "memory")
#define PG8_WAIT_L(n) asm volatile("s_waitcnt lgkmcnt(" #n ")" ::: "memory")
#define PG8_BAR __builtin_amdgcn_s_barrier()
#define PG8_SCHED __builtin_amdgcn_sched_barrier(0)
    Unit cur, nxt; int ui = 0;
    if (!S.next(0, cur)) return;
    f32x4 acc[2][2][4][2];
#pragma unroll
    for (int a = 0; a < 2; ++a)
#pragma unroll
        for (int b = 0; b < 2; ++b)
#pragma unroll
            for (int m = 0; m < 4; ++m)
#pragma unroll
                for (int n = 0; n < 2; ++n) acc[a][b][m][n] = (f32x4){0.f, 0.f, 0.f, 0.f};
    bf16x8 At[4][2], B0[2][2], B1[2][2]; i32x8 At8[4], B08[2], B18[2]; const int fp8_sw = FP8_WSCALE, fp8_sa = 127;
    const char* cA = (const char*)g.A + (size_t)cur.pm * tstepA; const char* cB = (const char*)g.Bt + (size_t)cur.be * g.bstride + (size_t)cur.pn * tstepB;
    S.a_ready(cur);
    if constexpr (SP2) {
        PG8_STAGE(PG8_SB(0, 0), cB, voffB); PG8_STAGE(PG8_SB(0, 1), cB + hstepB, voffB); PG8_STAGE(PG8_SA(0, 0), cA, voffA); PG8_STAGE(PG8_SA(0, 1), cA + hstepA, voffA);
        if (wr == 1) PG8_BAR;
        PG8_WAIT_V(2); PG8_BAR;
        PG8_STAGE(PG8_SB(1, 0), cB + kstep, voffB); PG8_STAGE(PG8_SA(1, 0), cA + kstep, voffA); PG8_STAGE(PG8_SB(1, 1), cB + hstepB + kstep, voffB);
        PG8_WAIT_V(6); PG8_BAR;
    } else {
        PG8_STAGE(PG8_SB(0, 0), cB, voffB); PG8_STAGE(PG8_SA(0, 0), cA, voffA); PG8_STAGE(PG8_SB(0, 1), cB + hstepB, voffB); PG8_STAGE(PG8_SA(0, 1), cA + hstepA, voffA);
        if (wr == 1) PG8_BAR;
        PG8_WAIT_V(4); PG8_BAR;
        PG8_STAGE(PG8_SB(1, 0), cB + kstep, voffB); PG8_STAGE(PG8_SA(1, 0), cA + kstep, voffA); PG8_STAGE(PG8_SB(1, 1), cB + hstepB + kstep, voffB);
        PG8_WAIT_V(6); PG8_BAR;
    }
    for (;;) {
        const bool has_next = S.next(ui + 1, nxt);
        const char* nA = has_next ? (const char*)g.A + (size_t)nxt.pm * tstepA : cA; const char* nB = has_next ? (const char*)g.Bt + (size_t)nxt.be * g.bstride + (size_t)nxt.pn * tstepB : cB;
        for (int t = 0; t < nt; t += 2) {
            if constexpr (Epi::HOOK) { if (t == Epi::HOOK_T) E.hook(acc, cur, wr, wc, fr, fq); }
            const bool last = (t == nt - 2);
            const char* a1 = cA + (size_t)(t + 1) * kstep;
            const char* a2 = last ? nA : cA + (size_t)(t + 2) * kstep; const char* b2 = last ? nB : cB + (size_t)(t + 2) * kstep;
            const char* a3 = a2 + kstep; const char* b3 = b2 + kstep;
            if (last && has_next) S.a_ready(nxt);
            if constexpr (SP2) {
            PG8_LDB(B0, 0, 0); PG8_LDB(B1, 0, 1); PG8_SCHED; PG8_LDA(At, 0, 0); PG8_STAGE(PG8_SA(1, 1), a1 + hstepA, voffA);
            PG8_WAIT_V(8); PG8_WAIT_L(0); PG8_BAR; PG8_MMA(0, 0, At, B0); PG8_MMA(0, 1, At, B1); PG8_BAR; PG8_SCHED;
            PG8_LDA(At, 0, 1); PG8_STAGE(PG8_SB(0, 0), b2, voffB); PG8_STAGE(PG8_SB(0, 1), b2 + hstepB, voffB); PG8_STAGE(PG8_SA(0, 0), a2, voffA);
            PG8_WAIT_V(8); PG8_WAIT_L(0); PG8_BAR; PG8_MMA(1, 0, At, B0); PG8_MMA(1, 1, At, B1); PG8_BAR; PG8_SCHED;
            PG8_LDB(B0, 1, 0); PG8_LDB(B1, 1, 1); PG8_SCHED; PG8_LDA(At, 1, 0); PG8_STAGE(PG8_SA(0, 1), a2 + hstepA, voffA);
            PG8_WAIT_V(8); PG8_WAIT_L(0); PG8_BAR; PG8_MMA(0, 0, At, B0); PG8_MMA(0, 1, At, B1); PG8_BAR; PG8_SCHED;
            PG8_LDA(At, 1, 1); PG8_STAGE(PG8_SB(1, 0), b3, voffB); PG8_STAGE(PG8_SB(1, 1), b3 + hstepB, voffB); PG8_STAGE(PG8_SA(1, 0), a3, voffA);
            PG8_WAIT_V(8); PG8_WAIT_L(0); PG8_BAR; PG8_MMA(1, 0, At, B0); PG8_MMA(1, 1, At, B1); PG8_BAR; PG8_SCHED;
            } else {
            PG8_LDB(B0, 0, 0); PG8_SCHED; PG8_LDA(At, 0, 0); PG8_STAGE(PG8_SA(1, 1), a1 + hstepA, voffA);
            PG8_WAIT_L(8); PG8_BAR; PG8_WAIT_L(0); PG8_MMA(0, 0, At, B0); PG8_BAR; PG8_SCHED;
            PG8_LDB(B1, 0, 1); PG8_STAGE(PG8_SB(0, 0), b2, voffB);
            PG8_BAR; PG8_WAIT_L(0); PG8_MMA(0, 1, At, B1); PG8_BAR;
            PG8_LDA(At, 0, 1); PG8_STAGE(PG8_SA(0, 0), a2, voffA);
            PG8_BAR; PG8_WAIT_L(0); PG8_MMA(1, 0, At, B0); PG8_BAR; PG8_SCHED;
            PG8_STAGE(PG8_SB(0, 1), b2 + hstepB, voffB);
            PG8_WAIT_V(6); PG8_BAR; PG8_MMA(1, 1, At, B1); PG8_BAR;
            PG8_LDB(B0, 1, 0); PG8_SCHED; PG8_LDA(At, 1, 0); PG8_STAGE(PG8_SA(0, 1), a2 + hstepA, voffA);
            PG8_WAIT_L(8); PG8_BAR; PG8_WAIT_L(0); PG8_MMA(0, 0, At, B0); PG8_BAR; PG8_SCHED;
            PG8_LDB(B1, 1, 1); PG8_STAGE(PG8_SB(1, 0), b3, voffB);
            PG8_BAR; PG8_WAIT_L(0); PG8_MMA(0, 1, At, B1); PG8_BAR;
            PG8_LDA(At, 1, 1); PG8_STAGE(PG8_SA(1, 0), a3, voffA);
            PG8_BAR; PG8_WAIT_L(0); PG8_MMA(1, 0, At, B0); PG8_BAR; PG8_SCHED;
            PG8_STAGE(PG8_SB(1, 1), b3 + hstepB, voffB);
            PG8_WAIT_V(6); PG8_BAR; PG8_MMA(1, 1, At, B1); PG8_BAR;
            }
        }
        if constexpr (FP8) asm volatile("s_nop 15\n\ts_nop 15" ::: "memory");
        if constexpr (ALIGN_EPI) { if (wr == 0) PG8_BAR; }
        if constexpr (!Epi::AFTER_DRAIN) { E(acc, cur, wr, wc, fr, fq); S.done(cur); }
        if (!has_next) break;
#pragma unroll
        for (int a = 0; a < 2; ++a)
#pragma unroll
            for (int b = 0; b < 2; ++b)
#pragma unroll
                for (int m = 0; m < 4; ++m)
#pragma unroll
                    for (int n = 0; n < 2; ++n) acc[a][b][m][n] = (f32x4){0.f, 0.f, 0.f, 0.f};
        cur = nxt; cA = nA; cB = nB; ++ui;
        if constexpr (ALIGN_EPI) { if (wr == 1) PG8_BAR; }
    }
    PG8_WAIT_V(0);
    if constexpr (!ALIGN_EPI) { if (wr == 0) PG8_BAR; }
    PG8_BAR;
    if constexpr (Epi::AFTER_DRAIN) { E.fused(acc, cur, wr, wc, fr, fq, lds, wid, lane); S.done(cur); }
#undef PG8_SA
#undef PG8_SB
#undef PG8_STAGE
#undef PG8_LDA
#undef PG8_LDB
#undef PG8_MMA
#undef PG8_WAIT_V
#undef PG8_WAIT_L
#undef PG8_BAR
#undef PG8_SCHED
}
}

#ifndef DENSE_FP8
#define DENSE_FP8 0
#endif
constexpr int NWAVES = 8;
constexpr int BATCH = 2, SEQ = 8192, M = BATCH * SEQ, D = 2048, NH = 4, HK = 256, HV = 512, PW = 1024, DFF = 5632, NE = 8, DIN = 11280;
constexpr int ZN = 12288;
constexpr int ZP = 11264;
constexpr int ZC_Q = 0, ZC_K = 1024, ZC_V = 2048, ZC_R = 4096, ZC_P = 6144, ZC_GA = 7168, ZC_GB = 9216;
constexpr int KCAT = 3072;
constexpr int FFN = 2 * DFF;
constexpr int MAXSLOT = 2 * M + NE * 256;
constexpr float EPS = 1e-6f;
static_assert(pg8::ZP_ == ZP, "pitch");

constexpr size_t MiB = 1u << 20;
constexpr size_t WS_CTL = 0, CTL_ZERO_BYTES = 65536;
constexpr size_t WS_TOKSLOT = 1 * MiB, WS_WSLOT = 1 * MiB + 256 * 1024, WS_TOKE = 2 * MiB, WS_TOKW = 2 * MiB + 256 * 1024;
constexpr size_t WS_WIN = 4 * MiB, WS_BCAT = 100 * MiB, WS_WOUT = 124 * MiB, WS_FF1 = 140 * MiB, WS_FF2 = 184 * MiB, WS_EF1 = 206 * MiB, WS_EF2 = 558 * MiB;
constexpr size_t WS_HB = 734 * MiB, WS_ZB = 798 * MiB, WS_LA = 1172 * MiB, WS_OF = 1236 * MiB, WS_ACAT = 1364 * MiB, WS_U = 1460 * MiB, WS_END = 1524 * MiB;
constexpr size_t WS_HMID = WS_ZB, WS_HPERM = WS_ACAT;
static_assert(WS_WIN + 2 * (size_t)ZN * D * 2 <= WS_BCAT && WS_BCAT + 2 * (size_t)D * KCAT * 2 <= WS_WOUT && WS_WOUT + 2 * (size_t)D * D * 2 <= WS_FF1, "ws map 1");
static_assert(WS_FF1 + (size_t)FFN * D * 2 <= WS_FF2 && WS_FF2 + (size_t)D * DFF * 2 <= WS_EF1 && WS_EF1 + 8 * (size_t)FFN * D * 2 <= WS_EF2 && WS_EF2 + 8 * (size_t)D * DFF * 2 <= WS_HB, "ws map 2");
static_assert(WS_HB + (size_t)M * D * 2 <= WS_ZB && WS_ZB + (size_t)M * ZP * 2 <= WS_LA && WS_HMID + (size_t)MAXSLOT * DFF * 2 <= WS_LA && WS_LA + (size_t)M * 1024 * 4 <= WS_OF, "ws map 3");
static_assert(WS_OF + (size_t)M * D * 4 <= WS_ACAT && WS_ACAT + (size_t)M * KCAT * 2 <= WS_U && WS_U + (size_t)M * D * 2 <= WS_END && WS_HPERM + (size_t)MAXSLOT * D * 2 <= WS_END, "ws map 4");
static_assert((size_t)MAXSLOT * 4 <= 256 * 1024 && (size_t)M * 2 * 4 <= 256 * 1024, "ctl tables");
constexpr int CW_TMO = 0, CW_CODE = 1, CW_BAR = 4096, CW_CNT = 8192, CW_FILL = 8256;

constexpr int RING_OFF = 0, RING_BYTES = 131072;
constexpr int LDSCTL_OFF = RING_BYTES, MISC_OFF = LDSCTL_OFF + 320;
constexpr int LDS_BYTES = 147456;

#define GAS __attribute__((address_space(1)))
#define LAS __attribute__((address_space(3)))
typedef unsigned short bf16;
typedef unsigned v4u __attribute__((ext_vector_type(4)));
typedef unsigned v2u __attribute__((ext_vector_type(2)));
typedef float f32x4 __attribute__((ext_vector_type(4)));
typedef GAS unsigned gu32;
#define RLX_AGENT __ATOMIC_RELAXED, __HIP_MEMORY_SCOPE_AGENT
#define LDS_WAIT() asm volatile("s_waitcnt lgkmcnt(0)" ::: "memory")
#define VM_WAIT() asm volatile("s_waitcnt vmcnt(0)" ::: "memory")
__device__ __forceinline__ unsigned f2bf(float f) { unsigned u = __builtin_bit_cast(unsigned, f); return (u + 0x7fffu + ((u >> 16) & 1u)) >> 16; }
__device__ __forceinline__ unsigned pk2(float lo, float hi) { return f2bf(lo) | (f2bf(hi) << 16); }
__device__ __forceinline__ float bfl(unsigned w) { return __uint_as_float(w << 16); }
__device__ __forceinline__ float bfh(unsigned w) { return __uint_as_float(w & 0xffff0000u); }
__device__ __forceinline__ float wave_sum(float v) {
#pragma unroll
    for (int o = 1; o < 64; o <<= 1) v += __shfl_xor(v, o);
    return v;
}
typedef __bf16 gl_bf2 __attribute__((ext_vector_type(2)));
typedef float gl_f2 __attribute__((ext_vector_type(2)));
__device__ __forceinline__ unsigned pkbf(float lo, float hi) { gl_f2 v = {lo, hi}; return __builtin_bit_cast(unsigned, __builtin_convertvector(v, gl_bf2)); }
__device__ __forceinline__ int opq(int x) { asm volatile("" : "+v"(x)); return x; }
#define XB_TMO      128
#define XB_XCNT(j)  (256  + 64 * (j))
#define XB_XSUB(j)  (1280 + 64 * (j))
#define XB_XGEN(j)  (2304 + 64 * (j))
#define XB_TOP      3328
#define XB_TOPGEN   3392
#define XCD_BAR_WORDS 3456
#define XB_SPIN_CAP (1u << 18)

__device__ __forceinline__ unsigned xb_ld(unsigned* p)              { return __hip_atomic_load(p, __ATOMIC_RELAXED, __HIP_MEMORY_SCOPE_AGENT); }
__device__ __forceinline__ unsigned xb_add(unsigned* p, unsigned v) { return __hip_atomic_fetch_add(p, v, __ATOMIC_RELAXED, __HIP_MEMORY_SCOPE_AGENT); }
__device__ __forceinline__ unsigned xb_xcc_id() { return (unsigned)__builtin_amdgcn_s_getreg((3 << 11) | 20) & 0xFu; }
#define XB_SPIN(cond, bar) do { unsigned _sp = 0; while (cond) { __builtin_amdgcn_s_sleep(1); \
    if ((++_sp & 255u) == 0u) { if (xb_ld(&(bar)[XB_TMO])) break; if (_sp > XB_SPIN_CAP) { atomicAdd(&(bar)[XB_TMO], 1u); break; } } } } while (0)

struct XcdBarrier {
    unsigned* bar; unsigned x;
    volatile LAS unsigned* st;
};

__device__ __forceinline__ XcdBarrier xcd_barrier_post(unsigned* bar, volatile LAS unsigned* st) {
    XcdBarrier b; b.bar = bar; b.x = xb_xcc_id(); b.st = st;
    if (threadIdx.x == 0) (void)xb_add(&bar[XB_XCNT(b.x)], 1u);
    return b;
}
__device__ __forceinline__ void xcd_barrier_complete(unsigned* bar, unsigned x, unsigned& nloc, unsigned& nx) {
    const unsigned G = gridDim.x * gridDim.y * gridDim.z;
    unsigned sum, cnt, mine, sp = 0u;
    for (;;) {
        sum = 0u; cnt = 0u; mine = 0u;
#pragma unroll
        for (unsigned j = 0; j < 16; ++j) { const unsigned c = xb_ld(&bar[XB_XCNT(j)]); sum += c; cnt += (c > 0u) ? 1u : 0u; mine = (j == x) ? c : mine; }
        if (sum == G) break;
        __builtin_amdgcn_s_sleep(1);
        if ((++sp & 255u) == 0u) { if (xb_ld(&bar[XB_TMO])) break; if (sp > XB_SPIN_CAP) { atomicAdd(&bar[XB_TMO], 1u); break; } }
    }
    nloc = mine > 0u ? mine : 1u; nx = cnt > 0u ? cnt : 1u;
}

__device__ __forceinline__ void xcd_barrier(const XcdBarrier& b) {
    asm volatile("s_waitcnt vmcnt(0)" ::: "memory");
    __syncthreads();
    if (threadIdx.x == 0) {
        unsigned* bar = b.bar;
        __builtin_amdgcn_s_waitcnt(0);
        unsigned nloc = b.st[0], nx = b.st[1];
        if (nloc == 0u) { xcd_barrier_complete(bar, b.x, nloc, nx); b.st[0] = nloc; b.st[1] = nx; }
        const unsigned old = xb_add(&bar[XB_XSUB(b.x)], 1u);
        const unsigned gen = old / nloc;
        if (old + 1u == (gen + 1u) * nloc) {
            __builtin_amdgcn_fence(__ATOMIC_RELEASE, "agent");
            asm volatile("s_waitcnt vmcnt(0)" ::: "memory");
            const unsigned og = xb_add(&bar[XB_TOP], 1u);
            const unsigned tg = og / nx;
            if (og + 1u == (tg + 1u) * nx) xb_add(&bar[XB_TOPGEN], 1u);
            else XB_SPIN(xb_ld(&bar[XB_TOPGEN]) == tg, bar);
            __builtin_amdgcn_fence(__ATOMIC_ACQUIRE, "agent");
            xb_add(&bar[XB_XGEN(b.x)], 1u);
            asm volatile("s_waitcnt vmcnt(0)" ::: "memory");
        } else {
            XB_SPIN(xb_ld(&bar[XB_XGEN(b.x)]) == gen, bar);
            __builtin_amdgcn_fence(__ATOMIC_ACQUIRE, "agent");
            asm volatile("s_waitcnt vmcnt(0)" ::: "memory");
        }
    }
    __syncthreads();
}

struct TrJob { const float* src; unsigned char* dst; int ldw, ldt, k0, n0, mode, row_off, kind; };
__device__ __forceinline__ int tr_drow(int nn, int mode, int row_off) {
    if (mode == 2) { if (nn < 1024) return 6144 + nn; const int m = nn - 1024, n = m & 2047; return 7168 + 256 * (n >> 7) + 128 * (m >> 11) + (n & 127); }
    return mode ? (256 * (nn >> 7) + (nn & 127) + row_off) : (row_off + nn); }
__device__ __forceinline__ void tr_load(const TrJob& J, f32x4 (&R)[16], int lane) {
    if (J.kind == 0) { const int nq = lane & 15, kr = lane >> 4; const float* b = J.src + (size_t)(4 * kr) * J.ldw + 4 * nq;
#pragma unroll
        for (int jq = 0; jq < 4; ++jq)
#pragma unroll
            for (int x = 0; x < 4; ++x) R[4 * jq + x] = __builtin_nontemporal_load((const GAS f32x4*)(b + (size_t)(16 * jq + x) * J.ldw));
    } else { const int nq = lane & 7, kr = lane >> 3; const float* b = J.src + (size_t)(4 * kr) * J.ldw + 4 * nq;
#pragma unroll
        for (int jq = 0; jq < 4; ++jq)
#pragma unroll
            for (int x = 0; x < 4; ++x) R[4 * jq + x] = __builtin_nontemporal_load((const GAS f32x4*)(b + (size_t)(32 * jq + x) * J.ldw)); }
}
__device__ __forceinline__ void tr_finish(const TrJob& J, const f32x4 (&R)[16], LAS unsigned* T, int lane, int nostore) {
    if (J.kind == 0) { const int nq = lane & 15, kr = lane >> 4;
#pragma unroll
        for (int jq = 0; jq < 4; ++jq)
#pragma unroll
            for (int i = 0; i < 4; ++i) { T[(4 * nq + i) * 33 + 8 * jq + 2 * kr] = pkbf(R[4 * jq][i], R[4 * jq + 1][i]); T[(4 * nq + i) * 33 + 8 * jq + 2 * kr + 1] = pkbf(R[4 * jq + 2][i], R[4 * jq + 3][i]); }
        LDS_WAIT(); asm volatile("" ::: "memory");
#pragma unroll
        for (int r = 0; r < 8; ++r) { const int t = lane + 64 * r, n = t >> 3, c = t & 7; const LAS unsigned* s = T + n * 33 + 4 * c;
            v4u o; o.x = s[0]; o.y = s[1]; o.z = s[2]; o.w = s[3];
            if (!nostore || o.x == 0x12345678u) *(GAS v4u*)(J.dst + (size_t)tr_drow(J.n0 + n, J.mode, J.row_off) * J.ldt + 2 * J.k0 + 16 * c) = o; }
    } else { const int nq = lane & 7, kr = lane >> 3;
#pragma unroll
        for (int jq = 0; jq < 4; ++jq)
#pragma unroll
            for (int i = 0; i < 4; ++i) T[(4 * nq + i) * 33 + 8 * jq + kr] = pg8::pk4_fp8(R[4 * jq][i] * 64.0f, R[4 * jq + 1][i] * 64.0f, R[4 * jq + 2][i] * 64.0f, R[4 * jq + 3][i] * 64.0f);
        LDS_WAIT(); asm volatile("" ::: "memory");
#pragma unroll
        for (int r = 0; r < 4; ++r) { const int t = lane + 64 * r, n = t >> 3, c = t & 7; const LAS unsigned* s = T + n * 33 + 4 * c;
            v4u o; o.x = s[0]; o.y = s[1]; o.z = s[2]; o.w = s[3];
            if (!nostore || o.x == 0x12345678u) *(GAS v4u*)(J.dst + (size_t)tr_drow(J.n0 + n, J.mode, J.row_off) * J.ldt + J.k0 + 16 * c) = o; } }
    LDS_WAIT(); asm volatile("" ::: "memory");
}

template <bool ROUTE, bool OUT8 = false>
__device__ __forceinline__ void norm_rows(const float* X, const float* gain, bf16* out, int gw, int NGW, int lane0,
                                          const LAS float* rw, int* tok_e, float* tok_w, LAS unsigned* hist) {
    const int lane = opq(lane0);
    f32x4 nx[8], gv[8];
#pragma unroll
    for (int j = 0; j < 8; ++j) gv[j] = ((const GAS f32x4*)gain)[lane + 64 * j];
    if (gw < M) { const GAS f32x4* xr = (const GAS f32x4*)(X + (size_t)gw * D) + lane;
#pragma unroll
        for (int j = 0; j < 8; ++j) nx[j] = xr[64 * j]; }
    for (int m = gw; m < M; m += NGW) {
        f32x4 v[8]; float s = 0.f;
#pragma unroll
        for (int j = 0; j < 8; ++j) { v[j] = nx[j]; s += (v[j].x * v[j].x + v[j].y * v[j].y) + (v[j].z * v[j].z + v[j].w * v[j].w); }
        if (m + NGW < M) { const GAS f32x4* xr = (const GAS f32x4*)(X + (size_t)(m + NGW) * D) + lane;
#pragma unroll
            for (int j = 0; j < 8; ++j) nx[j] = xr[64 * j]; }
        const float rstd = 1.0f / sqrtf(wave_sum(s) * (1.0f / D) + EPS);
        GAS unsigned long long* o8 = (GAS unsigned long long*)(out + (size_t)m * D) + lane;
#pragma unroll
        for (int j = 0; j < 8; ++j) { const f32x4 g4 = gv[j]; v[j] = v[j] * rstd * g4;
            if (OUT8) ((GAS unsigned*)((unsigned char*)out + (size_t)m * D))[lane + 64 * j] = pg8::pk4_fp8(v[j].x, v[j].y, v[j].z, v[j].w);
            else o8[64 * j] = (unsigned long long)pk2(v[j].x, v[j].y) | ((unsigned long long)pk2(v[j].z, v[j].w) << 32); }
        if (ROUTE) {
            float lg[8];
#pragma unroll
            for (int e = 0; e < 8; ++e) lg[e] = 0.f;
#pragma unroll
            for (int j = 0; j < 8; ++j) {
                f32x4 r0[4], r1[4];
#pragma unroll
                for (int i = 0; i < 4; ++i) { const int k = 4 * (lane + 64 * j) + i; r0[i] = *(const LAS f32x4*)(rw + k * 8); r1[i] = *(const LAS f32x4*)(rw + k * 8 + 4); }
                __builtin_amdgcn_sched_barrier(0);
#pragma unroll
                for (int i = 0; i < 4; ++i) { const float hv = v[j][i];
                    lg[0] += hv * r0[i].x; lg[1] += hv * r0[i].y; lg[2] += hv * r0[i].z; lg[3] += hv * r0[i].w; lg[4] += hv * r1[i].x; lg[5] += hv * r1[i].y; lg[6] += hv * r1[i].z; lg[7] += hv * r1[i].w; }
                __builtin_amdgcn_sched_barrier(0);
            }
#pragma unroll
            for (int e = 0; e < 8; ++e) lg[e] = wave_sum(lg[e]);
            float v1 = lg[0]; int i1 = 0;
#pragma unroll
            for (int e = 1; e < 8; ++e) if (lg[e] > v1) { v1 = lg[e]; i1 = e; }
            float v2 = -3.0e38f; int i2 = 0;
#pragma unroll
            for (int e = 0; e < 8; ++e) if (e != i1 && lg[e] > v2) { v2 = lg[e]; i2 = e; }
            const float ex = __expf(v2 - v1), w1 = 1.0f / (1.0f + ex), w2 = ex * w1;
            if (lane == 0) { tok_e[2 * m] = i1; tok_e[2 * m + 1] = i2; tok_w[2 * m] = w1; tok_w[2 * m + 1] = w2;
                __hip_atomic_fetch_add(hist + i1, 1u, __ATOMIC_RELAXED, __HIP_MEMORY_SCOPE_WORKGROUP); __hip_atomic_fetch_add(hist + i2, 1u, __ATOMIC_RELAXED, __HIP_MEMORY_SCOPE_WORKGROUP); }
        }
    }
}


typedef short gl_bf16x8 __attribute__((ext_vector_type(8)));
typedef short gl_s16x4 __attribute__((ext_vector_type(4)));
__device__ __forceinline__ unsigned off_q(unsigned row, unsigned ch) { return 512u * row + 16u * (ch ^ (row & 15u)); }
__device__ __forceinline__ unsigned off_a(unsigned row, unsigned ch) { return 128u * row + 16u * (ch ^ (row & 7u)); }
__device__ __forceinline__ unsigned off_b(unsigned row, unsigned ch) { return 256u * row + 16u * (ch ^ (((row & 3u) << 2) | ((row >> 2) & 3u))); }
__device__ __forceinline__ gl_bf16x8 tr_frag(unsigned base, unsigned lane, unsigned c) {
    const unsigned g = lane >> 4, q = (lane & 15u) >> 2, p = lane & 3u;
    const unsigned a0 = base + off_b(8u * g + q, 2u * c + (p >> 1)) + 8u * (p & 1u), a1 = base + off_b(8u * g + 4u + q, 2u * c + (p >> 1)) + 8u * (p & 1u);
    const gl_s16x4 lo = __builtin_amdgcn_ds_read_tr16_b64_v4i16((LAS gl_s16x4*)a0), hi = __builtin_amdgcn_ds_read_tr16_b64_v4i16((LAS gl_s16x4*)a1);
    return __builtin_shufflevector(lo, hi, 0, 1, 2, 3, 4, 5, 6, 7);
}
#define GLA_MFMA(a, b, c) __builtin_amdgcn_mfma_f32_16x16x32_bf16((a), (b), (c), 0, 0, 0)
constexpr int GLA_NSEG = 8, GLA_CPS = 16;
constexpr int GL_QT = 0, GL_KE = 32768, GL_V = 65536, GL_ATT = 81920, GL_DEC = 90112;

__device__ __forceinline__ void gla_g0(LAS unsigned char* lds, bf16* Zb, const bf16* Hb, const bf16* WA1T, const float* w_alpha, const float* b_alpha, bf16* ATT, float* DEC, int bx, int G, int tid0, int lane0, int wave) {
    const int tid = opq(tid0), lane = tid & 63; (void)lane0;
    LAS float* sB = (LAS float*)lds; LAS unsigned char* sQ = lds + 65536; LAS unsigned char* sK = lds + 98304;
    LAS float* sP = (LAS float*)(lds + 65536);
    LAS float* sA1 = (LAS float*)(lds + 131072 + 1024);
    const unsigned li = lane & 15, g = lane >> 4;
    for (int uc = bx; uc < 256; uc += G) {
        const int b = uc >> 7, c = uc & 127; const size_t row0 = (size_t)b * SEQ + (size_t)c * 64;
        __syncthreads();
        { f32x4 pa[4];
#pragma unroll
            for (int mt = 0; mt < 4; ++mt) pa[mt] = (f32x4){0.f, 0.f, 0.f, 0.f};
#pragma unroll
            for (int s2 = 0; s2 < 4; ++s2) { gl_bf16x8 bf[2], af[2][4];
#pragma unroll
                for (int ss = 0; ss < 2; ++ss) { const int s = 8 * wave + 2 * s2 + ss; bf[ss] = *(const GAS gl_bf16x8*)(WA1T + (size_t)li * D + 32 * s + 8 * g);
#pragma unroll
                    for (int mt = 0; mt < 4; ++mt) af[ss][mt] = *(const GAS gl_bf16x8*)(Hb + (row0 + 16 * mt + li) * D + 32 * s + 8 * g); }
#pragma unroll
                for (int ss = 0; ss < 2; ++ss)
#pragma unroll
                    for (int mt = 0; mt < 4; ++mt) pa[mt] = GLA_MFMA(af[ss][mt], bf[ss], pa[mt]); }
#pragma unroll
            for (int mt = 0; mt < 4; ++mt)
#pragma unroll
                for (int j = 0; j < 4; ++j) sP[(wave * 64 + 16 * mt + 4 * g + j) * 16 + li] = pa[mt][j]; }
        __syncthreads();
#pragma unroll
        for (int e2 = 0; e2 < 2; ++e2) { const int e = tid + 512 * e2; float s = 0.f;
#pragma unroll
            for (int w = 0; w < 8; ++w) s += sP[w * 1024 + e];
            sA1[e] = s; }
        for (int h = 0; h < 4; ++h) {
        const int u = (b << 9) | (c << 2) | h;
        __syncthreads();
        v4u q8r[4], k8r[4];
#pragma unroll
        for (int i = 0; i < 4; ++i) { const int n = tid + 512 * i, r = n >> 5, ch = n & 31;
            q8r[i] = *(const GAS v4u*)(Zb + (row0 + r) * ZP + ZC_Q + h * 256 + 8 * ch); k8r[i] = *(const GAS v4u*)(Zb + (row0 + r) * ZP + ZC_K + h * 256 + 8 * ch); }
        {
            const int d = tid & 255, hf = tid >> 8; float wa[16];
#pragma unroll
            for (int r = 0; r < 16; ++r) wa[r] = w_alpha[r * 1024 + h * 256 + d];
            const float ba = b_alpha[h * 256 + d];
            float vv[32];
#pragma unroll
            for (int t4 = 0; t4 < 32; t4 += 4) {
                f32x4 av[4][4];
#pragma unroll
                for (int tt = 0; tt < 4; ++tt) { const LAS f32x4* ap = (const LAS f32x4*)(sA1 + (32 * hf + t4 + tt) * 16); av[tt][0] = ap[0]; av[tt][1] = ap[1]; av[tt][2] = ap[2]; av[tt][3] = ap[3]; }
                __builtin_amdgcn_sched_barrier(0);
#pragma unroll
                for (int tt = 0; tt < 4; ++tt) { const f32x4 a0 = av[tt][0], a1 = av[tt][1], a2 = av[tt][2], a3 = av[tt][3];
                    float s = ba + (a0.x * wa[0] + a0.y * wa[1]) + (a0.z * wa[2] + a0.w * wa[3]) + (a1.x * wa[4] + a1.y * wa[5]) + (a1.z * wa[6] + a1.w * wa[7])
                                 + (a2.x * wa[8] + a2.y * wa[9]) + (a2.z * wa[10] + a2.w * wa[11]) + (a3.x * wa[12] + a3.y * wa[13]) + (a3.z * wa[14] + a3.w * wa[15]);
                    vv[t4 + tt] = pg8::flogsig(s) * 0.0625f; }
                __builtin_amdgcn_sched_barrier(0);
            }
#pragma unroll
            for (int t = 1; t < 32; ++t) vv[t] += vv[t - 1];
            LAS float* tot = (LAS float*)(lds + 65536);
            if (hf == 0) tot[d] = vv[31];
            __syncthreads();
            const float add = hf ? tot[d] : 0.f;
#pragma unroll
            for (int t = 0; t < 32; ++t) sB[(32 * hf + t) * 256 + d] = vv[t] + add;
        }
        __syncthreads();
#pragma unroll
        for (int i = 0; i < 4; ++i) { const int n = tid + 512 * i, r = n >> 5, ch = n & 31;
            bf16* qp = Zb + (row0 + r) * ZP + ZC_Q + h * 256; bf16* kp = Zb + (row0 + r) * ZP + ZC_K + h * 256;
            const v4u q8 = q8r[i], k8 = k8r[i];
            const f32x4 b0 = *(const LAS f32x4*)(sB + r * 256 + 8 * ch), b1 = *(const LAS f32x4*)(sB + r * 256 + 8 * ch + 4);
            const f32x4 l0 = *(const LAS f32x4*)(sB + 63 * 256 + 8 * ch), l1 = *(const LAS f32x4*)(sB + 63 * 256 + 8 * ch + 4);
            const float qv[8] = {bfl(q8.x), bfh(q8.x), bfl(q8.y), bfh(q8.y), bfl(q8.z), bfh(q8.z), bfl(q8.w), bfh(q8.w)};
            const float kv[8] = {bfl(k8.x), bfh(k8.x), bfl(k8.y), bfh(k8.y), bfl(k8.z), bfh(k8.z), bfl(k8.w), bfh(k8.w)};
            const float bb[8] = {b0.x, b0.y, b0.z, b0.w, b1.x, b1.y, b1.z, b1.w}; const float bl[8] = {l0.x, l0.y, l0.z, l0.w, l1.x, l1.y, l1.z, l1.w};
            float qt[8], kt[8], ke[8];
#pragma unroll
            for (int e = 0; e < 8; ++e) { qt[e] = qv[e] * __expf(bb[e]) * 0.0625f; kt[e] = kv[e] * __expf(-bb[e]); ke[e] = kv[e] * __expf(bl[e] - bb[e]); }
            v4u qw, kw, ew; qw.x = pkbf(qt[0], qt[1]); qw.y = pkbf(qt[2], qt[3]); qw.z = pkbf(qt[4], qt[5]); qw.w = pkbf(qt[6], qt[7]);
            kw.x = pkbf(kt[0], kt[1]); kw.y = pkbf(kt[2], kt[3]); kw.z = pkbf(kt[4], kt[5]); kw.w = pkbf(kt[6], kt[7]);
            ew.x = pkbf(ke[0], ke[1]); ew.y = pkbf(ke[2], ke[3]); ew.z = pkbf(ke[4], ke[5]); ew.w = pkbf(ke[6], ke[7]);
            *(LAS v4u*)(sQ + off_q(r, ch)) = qw; *(LAS v4u*)(sK + off_q(r, ch)) = kw;
            *(GAS v4u*)(kp + 8 * ch) = ew;
            const int p0 = 32 * (ch >> 2) + 16 * (ch & 1) + 4 * ((ch >> 1) & 1);
            v2u w0, w1; w0.x = qw.x; w0.y = qw.y; w1.x = qw.z; w1.y = qw.w;
            *(GAS v2u*)(qp + p0) = w0; *(GAS v2u*)(qp + p0 + 8) = w1; }
        if (tid < 256) DEC[((size_t)b * 128 + c) * 1024 + h * 256 + tid] = __expf(sB[63 * 256 + tid]);
        __syncthreads();
#pragma unroll
        for (int tt = 0; tt < 2; ++tt) { const int T = 2 * wave + tt, jt = T >> 2, it = T & 3;
            f32x4 acc = {0.f, 0.f, 0.f, 0.f};
            if (jt <= it) {
#pragma unroll
                for (int s = 0; s < 8; ++s) { const gl_bf16x8 a = *(const LAS gl_bf16x8*)(sK + off_q(16 * jt + li, 4 * s + g)), bq = *(const LAS gl_bf16x8*)(sQ + off_q(16 * it + li, 4 * s + g));
                    acc = GLA_MFMA(a, bq, acc); } }
            const int i = 16 * it + (int)li, j0 = 16 * jt + 4 * (int)g;
            v2u w; w.x = pkbf(j0 + 0 <= i ? acc[0] : 0.f, j0 + 1 <= i ? acc[1] : 0.f); w.y = pkbf(j0 + 2 <= i ? acc[2] : 0.f, j0 + 3 <= i ? acc[3] : 0.f);
            *(GAS v2u*)(ATT + (size_t)u * 4096 + i * 64 + j0) = w; }
        }
    }
}

struct GlaRegs { v4u k[4], q[4], v[2], a; f32x4 d; };
template <bool WITH_Q>
__device__ __forceinline__ void gla_issue(GlaRegs& R, const bf16* Zb, const bf16* ATT, const float* DEC, int b, int c, int h, int sl, int tid) {
    const size_t row0 = (size_t)b * SEQ + (size_t)c * 64;
#pragma unroll
    for (int i = 0; i < 4; ++i) { const int n = tid + 512 * i, r = n >> 5, ch = n & 31;
        R.k[i] = *(const GAS v4u*)(Zb + (row0 + r) * ZP + ZC_K + h * 256 + 8 * ch);
        if (WITH_Q) R.q[i] = *(const GAS v4u*)(Zb + (row0 + r) * ZP + ZC_Q + h * 256 + 8 * ch); }
#pragma unroll
    for (int i = 0; i < 2; ++i) { const int n = tid + 512 * i, r = n >> 4, ch = n & 15; R.v[i] = *(const GAS v4u*)(Zb + (row0 + r) * ZP + ZC_V + h * 512 + sl * 128 + 8 * ch); }
    if (WITH_Q) { const int r = tid >> 3, ch = tid & 7; const unsigned u = ((unsigned)b << 9) | ((unsigned)c << 2) | (unsigned)h; R.a = *(const GAS v4u*)(ATT + (size_t)u * 4096 + r * 64 + 8 * ch); }
    if (tid < 64) R.d = *(const GAS f32x4*)(DEC + ((size_t)b * 128 + c) * 1024 + h * 256 + 4 * tid);
}
template <bool WITH_Q>
__device__ __forceinline__ void gla_commit(const GlaRegs& R, LAS unsigned char* lds, int tid) {
#pragma unroll
    for (int i = 0; i < 4; ++i) { const int n = tid + 512 * i, r = n >> 5, ch = n & 31;
        *(LAS v4u*)(lds + GL_KE + ((r >> 5) * 2 + (ch >> 4)) * 8192 + off_b(r & 31, ch & 15)) = R.k[i];
        if (WITH_Q) *(LAS v4u*)(lds + GL_QT + off_q(r, ch)) = R.q[i]; }
#pragma unroll
    for (int i = 0; i < 2; ++i) { const int n = tid + 512 * i, r = n >> 4, ch = n & 15; *(LAS v4u*)(lds + GL_V + (r >> 5) * 8192 + off_b(r & 31, ch)) = R.v[i]; }
    if (WITH_Q) { const int r = tid >> 3, ch = tid & 7; *(LAS v4u*)(lds + GL_ATT + off_a(r, ch)) = R.a; }
    if (tid < 64) ((LAS f32x4*)(lds + GL_DEC))[tid] = R.d;
}
__device__ __forceinline__ void gla_update(LAS unsigned char* lds, f32x4 (&S)[16], const gl_bf16x8 (&vf)[2], unsigned lane, unsigned g) {
    const unsigned lbase = (unsigned)(size_t)lds;
#pragma unroll
    for (int i2 = 0; i2 < 8; ++i2) {
        f32x4 d4[2]; gl_bf16x8 kf[2][2];
#pragma unroll
        for (int ii = 0; ii < 2; ++ii) { const int i = 2 * i2 + ii; d4[ii] = *(const LAS f32x4*)(lds + GL_DEC + 4 * (16 * i + 4 * g));
            kf[ii][0] = tr_frag(lbase + GL_KE + (0 * 2 + (i >> 3)) * 8192, lane, i & 7); kf[ii][1] = tr_frag(lbase + GL_KE + (1 * 2 + (i >> 3)) * 8192, lane, i & 7); }
        __builtin_amdgcn_sched_barrier(0);
#pragma unroll
        for (int ii = 0; ii < 2; ++ii) { const int i = 2 * i2 + ii; S[i] = S[i] * d4[ii]; S[i] = GLA_MFMA(kf[ii][0], vf[0], S[i]); S[i] = GLA_MFMA(kf[ii][1], vf[1], S[i]); }
        __builtin_amdgcn_sched_barrier(0);
    }
}

__device__ __forceinline__ void gla_g1(LAS unsigned char* lds, const bf16* Zb, const float* DEC, float* SL, float* DSEG, int bx, int G, int tid0, int lane0, int wave) {
    const int tid = opq(tid0), lane = tid & 63; (void)lane0;
    const unsigned li = lane & 15, g = lane >> 4; const unsigned lbase = (unsigned)(size_t)lds;
    for (int un = bx; un < 256; un += G) {
        const int seg = un & 7, bh = un >> 5, sl = (un >> 3) & 3, b = bh >> 2, h = bh & 3;
        if (seg == 7) continue;
        f32x4 S[16];
#pragma unroll
        for (int i = 0; i < 16; ++i) S[i] = (f32x4){0.f, 0.f, 0.f, 0.f};
        float dprod = 1.0f;
        GlaRegs R; gla_issue<false>(R, Zb, nullptr, DEC, b, seg * GLA_CPS, h, sl, tid);
        for (int cc = 0; cc < GLA_CPS; ++cc) {
            __syncthreads();
            gla_commit<false>(R, lds, tid);
            __syncthreads();
            if (cc + 1 < GLA_CPS) gla_issue<false>(R, Zb, nullptr, DEC, b, seg * GLA_CPS + cc + 1, h, sl, tid);
            if (tid < 256) dprod *= ((LAS float*)(lds + GL_DEC))[tid];
            unsigned lv = (unsigned)lane; asm volatile("" : "+v"(lv));
            gl_bf16x8 vf[2]; vf[0] = tr_frag(lbase + GL_V, lv, wave); vf[1] = tr_frag(lbase + GL_V + 8192, lv, wave);
            gla_update(lds, S, vf, lv, lv >> 4);
        }
        float* pp = SL + ((size_t)(bh * 7 + seg) * 256 + 4 * g) * 512 + sl * 128 + 16 * wave + li;
#pragma unroll
        for (int i = 0; i < 16; ++i) { asm volatile("" : "+v"(pp));
#pragma unroll
            for (int r = 0; r < 4; ++r) pp[r * 512] = S[i][r];
            pp += 16 * 512; }
        if (sl == 0 && tid < 256) DSEG[(bh * 7 + seg) * 256 + tid] = dprod;
    }
}
__device__ __forceinline__ void gla_g2(float* SL, const float* DSEG, int gtid, int NT) {
    for (int it = gtid; it < 8 * 256 * 128; it += NT) { const int bh = it >> 15, dk = (it >> 7) & 255, d4 = it & 127;
        f32x4 s = {0.f, 0.f, 0.f, 0.f}, lv[7]; float dv[7];
#pragma unroll
        for (int seg = 0; seg < 7; ++seg) { lv[seg] = *((const GAS f32x4*)(SL + ((size_t)(bh * 7 + seg) * 256 + dk) * 512) + d4); dv[seg] = DSEG[(bh * 7 + seg) * 256 + dk]; }
#pragma unroll
        for (int seg = 0; seg < 7; ++seg) { s = s * dv[seg] + lv[seg]; *((GAS f32x4*)(SL + ((size_t)(bh * 7 + seg) * 256 + dk) * 512) + d4) = s; } }
}
__device__ __forceinline__ void gla_g3_chunk(LAS unsigned char* lds, f32x4 (&S)[16], GlaRegs& R, const bf16* Zb, const bf16* ATT, const float* DEC, float* OF,
                                             int b, int c, int h, int sl, int c_next, bool refill, bool do_update, int tid, int lane, int wave) {
    const unsigned lbase = (unsigned)(size_t)lds;
    __syncthreads();
    gla_commit<true>(R, lds, tid);
    __syncthreads();
    if (refill) gla_issue<true>(R, Zb, ATT, DEC, b, c_next, h, sl, tid);
    unsigned lv = (unsigned)lane; asm volatile("" : "+v"(lv));
    const unsigned li = lv & 15, g = lv >> 4;
    gl_bf16x8 vf[2]; vf[0] = tr_frag(lbase + GL_V, lv, wave); vf[1] = tr_frag(lbase + GL_V + 8192, lv, wave);
    f32x4 o[4];
#pragma unroll
    for (int nt = 0; nt < 4; ++nt) o[nt] = (f32x4){0.f, 0.f, 0.f, 0.f};
#pragma unroll
    for (int s = 0; s < 8; ++s) {
        gl_bf16x8 qf[4];
#pragma unroll
        for (int nt = 0; nt < 4; ++nt) qf[nt] = *(const LAS gl_bf16x8*)(lds + GL_QT + off_q(16 * nt + li, 4 * s + g));
        v4u aw; aw.x = pkbf(S[2 * s][0], S[2 * s][1]); aw.y = pkbf(S[2 * s][2], S[2 * s][3]); aw.z = pkbf(S[2 * s + 1][0], S[2 * s + 1][1]); aw.w = pkbf(S[2 * s + 1][2], S[2 * s + 1][3]);
        const gl_bf16x8 af = __builtin_bit_cast(gl_bf16x8, aw);
        __builtin_amdgcn_sched_barrier(0);
#pragma unroll
        for (int nt = 0; nt < 4; ++nt) o[nt] = GLA_MFMA(af, qf[nt], o[nt]);
        __builtin_amdgcn_sched_barrier(0);
    }
    { gl_bf16x8 tf[6];
#pragma unroll
        for (int nt = 0; nt < 4; ++nt) tf[nt] = *(const LAS gl_bf16x8*)(lds + GL_ATT + off_a(16 * nt + li, g));
#pragma unroll
        for (int nt = 2; nt < 4; ++nt) tf[2 + nt] = *(const LAS gl_bf16x8*)(lds + GL_ATT + off_a(16 * nt + li, 4 + g));
        __builtin_amdgcn_sched_barrier(0);
#pragma unroll
        for (int nt = 0; nt < 4; ++nt) o[nt] = GLA_MFMA(vf[0], tf[nt], o[nt]);
#pragma unroll
        for (int nt = 2; nt < 4; ++nt) o[nt] = GLA_MFMA(vf[1], tf[2 + nt], o[nt]);
        __builtin_amdgcn_sched_barrier(0); }
    bf16* op = (bf16*)OF + ((size_t)b * SEQ + (size_t)c * 64 + li) * D + h * 512 + sl * 128 + 16 * wave + 4 * g;
#pragma unroll
    for (int nt = 0; nt < 4; ++nt) { v2u w; w.x = pkbf(o[nt][0], o[nt][1]); w.y = pkbf(o[nt][2], o[nt][3]); *(GAS v2u*)(op + (size_t)(16 * nt) * D) = w; }
    if (do_update) gla_update(lds, S, vf, lv, g);
}
__device__ __forceinline__ void gla_g3(LAS unsigned char* lds, const bf16* Zb, const bf16* ATT, const float* DEC, const float* SL, float* OF, int bx, int G, int tid0, int lane0, int wave) {
    const int tid = opq(tid0), lane = tid & 63; (void)lane0;
    const unsigned li = lane & 15, g = lane >> 4;
    for (int un = bx; un < 256; un += G) {
        const int seg = un & 7, bh = un >> 5, sl = (un >> 3) & 3, b = bh >> 2, h = bh & 3;
        f32x4 S[16];
        if (seg == 0) {
#pragma unroll
            for (int i = 0; i < 16; ++i) S[i] = (f32x4){0.f, 0.f, 0.f, 0.f};
        } else { const float* pp = SL + ((size_t)(bh * 7 + seg - 1) * 256 + 4 * g) * 512 + sl * 128 + 16 * wave + li;
#pragma unroll
            for (int i = 0; i < 16; ++i) { asm volatile("" : "+v"(pp));
#pragma unroll
                for (int r = 0; r < 4; ++r) S[i][r] = pp[r * 512];
                pp += 16 * 512; } }
        const int c0 = seg * GLA_CPS;
        GlaRegs RA; gla_issue<true>(RA, Zb, ATT, DEC, b, c0, h, sl, tid);
        for (int cc = 0; cc < GLA_CPS; ++cc)
            gla_g3_chunk(lds, S, RA, Zb, ATT, DEC, OF, b, c0 + cc, h, sl, c0 + cc + 1, cc + 1 < GLA_CPS, cc + 1 < GLA_CPS, tid, lane, wave);
    }
}

struct Args { const float* in[20]; float* out; unsigned char* ws; int ph_lo, ph_hi, li, pad; };
constexpr int PH_PER_LAYER = 12, N_PHASES = 2 + 2 * PH_PER_LAYER;

#define IN(k) (lo <= (k) && (k) < hi)
#define SEAM(k) do { if (IN(k) && IN((k) + 1)) xcd_barrier(bar); } while (0)
template <int l> __device__ __forceinline__ void layer_phases(const Args& args, LAS unsigned char* lds, const XcdBarrier& bar, const int lo, const int hi,
                                                             const int tid, const int lane, const int wave, const int G, const int bx, const int vcu, const int gw, const int NGW) {
    unsigned char* ws = args.ws;
    gu32* ctl = (gu32*)(ws + WS_CTL);
    const float* x_in = args.in[0]; const float* ln_mix = args.in[1]; const float* w_in = args.in[2]; const float* w_alpha = args.in[3]; const float* b_alpha = args.in[4];
    const float* gla_norm = args.in[5]; const float* w_pool = args.in[6]; const float* pool_scale = args.in[7]; const float* w_bg = args.in[8]; const float* w_bp = args.in[9];
    const float* w_out = args.in[10]; const float* ln_ffn = args.in[11]; const float* ffn_g = args.in[12]; const float* ffn_u = args.in[13]; const float* ffn_d = args.in[14];
    const float* router_w = args.in[15]; const float* exp_g = args.in[16]; const float* exp_u = args.in[17]; const float* exp_d = args.in[18]; const float* ln_final = args.in[19];
    float* xo = args.out;
    bf16* WinT = (bf16*)(ws + WS_WIN); bf16* BcatT = (bf16*)(ws + WS_BCAT); bf16* WoutT = (bf16*)(ws + WS_WOUT); bf16* FF1T = (bf16*)(ws + WS_FF1); bf16* FF2T = (bf16*)(ws + WS_FF2);
    unsigned char* EF1T = ws + WS_EF1; unsigned char* EF2T = ws + WS_EF2;
    bf16* Hb = (bf16*)(ws + WS_HB); bf16* Zb = (bf16*)(ws + WS_ZB); float* LA = (float*)(ws + WS_LA); float* OF = (float*)(ws + WS_OF);
    bf16* Acat = (bf16*)(ws + WS_ACAT); bf16* Ub = (bf16*)(ws + WS_U); bf16* Hmid = (bf16*)(ws + WS_HMID); unsigned char* Hmid8 = ws + WS_HMID; unsigned char* Hperm8 = ws + WS_HPERM;
    bf16* WA1T = (bf16*)(ws + WS_CTL + 3 * MiB); bf16* WbpT = (bf16*)(ws + WS_OF); bf16* WpS = (bf16*)(ws + WS_OF + 8 * MiB);
    int* slot_of_tok = (int*)(ws + WS_TOKSLOT); int* tok_e = (int*)(ws + WS_TOKE); float* tok_w = (float*)(ws + WS_TOKW); bf16* YS = (bf16*)(ws + WS_LA);
    unsigned* cnt = (unsigned*)(ctl + CW_CNT); unsigned* fill = (unsigned*)(ctl + CW_FILL);

    constexpr int pb = 1 + PH_PER_LAYER * l;
        if (IN(pb + 0)) {
            pg8::Gemm g{Hb, WinT + (size_t)l * ZN * D, M, ZP, D, 0, D, D}; pg8::StaticOrder S; S.init(M, ZP, G, bx);
            pg8::EpiZ E{Zb};
            pg8::gemm_phase<pg8::EpiZ, pg8::StaticOrder, true, true>(lds + RING_OFF, g, S, E);
        }
        SEAM(pb + 0);
        bf16* ATT = (bf16*)(ws + WS_LA); float* DEC = (float*)(ws + WS_LA + 8 * MiB); float* DSEG = (float*)(ws + WS_LA + 10 * MiB); float* SL = (float*)(ws + WS_U);
        if (IN(pb + 1)) gla_g0(lds + RING_OFF, Zb, Hb, WA1T + (size_t)l * 16 * D, w_alpha + (size_t)l * 16 * 1024, b_alpha + l * 1024, ATT, DEC, bx, G, tid, lane, wave);
        SEAM(pb + 1);
        if (IN(pb + 2)) gla_g1(lds + RING_OFF, Zb, DEC, SL, DSEG, bx, G, tid, lane, wave);
        SEAM(pb + 2);
        if (IN(pb + 3)) {
            if (l == 0) {
                pg8::Gemm g{WbpT, WpS, 2 * 4 * 2048, 256, 256, (size_t)256 * 256 * 2, 256, 256}; pg8::PoolOrder S; S.G = G; S.c = bx;
                pg8::EpiPoolW E{BcatT};
                pg8::gemm_phase<pg8::EpiPoolW, pg8::PoolOrder, false, false>(lds + RING_OFF, g, S, E);
            }
            gla_g2(SL, DSEG, vcu * 512 + tid, G * 512);
        }
        SEAM(pb + 3);
        if (IN(pb + 4)) gla_g3(lds + RING_OFF, Zb, ATT, DEC, SL, OF, bx, G, tid, lane, wave);
        SEAM(pb + 4);
        if (IN(pb + 5)) {
            const float* gn = gla_norm + l * HV;
            const f32x4 g0 = *(const GAS f32x4*)(gn + lane * 8), g1 = *(const GAS f32x4*)(gn + lane * 8 + 4);
            v4u no[4], nr[4];
#define G4_FETCH(mm) do { const int m_ = (mm); _Pragma("unroll") for (int h_ = 0; h_ < NH; ++h_) { no[h_] = *(const GAS v4u*)((const bf16*)OF + (size_t)m_ * D + h_ * HV + lane * 8); \
                nr[h_] = *(const GAS v4u*)(Zb + (size_t)m_ * ZP + ZC_R + h_ * HV + lane * 8); } } while (0)
            if (gw < M) G4_FETCH(gw);
            for (int m = gw; m < M; m += NGW) {
                v4u co[4], cr[4];
#pragma unroll
                for (int h = 0; h < NH; ++h) { co[h] = no[h]; cr[h] = nr[h]; }
                if (m + NGW < M) G4_FETCH(m + NGW);
#pragma unroll
                for (int h = 0; h < NH; ++h) {
                    const v4u ow = co[h]; f32x4 o0 = {bfl(ow.x), bfh(ow.x), bfl(ow.y), bfh(ow.y)}, o1 = {bfl(ow.z), bfh(ow.z), bfl(ow.w), bfh(ow.w)};
                    float s = (o0.x * o0.x + o0.y * o0.y) + (o0.z * o0.z + o0.w * o0.w) + (o1.x * o1.x + o1.y * o1.y) + (o1.z * o1.z + o1.w * o1.w);
                    const float rstd = 1.0f / sqrtf(wave_sum(s) * (1.0f / HV) + EPS);
                    const v4u rw = cr[h];
                    o0 = o0 * rstd * g0; o1 = o1 * rstd * g1;
                    v4u w; w.x = pk2(o0.x * bfl(rw.x), o0.y * bfh(rw.x)); w.y = pk2(o0.z * bfl(rw.y), o0.w * bfh(rw.y)); w.z = pk2(o1.x * bfl(rw.z), o1.y * bfh(rw.z)); w.w = pk2(o1.z * bfl(rw.w), o1.w * bfh(rw.w));
                    *(GAS v4u*)(Acat + (size_t)m * KCAT + h * HV + lane * 8) = w;
                }
                const int t = m & (SEQ - 1), win = 2 << (lane >> 4), nw = (t + 1 < win) ? (t + 1) : win;
                float sm[16], p0[16];
#pragma unroll
                for (int i = 0; i < 16; ++i) { sm[i] = 0.f; p0[i] = 0.f; }
#pragma unroll
                for (int bt = 0; bt < 2; ++bt) {
                    v4u pa[8], pc[8];
#pragma unroll
                    for (int s = 0; s < 8; ++s) { const int sft = 8 * bt + s; pa[s] = (v4u){0u, 0u, 0u, 0u}; pc[s] = (v4u){0u, 0u, 0u, 0u};
                        if (sft < nw) { const GAS v4u* pp = (const GAS v4u*)(Zb + (size_t)(m - sft) * ZP + ZC_P + lane * 16); pa[s] = pp[0]; pc[s] = pp[1]; } }
#pragma unroll
                    for (int s = 0; s < 8; ++s) { const v4u a = pa[s], c = pc[s];
                        const float pv[16] = {bfl(a.x), bfh(a.x), bfl(a.y), bfh(a.y), bfl(a.z), bfh(a.z), bfl(a.w), bfh(a.w), bfl(c.x), bfh(c.x), bfl(c.y), bfh(c.y), bfl(c.z), bfh(c.z), bfl(c.w), bfh(c.w)};
#pragma unroll
                        for (int i = 0; i < 16; ++i) { sm[i] += pv[i]; if (bt == 0 && s == 0) p0[i] = pv[i]; } }
                }
                const float inv = 1.0f / (float)nw;
                v4u w0, w1;
                w0.x = pk2(sm[0] * inv - p0[0], sm[1] * inv - p0[1]); w0.y = pk2(sm[2] * inv - p0[2], sm[3] * inv - p0[3]); w0.z = pk2(sm[4] * inv - p0[4], sm[5] * inv - p0[5]); w0.w = pk2(sm[6] * inv - p0[6], sm[7] * inv - p0[7]);
                w1.x = pk2(sm[8] * inv - p0[8], sm[9] * inv - p0[9]); w1.y = pk2(sm[10] * inv - p0[10], sm[11] * inv - p0[11]); w1.z = pk2(sm[12] * inv - p0[12], sm[13] * inv - p0[13]); w1.w = pk2(sm[14] * inv - p0[14], sm[15] * inv - p0[15]);
                GAS v4u* mp = (GAS v4u*)(Acat + (size_t)m * KCAT + 2048 + lane * 16); mp[0] = w0; mp[1] = w1;
            }
        }
        SEAM(pb + 5);
        if (IN(pb + 6)) {
            pg8::Gemm g{Acat, BcatT + (size_t)l * D * KCAT, M, D, KCAT, 0, KCAT, KCAT}; pg8::StaticOrder S; S.init(M, D, G, bx);
            pg8::EpiY E{Ub, D, Zb, ZP};
            pg8::gemm_phase<pg8::EpiY, pg8::StaticOrder, true, true>(lds + RING_OFF, g, S, E);
        }
        SEAM(pb + 6);
        if (IN(pb + 7)) {
            pg8::Gemm g{Ub, WoutT + (size_t)l * D * D, M, D, D, 0, D, D}; pg8::StaticOrder S; S.init(M, D, G, bx);
            pg8::EpiRes E{l == 0 ? x_in : (const float*)xo, xo, D};
            pg8::gemm_phase<pg8::EpiRes, pg8::StaticOrder, true, true>(lds + RING_OFF, g, S, E);
        }
        SEAM(pb + 7);
        if (IN(pb + 8)) {
            if (l == 0) norm_rows<false, DENSE_FP8>(xo, ln_ffn, Hb, gw, NGW, lane, nullptr, nullptr, nullptr, nullptr);
            else {
                LAS float* rw = (LAS float*)(lds + RING_OFF); LAS unsigned* hist = (LAS unsigned*)(lds + RING_OFF + 65536);
                for (int i = tid; i < D * NE / 4; i += 512) ((LAS f32x4*)rw)[i] = ((const GAS f32x4*)router_w)[i];
                if (tid < 8) hist[tid] = 0u;
                __syncthreads();
                norm_rows<true>(xo, ln_ffn + D, Hb, gw, NGW, lane, rw, tok_e, tok_w, hist);
                __syncthreads();
                if (tid < 8) __hip_atomic_fetch_add(cnt + tid, hist[tid], RLX_AGENT);
            }
        }
        SEAM(pb + 8);
        if (l == 0) {
            if (IN(pb + 9)) {
                pg8::StaticOrder S; S.init(M, FFN, G, bx);
                if constexpr (DENSE_FP8) { pg8::Gemm g{Hb, FF1T, M, FFN, D / 2, 0, D / 2, D / 2}; pg8::EpiSwiGLU8 E{Hmid8, DFF};
                    pg8::gemm_phase<pg8::EpiSwiGLU8, pg8::StaticOrder, true, true, true>(lds + RING_OFF, g, S, E); }
                else { pg8::Gemm g{Hb, FF1T, M, FFN, D, 0, D, D}; pg8::EpiSwiGLU E{Hmid, DFF};
                    pg8::gemm_phase<pg8::EpiSwiGLU, pg8::StaticOrder, true, true>(lds + RING_OFF, g, S, E); }
            }
            SEAM(pb + 9);
            if (IN(pb + 10)) {
                pg8::StaticOrder S; S.init(M, D, G, bx); pg8::EpiRes E{xo, xo, D};
                if constexpr (DENSE_FP8) { pg8::Gemm g{Hmid, FF2T, M, D, DFF / 2, 0, DFF / 2, DFF / 2}; pg8::gemm_phase<pg8::EpiRes, pg8::StaticOrder, true, true, true>(lds + RING_OFF, g, S, E); }
                else { pg8::Gemm g{Hmid, FF2T, M, D, DFF, 0, DFF, DFF}; pg8::gemm_phase<pg8::EpiRes, pg8::StaticOrder, true, true>(lds + RING_OFF, g, S, E); }
            }
            SEAM(pb + 10);
            if (IN(pb + 11)) norm_rows<false>(xo, ln_mix + D, Hb, gw, NGW, lane, nullptr, nullptr, nullptr, nullptr);
            SEAM(pb + 11);
        } else {
            if (IN(pb + 9)) {
                LAS unsigned* lcnt = (LAS unsigned*)(lds + RING_OFF); LAS unsigned* lbase = lcnt + 8; LAS int* lslot = (LAS int*)(lcnt + 16);
                int brow[8]; { int p = 0;
#pragma unroll
                    for (int e = 0; e < 8; ++e) { brow[e] = 256 * p; p += (int)((__hip_atomic_load(cnt + e, RLX_AGENT) + 255u) >> 8); } }
                for (int ch = bx; ch < M / 64; ch += G) {
                    __syncthreads();
                    if (tid < 8) lcnt[tid] = 0u;
                    __syncthreads();
                    int e = 0, tok = 0; unsigned rank = 0;
                    if (tid < 128) { tok = ch * 64 + (tid >> 1); e = tok_e[2 * tok + (tid & 1)]; rank = __hip_atomic_fetch_add(lcnt + e, 1u, __ATOMIC_RELAXED, __HIP_MEMORY_SCOPE_WORKGROUP); }
                    __syncthreads();
                    if (tid < 8) lbase[tid] = __hip_atomic_fetch_add(fill + tid, lcnt[tid], RLX_AGENT);
                    __syncthreads();
                    if (tid < 128) { int br = 0;
#pragma unroll
                        for (int q = 0; q < 8; ++q) br = (e == q) ? brow[q] : br;
                        const int slot = br + (int)lbase[e] + (int)rank; lslot[tid] = slot; slot_of_tok[2 * tok + (tid & 1)] = slot; }
                    __syncthreads();
                    for (int en = wave; en < 128; en += NWAVES) { const int tk = ch * 64 + (en >> 1), slot = lslot[en];
                        const GAS v4u* src = (const GAS v4u*)(Hb + (size_t)tk * D) + 4 * lane; GAS v4u* dst = (GAS v4u*)(Hperm8 + (size_t)slot * D) + 2 * lane;
#pragma unroll
                        for (int j = 0; j < 2; ++j) { const v4u a = src[2 * j], c = src[2 * j + 1]; v4u o;
                            o.x = pg8::pk4_fp8(bfl(a.x), bfh(a.x), bfl(a.y), bfh(a.y)); o.y = pg8::pk4_fp8(bfl(a.z), bfh(a.z), bfl(a.w), bfh(a.w));
                            o.z = pg8::pk4_fp8(bfl(c.x), bfh(c.x), bfl(c.y), bfh(c.y)); o.w = pg8::pk4_fp8(bfl(c.z), bfh(c.z), bfl(c.w), bfh(c.w)); dst[j] = o; } }
                }
            }
            SEAM(pb + 9);
            if (IN(pb + 10)) {
                pg8::Gemm g{(const bf16*)Hperm8, (const bf16*)EF1T, MAXSLOT, FFN, D / 2, (size_t)FFN * D, D / 2, D / 2}; pg8::MoeOrder S; S.init(cnt, FFN / 256, G, bx);
                pg8::EpiSwiGLU8 E{Hmid8, DFF};
                pg8::gemm_phase<pg8::EpiSwiGLU8, pg8::MoeOrder, true, true, true>(lds + RING_OFF, g, S, E);
            }
            SEAM(pb + 10);
            if (IN(pb + 11)) {
                pg8::Gemm g{(const bf16*)Hmid8, (const bf16*)EF2T, MAXSLOT, D, DFF / 2, (size_t)D * DFF, DFF / 2, DFF / 2}; pg8::MoeOrder S; S.init(cnt, D / 256, G, bx);
                pg8::EpiBf16 E{YS, D};
                pg8::gemm_phase<pg8::EpiBf16, pg8::MoeOrder, true, true, true>(lds + RING_OFF, g, S, E);
            }
            SEAM(pb + 11);
        }
}

__global__ void __launch_bounds__(NWAVES * 64, 2) fwd(Args args) {
    extern __shared__ __attribute__((aligned(16))) unsigned char lds_raw[];
    LAS unsigned char* lds = (LAS unsigned char*)lds_raw;
    volatile LAS unsigned* MISC = (volatile LAS unsigned*)(lds + MISC_OFF);
    const int tid = threadIdx.x, lane = tid & 63, wave = __builtin_amdgcn_readfirstlane(tid >> 6);
    const int G = gridDim.x, bx = blockIdx.x;
    const int vcu = (G % 8 == 0) ? (bx % 8) * (G / 8) + bx / 8 : bx;
    const int gw = vcu * NWAVES + wave, NGW = G * NWAVES;
    unsigned char* ws = args.ws;
    gu32* ctl = (gu32*)(ws + WS_CTL);
    const float* x_in = args.in[0]; const float* ln_mix = args.in[1]; const float* w_in = args.in[2]; const float* w_alpha = args.in[3]; const float* b_alpha = args.in[4];
    const float* gla_norm = args.in[5]; const float* w_pool = args.in[6]; const float* pool_scale = args.in[7]; const float* w_bg = args.in[8]; const float* w_bp = args.in[9];
    const float* w_out = args.in[10]; const float* ln_ffn = args.in[11]; const float* ffn_g = args.in[12]; const float* ffn_u = args.in[13]; const float* ffn_d = args.in[14];
    const float* router_w = args.in[15]; const float* exp_g = args.in[16]; const float* exp_u = args.in[17]; const float* exp_d = args.in[18]; const float* ln_final = args.in[19];
    float* xo = args.out;
    bf16* WinT = (bf16*)(ws + WS_WIN); bf16* BcatT = (bf16*)(ws + WS_BCAT); bf16* WoutT = (bf16*)(ws + WS_WOUT); bf16* FF1T = (bf16*)(ws + WS_FF1); bf16* FF2T = (bf16*)(ws + WS_FF2);
    unsigned char* EF1T = ws + WS_EF1; unsigned char* EF2T = ws + WS_EF2;
    bf16* Hb = (bf16*)(ws + WS_HB); bf16* Zb = (bf16*)(ws + WS_ZB); float* LA = (float*)(ws + WS_LA); float* OF = (float*)(ws + WS_OF);
    bf16* Acat = (bf16*)(ws + WS_ACAT); bf16* Ub = (bf16*)(ws + WS_U); bf16* Hmid = (bf16*)(ws + WS_HMID); unsigned char* Hmid8 = ws + WS_HMID; unsigned char* Hperm8 = ws + WS_HPERM;
    bf16* WA1T = (bf16*)(ws + WS_CTL + 3 * MiB); bf16* WbpT = (bf16*)(ws + WS_OF); bf16* WpS = (bf16*)(ws + WS_OF + 8 * MiB);
    int* slot_of_tok = (int*)(ws + WS_TOKSLOT); int* tok_e = (int*)(ws + WS_TOKE); float* tok_w = (float*)(ws + WS_TOKW); bf16* YS = (bf16*)(ws + WS_LA);
    unsigned* cnt = (unsigned*)(ctl + CW_CNT); unsigned* fill = (unsigned*)(ctl + CW_FILL);

    for (int u = tid; u < (LDS_BYTES - LDSCTL_OFF) / 4; u += NWAVES * 64) ((LAS unsigned*)(lds + LDSCTL_OFF))[u] = 0u;
    __syncthreads();
    const int lo = args.ph_lo, hi = args.ph_hi;
    XcdBarrier bar; bar.bar = (unsigned*)(ctl + CW_BAR); bar.x = 0; bar.st = nullptr;
    if (hi - lo > 1) bar = xcd_barrier_post((unsigned*)(ctl + CW_BAR), MISC + 8);

    if (IN(0)) {
        LAS unsigned* Tl = (LAS unsigned*)(lds + RING_OFF + wave * 16384);
#ifdef PROBE_NOW
        const int PNW = (args.li == 7);
#else
        constexpr int PNW = 0;
#endif
        for (int i = vcu * 512 + tid; i < 2 * 16 * D; i += G * 512) { const int l = i >> 15, r = (i >> 11) & 15, k = i & 2047; WA1T[i] = (bf16)f2bf(w_in[(size_t)l * D * DIN + (size_t)k * DIN + 6144 + r]); }
        for (int i = vcu * 512 + tid; i < 2 * 4 * 256 * 256 / 4; i += G * 512) { const int d4 = i & 63, lg = i >> 14;
            const f32x4 w = ((const GAS f32x4*)w_pool)[i], s = ((const GAS f32x4*)pool_scale)[lg * 64 + d4];
            v2u o; o.x = pkbf(w.x * s.x, w.y * s.y); o.y = pkbf(w.z * s.z, w.w * s.w); ((GAS v2u*)WpS)[i] = o; }
#ifdef PROBE_NOSTORE
        const int PNS = (args.li == 7);
#else
        constexpr int PNS = 0;
#endif
        constexpr int T_LAYER = 8192, T_DENSE = 8448, T_ALL = 2 * T_LAYER + T_DENSE + 8 * T_DENSE;
        auto decode = [&](int it, TrJob& J) {
            J.mode = 0; J.row_off = 0; J.kind = 0; int kt, nt;
            if (it < 2 * T_LAYER) { const int l = it / T_LAYER, r = it % T_LAYER; const float* wi = w_in + (size_t)l * D * DIN; unsigned char* wt = (unsigned char*)(WinT + (size_t)l * ZN * D);
                if (r < 3072) { J.src = wi; J.ldw = DIN; J.dst = wt; J.ldt = 2 * D; kt = r / 96; nt = r % 96; }
                else if (r < 5632) { const int q = r - 3072; J.src = wi + 6160; J.ldw = DIN; J.dst = wt; J.ldt = 2 * D; J.mode = 2; kt = q / 80; nt = q % 80; }
                else if (r < 6656) { const int q = r - 5632; J.src = w_bg + (size_t)l * D * D; J.ldw = D; J.dst = (unsigned char*)(BcatT + (size_t)l * D * KCAT); J.ldt = 2 * KCAT; kt = q >> 5; nt = q & 31; }
                else if (r < 7680) { const int q = r - 6656; J.src = w_out + (size_t)l * D * D; J.ldw = D; J.dst = (unsigned char*)(WoutT + (size_t)l * D * D); J.ldt = 2 * D; kt = q >> 5; nt = q & 31; }
                else { const int q = r - 7680; kt = q >> 5; nt = q & 31;
                    J.src = w_bp + (size_t)l * 1024 * D + (size_t)(64 * kt) * D + 64 * nt; J.ldw = D; J.dst = (unsigned char*)(WbpT + ((size_t)(l * 4 + (kt >> 2)) * 2048) * 256); J.ldt = 512; J.k0 = 64 * (kt & 3); J.n0 = 64 * nt; return; }
                J.k0 = 64 * kt; J.n0 = 64 * nt;
            } else if (it < 2 * T_LAYER + T_DENSE) { const int r = it - 2 * T_LAYER, j = r / 2816, q = r % 2816;
                if (DENSE_FP8) { J.kind = 1;
                    if (j == 0) { J.src = ffn_g; J.ldw = DFF; J.dst = (unsigned char*)FF1T; J.ldt = D; J.mode = 1; kt = q / 176; nt = q % 176; }
                    else if (j == 1) { J.src = ffn_u; J.ldw = DFF; J.dst = (unsigned char*)FF1T; J.ldt = D; J.mode = 1; J.row_off = 128; kt = q / 176; nt = q % 176; }
                    else { J.src = ffn_d; J.ldw = D; J.dst = (unsigned char*)FF2T; J.ldt = DFF; kt = q >> 6; nt = q & 63; }
                    J.k0 = 128 * kt; J.n0 = 32 * nt;
                } else {
                if (j == 0) { J.src = ffn_g; J.ldw = DFF; J.dst = (unsigned char*)FF1T; J.ldt = 2 * D; J.mode = 1; kt = q / 88; nt = q % 88; }
                else if (j == 1) { J.src = ffn_u; J.ldw = DFF; J.dst = (unsigned char*)FF1T; J.ldt = 2 * D; J.mode = 1; J.row_off = 128; kt = q / 88; nt = q % 88; }
                else { J.src = ffn_d; J.ldw = D; J.dst = (unsigned char*)FF2T; J.ldt = 2 * DFF; kt = q >> 5; nt = q & 31; }
                J.k0 = 64 * kt; J.n0 = 64 * nt; }
            } else { const int r = it - 2 * T_LAYER - T_DENSE, e = r / T_DENSE, r2 = r % T_DENSE, j = r2 / 2816, q = r2 % 2816; J.kind = 1;
                if (j == 0) { J.src = exp_g + (size_t)e * D * DFF; J.ldw = DFF; J.dst = EF1T + (size_t)e * FFN * D; J.ldt = D; J.mode = 1; kt = q / 176; nt = q % 176; }
                else if (j == 1) { J.src = exp_u + (size_t)e * D * DFF; J.ldw = DFF; J.dst = EF1T + (size_t)e * FFN * D; J.ldt = D; J.mode = 1; J.row_off = 128; kt = q / 176; nt = q % 176; }
                else { J.src = exp_d + (size_t)e * DFF * D; J.ldw = D; J.dst = EF2T + (size_t)e * D * DFF; J.ldt = DFF; kt = q >> 6; nt = q & 63; }
                J.k0 = 128 * kt; J.n0 = 32 * nt;
            }
            J.src += (size_t)J.k0 * J.ldw + J.n0;
        };
        if (gw < T_ALL) {
            TrJob J, Jn; f32x4 R[16], Rn[16];
            decode(gw, J); tr_load(J, R, lane);
            for (int it = gw; it < T_ALL; it += NGW) {
                const bool more = it + NGW < T_ALL;
                if (more) { decode(it + NGW, Jn); tr_load(Jn, Rn, lane); }
                tr_finish(J, R, Tl, lane, PNS && J.kind == 1);
                if (more) { J = Jn;
#pragma unroll
                    for (int i = 0; i < 16; ++i) R[i] = Rn[i]; }
            }
        }
        norm_rows<false>(x_in, ln_mix, Hb, gw, NGW, lane, nullptr, nullptr, nullptr, nullptr);
    }
    SEAM(0);
#ifdef PROBE_XBAR
    if (hi - lo > 1) for (int i = 0; i < PROBE_XBAR; ++i) xcd_barrier(bar);
#endif

    layer_phases<0>(args, lds, bar, lo, hi, tid, lane, wave, G, bx, vcu, gw, NGW);
    layer_phases<1>(args, lds, bar, lo, hi, tid, lane, wave, G, bx, vcu, gw, NGW);
    if (IN(N_PHASES - 1)) {
        f32x4 nx[8], gv[8]; v2u na[8], nc[8]; float nw1 = 0.f, nw2 = 0.f;
#pragma unroll
        for (int j = 0; j < 8; ++j) gv[j] = ((const GAS f32x4*)ln_final)[lane + 64 * j];
#define FINAL_FETCH(mm) do { const int m_ = (mm); const GAS f32x4* xr_ = (const GAS f32x4*)(xo + (size_t)m_ * D) + lane; \
            const int s1_ = slot_of_tok[2 * m_], s2_ = slot_of_tok[2 * m_ + 1]; nw1 = tok_w[2 * m_]; nw2 = tok_w[2 * m_ + 1]; \
            const GAS v2u* y1_ = (const GAS v2u*)(YS + (size_t)s1_ * D) + lane; const GAS v2u* y2_ = (const GAS v2u*)(YS + (size_t)s2_ * D) + lane; \
            _Pragma("unroll") for (int j = 0; j < 8; ++j) { nx[j] = xr_[64 * j]; na[j] = y1_[64 * j]; nc[j] = y2_[64 * j]; } } while (0)
        if (gw < M) FINAL_FETCH(gw);
        for (int m = gw; m < M; m += NGW) {
            GAS f32x4* xr = (GAS f32x4*)(xo + (size_t)m * D) + lane;
            const float w1 = nw1, w2 = nw2;
            f32x4 v[8]; float s = 0.f;
#pragma unroll
            for (int j = 0; j < 8; ++j) { const v2u a = na[j], c = nc[j]; f32x4 t = nx[j];
                t.x += w1 * bfl(a.x) + w2 * bfl(c.x); t.y += w1 * bfh(a.x) + w2 * bfh(c.x); t.z += w1 * bfl(a.y) + w2 * bfl(c.y); t.w += w1 * bfh(a.y) + w2 * bfh(c.y);
                v[j] = t; s += (t.x * t.x + t.y * t.y) + (t.z * t.z + t.w * t.w); }
            if (m + NGW < M) FINAL_FETCH(m + NGW);
            const float rstd = 1.0f / sqrtf(wave_sum(s) * (1.0f / D) + EPS);
#pragma unroll
            for (int j = 0; j < 8; ++j) xr[64 * j] = v[j] * rstd * gv[j];
        }
    }
#undef IN
#undef SEAM
}

#ifndef MK_ONE_LAUNCH
#define MK_ONE_LAUNCH 1
#endif
#ifndef PROBE_DUP
#define PROBE_DUP -1
#endif
#ifndef PROBE_REP
#define PROBE_REP 1
#endif
extern "C" void kernel_launch(void* const* d_in, const int* in_sizes, int n_in, void* d_out, int out_size, void* d_ws, size_t ws_size, hipStream_t stream) {
    static int grid = 0;
    if (grid == 0) {
        if (n_in != 20 || in_sizes[0] != M * D || out_size != M * D || ws_size < WS_END) { fprintf(stderr, "kernel_launch: unexpected shapes / workspace (n_in %d, in0 %d, out %d, ws %zu < %zu); nothing launched\n", n_in, n_in > 0 ? in_sizes[0] : -1, out_size, ws_size, (size_t)WS_END); grid = -1; return; }
        int dev = 0, cus = 0, per_cu = 0;
        if (hipGetDevice(&dev) != hipSuccess || hipDeviceGetAttribute(&cus, hipDeviceAttributeMultiprocessorCount, dev) != hipSuccess) { grid = -1; return; }
        if (hipFuncSetAttribute((const void*)fwd, hipFuncAttributeMaxDynamicSharedMemorySize, LDS_BYTES) != hipSuccess) { fprintf(stderr, "kernel_launch: hipFuncSetAttribute failed\n"); grid = -1; return; }
        if (hipOccupancyMaxActiveBlocksPerMultiprocessor(&per_cu, (const void*)fwd, NWAVES * 64, LDS_BYTES) != hipSuccess || per_cu < 1) { fprintf(stderr, "kernel_launch: occupancy query reports %d workgroups per CU\n", per_cu); }
        (void)hipGetLastError();
        grid = cus;
    }
    if (grid < 0) return;
    if (hipMemsetAsync((char*)d_ws + WS_CTL, 0, CTL_ZERO_BYTES, stream) != hipSuccess) return;
    Args a{};
    for (int i = 0; i < 20; ++i) a.in[i] = (const float*)d_in[i];
    a.out = (float*)d_out; a.ws = (unsigned char*)d_ws;
#if MK_ONE_LAUNCH
    a.ph_lo = 0; a.ph_hi = N_PHASES; a.li = 0;
    hipLaunchKernelGGL(fwd, dim3(grid), dim3(NWAVES * 64), LDS_BYTES, stream, a);
#else
    for (int p = 0; p < N_PHASES; ++p) { a.ph_lo = p; a.ph_hi = p + 1;
        if (p == PROBE_DUP) { a.li = 7; for (int r = 0; r < PROBE_REP; ++r) hipLaunchKernelGGL(fwd, dim3(grid), dim3(NWAVES * 64), LDS_BYTES, stream, a); }
        a.li = 0; hipLaunchKernelGGL(fwd, dim3(grid), dim3(NWAVES * 64), LDS_BYTES, stream, a); }
#endif
}
```
